# Optimizing an MI355X kernel written in HIP

```python
import math
import jax, jax.numpy as jnp
from jax import lax
import numpy as np

D_MODEL = 1024
BATCH = 8
SEQ = 2048
DEPTH = 2

A_HEADS = 8
A_HEAD_DIM = 64
A_V_DIM = 2 * A_HEAD_DIM
A_WIDTH = A_HEADS * A_V_DIM
ROPE_THETA = 500000.0
ROPE_DIM = A_HEAD_DIM // 4
Q_BLOCK = 128
B_GROUPS = 4
B_GROUP_DIM = 128
B_WIDTH = B_GROUPS * B_GROUP_DIM
C_GROUPS = 4
C_GROUP_DIM = 128
C_WIDTH = C_GROUPS * C_GROUP_DIM
C_CHUNK = 128
N_BRANCH = 3
IN_COLS = 3 * A_WIDTH + B_WIDTH + 2 * C_WIDTH + N_BRANCH * D_MODEL
N_EXPERTS = 16
EXPERT_FF = 2752
EC_FACTOR = 2
EPS = 1e-6

kernel_name = "hybrid_diffattn_fnet_gmlp_ecmoe_encoder"


def rmsnorm(x, g=None):
    xf = x.astype(jnp.float32)
    y = xf * lax.rsqrt(jnp.mean(xf * xf, axis=-1, keepdims=True) + EPS)
    if g is not None:
        y = y * g.astype(jnp.float32)
    return y.astype(x.dtype)


def modulate(h, shift, scale):
    return h * (1 + scale[:, None, :]) + shift[:, None, :]


def lambda_init_fn(layer_idx):
    return 0.8 - 0.6 * math.exp(-0.3 * layer_idx)


def rope_tables(positions):
    inv_freq = ROPE_THETA ** (-jnp.arange(0, ROPE_DIM, 2, dtype=jnp.float32) / ROPE_DIM)
    ang = positions.astype(jnp.float32)[..., None] * inv_freq
    return jnp.cos(ang), jnp.sin(ang)


def apply_partial_rope(t, cos, sin):
    rot, keep = t[..., :ROPE_DIM], t[..., ROPE_DIM:]
    r1, r2 = rot[..., :ROPE_DIM // 2], rot[..., ROPE_DIM // 2:]
    c = cos[:, :, None, None, :].astype(t.dtype)
    s = sin[:, :, None, None, :].astype(t.dtype)
    return jnp.concatenate([r1 * c - r2 * s, r1 * s + r2 * c, keep], axis=-1)


def diff_attention(q, k, v, lam):
    bsz, seq = q.shape[0], q.shape[1]
    n_blk = seq // Q_BLOCK
    scale = A_HEAD_DIM ** -0.5
    q_blocks = q.reshape(bsz, n_blk, Q_BLOCK, A_HEADS, 2, A_HEAD_DIM).transpose(1, 0, 2, 3, 4, 5)

    def one_block(qi):
        s = jnp.einsum('bqhcd,bkhcd->bchqk', qi, k).astype(jnp.float32) * scale
        p = jax.nn.softmax(s, axis=-1)
        p = p[:, 0] - lam * p[:, 1]
        return jnp.einsum('bhqk,bkhe->bqhe', p.astype(v.dtype), v)

    o = lax.map(one_block, q_blocks)
    return o.transpose(1, 0, 2, 3, 4).reshape(bsz, seq, A_HEADS, A_V_DIM)


def fourier_mix(h):
    bsz, seq = h.shape[0], h.shape[1]
    hg = h.reshape(bsz, seq, B_GROUPS, B_GROUP_DIM).astype(jnp.float32)
    f = jnp.fft.fft2(hg, axes=(1, 3), norm='ortho').real
    return f.reshape(bsz, seq, B_WIDTH).astype(h.dtype)


def spatial_gating(z, w_s, b_s):
    bsz, seq = z.shape[0], z.shape[1]
    u, v = jnp.split(z, 2, axis=-1)
    n_chunk = seq // C_CHUNK
    vg = rmsnorm(v.reshape(bsz, n_chunk, C_CHUNK, C_GROUPS, C_GROUP_DIM))
    mixed = jnp.einsum('gpq,bnqgc->bnpgc', w_s.astype(z.dtype), vg) + b_s.T[None, None, :, :, None]
    return u * mixed.reshape(bsz, seq, C_WIDTH)


def expert_choice_ffn(h, w_router, w1, w3, w2):
    bsz, seq, d = h.shape
    cap = EC_FACTOR * seq // N_EXPERTS
    logits = jnp.einsum('bsd,de->bse', h, w_router).astype(jnp.float32)
    aff = jax.nn.softmax(logits, axis=-1)
    g, idx = lax.top_k(jnp.swapaxes(aff, 1, 2), cap)
    xin = jax.vmap(lambda hb, ib: hb[ib])(h, idx)
    hid = jax.nn.silu(jnp.einsum('becd,edf->becf', xin, w1)) * jnp.einsum('becd,edf->becf', xin, w3)
    y = jnp.einsum('becf,efd->becd', hid, w2) * g[..., None].astype(h.dtype)
    flat = (idx + (jnp.arange(bsz, dtype=jnp.int32) * seq)[:, None, None]).reshape(-1)
    out = jnp.zeros((bsz * seq, d), h.dtype).at[flat].add(y.reshape(-1, d))
    return out.reshape(bsz, seq, d)


def setup_inputs(seed: int = 0) -> dict:
    key = jax.random.key(seed)
    ks = jax.random.split(key, 26)
    D, L = D_MODEL, DEPTH

    def nrm(k, shape, fan_in, gain=1.0):
        return jax.random.normal(k, shape, jnp.float32) * (gain * fan_in ** -0.5)

    def near_one(k, shape):
        return 1.0 + 0.01 * jax.random.normal(k, shape, jnp.float32)

    offs = jax.random.randint(ks[2], (BATCH, 1), 0, 4096, dtype=jnp.int32)
    return {
        'x': jax.random.normal(ks[0], (BATCH, SEQ, D), jnp.float32),
        'c': jax.random.normal(ks[1], (BATCH, D), jnp.float32),
        'positions': offs + jnp.arange(SEQ, dtype=jnp.int32)[None, :],
        'w_ada': nrm(ks[3], (L, D, 6 * D), D, 0.5),
        'b_ada': 0.01 * jax.random.normal(ks[4], (L, 6 * D), jnp.float32),
        'g_mix': near_one(ks[5], (L, D)),
        'g_ffn': near_one(ks[6], (L, D)),
        'w_in': nrm(ks[7], (L, D, IN_COLS), D),
        'lam_q1': 0.1 * jax.random.normal(ks[8], (L, A_HEAD_DIM), jnp.float32),
        'lam_k1': 0.1 * jax.random.normal(ks[9], (L, A_HEAD_DIM), jnp.float32),
        'lam_q2': 0.1 * jax.random.normal(ks[10], (L, A_HEAD_DIM), jnp.float32),
        'lam_k2': 0.1 * jax.random.normal(ks[11], (L, A_HEAD_DIM), jnp.float32),
        'a_norm_g': near_one(ks[12], (L, A_V_DIM)),
        'w_s': nrm(ks[13], (L, C_GROUPS, C_CHUNK, C_CHUNK), C_CHUNK),
        'b_s': near_one(ks[14], (L, C_GROUPS, C_CHUNK)),
        'p_a': nrm(ks[15], (L, A_WIDTH, D), A_WIDTH),
        'p_b': nrm(ks[16], (L, B_WIDTH, D), B_WIDTH),
        'p_c': nrm(ks[17], (L, C_WIDTH, D), C_WIDTH),
        'w_out': nrm(ks[18], (L, D, D), D),
        'w_router': nrm(ks[19], (L, D, N_EXPERTS), D),
        'w1': nrm(ks[20], (L, N_EXPERTS, D, EXPERT_FF), D),
        'w3': nrm(ks[21], (L, N_EXPERTS, D, EXPERT_FF), D),
        'w2': nrm(ks[22], (L, N_EXPERTS, EXPERT_FF, D), EXPERT_FF),
        'g_final': near_one(ks[23], (D,)),
    }


def reference(x, c, positions, w_ada, b_ada, g_mix, g_ffn, w_in, lam_q1, lam_k1, lam_q2, lam_k2,
              a_norm_g, w_s, b_s, p_a, p_b, p_c, w_out, w_router, w1, w3, w2, g_final):
    bsz, seq, d = x.shape
    cos, sin = rope_tables(positions)
    c_act = jax.nn.silu(c)
    splits = [A_WIDTH, 2 * A_WIDTH, 3 * A_WIDTH, 3 * A_WIDTH + B_WIDTH,
              3 * A_WIDTH + B_WIDTH + 2 * C_WIDTH]
    for l in range(DEPTH):
        ada = c_act @ w_ada[l] + b_ada[l]
        sh1, sc1, gt1, sh2, sc2, gt2 = jnp.split(ada, 6, axis=-1)

        h = modulate(rmsnorm(x, g_mix[l]), sh1, sc1)
        proj = h @ w_in[l]
        q, k, v, fb, zc, gates = jnp.split(proj, splits, axis=-1)

        q = apply_partial_rope(q.reshape(bsz, seq, A_HEADS, 2, A_HEAD_DIM), cos, sin)
        k = apply_partial_rope(k.reshape(bsz, seq, A_HEADS, 2, A_HEAD_DIM), cos, sin)
        v = v.reshape(bsz, seq, A_HEADS, A_V_DIM)
        lam_init = lambda_init_fn(l)
        lam = (jnp.exp(jnp.sum(lam_q1[l].astype(jnp.float32) * lam_k1[l].astype(jnp.float32)))
               - jnp.exp(jnp.sum(lam_q2[l].astype(jnp.float32) * lam_k2[l].astype(jnp.float32)))
               + lam_init)
        a_out = diff_attention(q, k, v, lam)
        a_out = (rmsnorm(a_out, a_norm_g[l]) * (1 - lam_init)).reshape(bsz, seq, A_WIDTH)

        b_out = fourier_mix(fb)

        c_out = spatial_gating(jax.nn.gelu(zc), w_s[l], b_s[l])

        g_a, g_b, g_c = jnp.split(jax.nn.sigmoid(gates), N_BRANCH, axis=-1)
        merged = g_a * (a_out @ p_a[l]) + g_b * (b_out @ p_b[l]) + g_c * (c_out @ p_c[l])
        x = x + gt1[:, None, :] * (merged @ w_out[l])

        h = modulate(rmsnorm(x, g_ffn[l]), sh2, sc2)
        x = x + gt2[:, None, :] * expert_choice_ffn(h, w_router[l], w1[l], w3[l], w2[l])

    return rmsnorm(x, g_final)
```

```cpp
#include <hip/hip_runtime.h>
#include <cstdio>
#include <cstdint>
#include <cmath>

#ifndef ATT_DUAL
#define ATT_DUAL 1
#endif
#ifndef WIN_DBG
#define WIN_DBG 0x6F
#endif
#define LAS __attribute__((address_space(3)))
typedef unsigned short bf16_t;
typedef short bf16x8 __attribute__((ext_vector_type(8)));
typedef float f32x4 __attribute__((ext_vector_type(4)));
typedef unsigned u32x4 __attribute__((ext_vector_type(4)));

constexpr int NB = 8, SEQ = 2048, DM = 1024, NL = 2, MT = NB * SEQ;
constexpr int NIN = 8192, NIN_SRC = 7680;
constexpr int NE = 16, FF = 2752, FFP = 2816, FFL = 2880, CAP = 256, NFT = 22;
constexpr float EPS = 1e-6f;

constexpr size_t MiB = 1u << 20;
constexpr size_t WS_CTL = 0, CTL_ZERO_BYTES = 1 * MiB;
constexpr size_t CTL_ADA = 256 * 1024;
constexpr size_t WS_ROPE = 2 * MiB;
constexpr size_t WS_SEL = 3 * MiB;
constexpr size_t WS_AFF = 4 * MiB;
constexpr size_t WS_IDX = 5 * MiB;
constexpr size_t WS_WIN = 8 * MiB;
constexpr size_t WS_PA = 40 * MiB, WS_PB = 44 * MiB, WS_PC = 48 * MiB, WS_WOUT = 50 * MiB;
constexpr size_t WS_DFTC = 56 * MiB, WS_DFTS = 64 * MiB;
constexpr size_t WS_W13 = 72 * MiB;
constexpr size_t WS_W2 = 424 * MiB;
constexpr size_t WS_X = 608 * MiB;
constexpr size_t WS_H = 672 * MiB;
constexpr size_t WS_Q = 704 * MiB, WS_K = 736 * MiB, WS_V = 768 * MiB;
constexpr size_t WS_YT = 800 * MiB;
constexpr size_t WS_UV = 832 * MiB;
constexpr size_t WS_GATES = 864 * MiB;
constexpr size_t WS_AOUT = 960 * MiB, WS_BOUT = 992 * MiB, WS_COUT = 1024 * MiB;
constexpr size_t WS_T1 = 1040 * MiB, WS_MERGED = 1072 * MiB;
static_assert(WS_K - WS_Q == (32u << 20) && WS_V - WS_K == (32u << 20), "EpiWin: Q|K|V 32 MiB apart");
constexpr size_t WS_XIN = 704 * MiB;
constexpr size_t WS_HID = 768 * MiB;
constexpr size_t WS_Y = 952 * MiB;
constexpr size_t WS_T2 = 1104 * MiB;
constexpr size_t WS_END = 1136 * MiB;

__device__ __forceinline__ unsigned f2bf(float f) { unsigned u = __builtin_bit_cast(unsigned, f); return (u + 0x7fffu + ((u >> 16) & 1u)) >> 16; }
__device__ __forceinline__ unsigned pk2(float lo, float hi) { return f2bf(lo) | (f2bf(hi) << 16); }
__device__ __forceinline__ float bf2f(unsigned short b) { return __builtin_bit_cast(float, ((unsigned)b) << 16); }
__device__ __forceinline__ float wave_sum(float v) {
#pragma unroll
    for (int o = 1; o < 64; o <<= 1) v += __shfl_xor(v, o);
    return v;
}
__device__ __forceinline__ float sigmoid_f(float v) { return 1.0f / (1.0f + __expf(-v)); }
__device__ __forceinline__ float silu_f(float v) { return v / (1.0f + __expf(-v)); }
__device__ __forceinline__ float gelu_tanh_f(float v) {
    const float u = 0.7978845608028654f * (v + 0.044715f * v * v * v);
    const float e = __expf(2.0f * u);
    const float th = 1.0f - 2.0f / (e + 1.0f);
    return 0.5f * v * (1.0f + th);
}
__device__ inline void sincos_d(double x, double& s, double& c) {
    const double n = __builtin_rint(x * 0.63661977236758134308);
    double r = (x - n * 1.57079632673412561417e+00) - n * 6.07710050650619224932e-11;
    const double z = r * r;
    const double sp = r + r * z * (-1.66666666666666324348e-01 + z * (8.33333333332248946124e-03 + z * (-1.98412698298579493134e-04 + z * (2.75573137070700676789e-06 + z * (-2.50507602534068634195e-08 + z * 1.58969099521155010221e-10)))));
    const double cp = 1.0 - 0.5 * z + z * z * (4.16666666666666019037e-02 + z * (-1.38888888888741095749e-03 + z * (2.48015872894767294178e-05 + z * (-2.75573143513906633035e-07 + z * (2.08757232129817482790e-09 + z * -1.13596475577881948265e-11)))));
    const int q = ((int)n) & 3;
    s = (q == 0) ? sp : (q == 1) ? cp : (q == 2) ? -sp : -cp;
    c = (q == 0) ? cp : (q == 1) ? -sp : (q == 2) ? -cp : sp;
}

__device__ __forceinline__ void ada_item(int item, const float* c, const float* w_ada, const float* b_ada, float* ADA, LAS float* scr, int tid) {
    const int nc = item % 96, l = item / 96;
    LAS float* cact = scr; LAS float* part = scr + NB * DM;
    __syncthreads();
    for (int i = tid; i < NB * DM; i += 512) cact[i] = silu_f(c[i]);
    __syncthreads();
    { const int col = tid & 63, kp = tid >> 6; const int n = nc * 64 + col;
      float acc[NB];
#pragma unroll
      for (int b = 0; b < NB; ++b) acc[b] = 0.f;
      const float* wp = w_ada + ((size_t)l * DM + kp * 128) * 6144 + n;
      for (int k0 = 0; k0 < 128; k0 += 16) { float w[16];
#pragma unroll
          for (int i = 0; i < 16; ++i) w[i] = wp[(size_t)(k0 + i) * 6144];
#pragma unroll
          for (int i = 0; i < 16; ++i) {
#pragma unroll
              for (int b = 0; b < NB; ++b) acc[b] += cact[b * DM + kp * 128 + k0 + i] * w[i]; } }
#pragma unroll
      for (int b = 0; b < NB; ++b) part[(kp * NB + b) * 64 + col] = acc[b]; }
    __syncthreads();
    { const int col = tid & 63, b = tid >> 6; const int n = nc * 64 + col; float sum = b_ada[l * 6144 + n];
#pragma unroll
      for (int kp = 0; kp < 8; ++kp) sum += part[(kp * NB + b) * 64 + col];
      ADA[((size_t)l * NB + b) * 6144 + n] = sum; }
}
struct InvF { float v[8]; };
__device__ __forceinline__ void rope_entry(int idx, const int* positions, float* ROPE, const InvF& F) {
    const int t = idx >> 3, i = idx & 7;
    float invf = F.v[0];
#pragma unroll
    for (int q = 1; q < 8; ++q) invf = (i == q) ? F.v[q] : invf;
    const float ang = (float)positions[t] * invf;
    double s, c; sincos_d((double)ang, s, c);
    ROPE[t * 16 + i] = (float)c; ROPE[t * 16 + 8 + i] = (float)s;
}
__device__ __forceinline__ void dft_entry8(int idx, bf16_t* DFTC, bf16_t* DFTS) {
    const int m = idx >> 8, k0 = (idx & 255) * 8;
    unsigned cw[4], sw[4];
#pragma unroll
    for (int j = 0; j < 4; ++j) {
        float cv[2], sv[2];
#pragma unroll
        for (int e = 0; e < 2; ++e) { const int k = k0 + 2 * j + e; const int r = (m * k) & 2047; double s, c; sincos_d((double)r * (6.283185307179586476925 / 2048.0), s, c);
            cv[e] = (float)(c * (1.0 / 512.0)); sv[e] = (float)(-s * (1.0 / 512.0)); }
        cw[j] = pk2(cv[0], cv[1]); sw[j] = pk2(sv[0], sv[1]);
    }
    *(u32x4*)(DFTC + (size_t)m * 2048 + k0) = (u32x4){cw[0], cw[1], cw[2], cw[3]};
    *(u32x4*)(DFTS + (size_t)m * 2048 + k0) = (u32x4){sw[0], sw[1], sw[2], sw[3]};
}
__device__ __forceinline__ void transpose_tile(const float* __restrict__ src, size_t ldsrc, int k0, int n0, bf16_t* __restrict__ dst, size_t ldd, bf16_t* __restrict__ dst2, LAS float* scr, int lane) {
    f32x4 v[16];
#pragma unroll
    for (int i = 0; i < 16; ++i) v[i] = *(const f32x4*)(src + (size_t)(k0 + i * 4 + (lane >> 4)) * ldsrc + n0 + (lane & 15) * 4);
#pragma unroll
    for (int i = 0; i < 16; ++i) { LAS float* p = scr + (i * 4 + (lane >> 4)) * 65 + (lane & 15) * 4; p[0] = v[i][0]; p[1] = v[i][1]; p[2] = v[i][2]; p[3] = v[i][3]; }
    asm volatile("s_waitcnt lgkmcnt(0)" ::: "memory");
    const int c = lane & 7;
#pragma unroll
    for (int j = 0; j < 8; ++j) { const int n = (lane >> 3) + 8 * j; const LAS float* s = scr + (8 * c) * 65 + n;
        u32x4 o; o.x = pk2(s[0 * 65], s[1 * 65]); o.y = pk2(s[2 * 65], s[3 * 65]); o.z = pk2(s[4 * 65], s[5 * 65]); o.w = pk2(s[6 * 65], s[7 * 65]);
        *(u32x4*)(dst + (size_t)n * ldd + 8 * c) = o;
        if (dst2) *(u32x4*)(dst2 + (size_t)n * ldd + 8 * c) = o; }
    asm volatile("s_waitcnt lgkmcnt(0)" ::: "memory");
}
struct ConvPtrs { const float *w_in, *p_a, *p_b, *p_c, *w_out, *w1, *w3, *w2; unsigned char* ws; };
constexpr int CV_WIN = 16 * 112, CV_PA = 256, CV_PB = 128, CV_PC = 128, CV_WO = 256, CV_SMALL = CV_WIN + CV_PA + CV_PB + CV_PC + CV_WO;
constexpr int CV_EXP = 688 * 3, CV_LAYER = CV_SMALL + NE * CV_EXP, CV_TOTAL = NL * CV_LAYER;
__device__ __forceinline__ void conv_item(int it, const ConvPtrs& P, LAS float* scr, int lane) {
    const int l = it / CV_LAYER; int r = it % CV_LAYER;
    if (r < CV_WIN) { const int kt = r & 15; int nt = r >> 4; if (nt >= 48) nt += 8;
        const int n0 = nt * 64, drow = (n0 < 3072) ? n0 : n0 + 512;
        transpose_tile(P.w_in + (size_t)l * DM * NIN_SRC, NIN_SRC, kt * 64, n0, (bf16_t*)(P.ws + WS_WIN) + ((size_t)l * NIN + drow) * DM + kt * 64, DM, nullptr, scr, lane); return; }
    r -= CV_WIN;
    if (r < CV_PA) { const int kt = r & 15, nt = r >> 4;
        transpose_tile(P.p_a + (size_t)l * 1024 * 1024, 1024, kt * 64, nt * 64, (bf16_t*)(P.ws + WS_PA) + ((size_t)l * 1024 + nt * 64) * 1024 + kt * 64, 1024, nullptr, scr, lane); return; }
    r -= CV_PA;
    if (r < CV_PB) { const int kt = r & 7, nt = r >> 3;
        bf16_t* d = (bf16_t*)(P.ws + WS_PB) + ((size_t)l * 1024 + nt * 64) * 1024 + kt * 64;
        transpose_tile(P.p_b + (size_t)l * 512 * 1024, 1024, kt * 64, nt * 64, d, 1024, d + 512, scr, lane); return; }
    r -= CV_PB;
    if (r < CV_PC) { const int kt = r & 7, nt = r >> 3;
        transpose_tile(P.p_c + (size_t)l * 512 * 1024, 1024, kt * 64, nt * 64, (bf16_t*)(P.ws + WS_PC) + ((size_t)l * 1024 + nt * 64) * 512 + kt * 64, 512, nullptr, scr, lane); return; }
    r -= CV_PC;
    if (r < CV_WO) { const int kt = r & 15, nt = r >> 4;
        transpose_tile(P.w_out + (size_t)l * 1024 * 1024, 1024, kt * 64, nt * 64, (bf16_t*)(P.ws + WS_WOUT) + ((size_t)l * 1024 + nt * 64) * 1024 + kt * 64, 1024, nullptr, scr, lane); return; }
    r -= CV_WO;
    const int e = r / CV_EXP; r %= CV_EXP;
    const size_t le = (size_t)l * NE + e;
    if (r < 1376) { const int which = r / 688; r %= 688; const int kt = r & 15, nt = r >> 4;
        const int f0 = nt * 64, drow = (f0 >> 7) * 256 + which * 128 + (f0 & 127);
        transpose_tile((which ? P.w3 : P.w1) + le * DM * FF, FF, kt * 64, f0, (bf16_t*)(P.ws + WS_W13) + (le * (NFT * 256) + drow) * DM + kt * 64, DM, nullptr, scr, lane); return; }
    r -= 1376;
    { const int kt = r % 43, nt = r / 43;
        transpose_tile(P.w2 + le * FF * DM, DM, kt * 64, nt * 64, (bf16_t*)(P.ws + WS_W2) + (le * DM + nt * 64) * FFL + kt * 64, FFL, nullptr, scr, lane); }
}
typedef float f32x2_c __attribute__((ext_vector_type(2))); typedef __bf16 bf16x2_c __attribute__((ext_vector_type(2)));
__device__ __forceinline__ unsigned cvtpk_c(float lo, float hi) { f32x2_c v = {lo, hi}; bf16x2_c b = __builtin_convertvector(v, bf16x2_c); return __builtin_bit_cast(unsigned, b); }
struct TileDesc { const float* src; bf16_t* dst; bf16_t* dst2; unsigned ldsrc, ldd; };
__device__ __forceinline__ TileDesc conv_decode(int it, const ConvPtrs& P) {
    TileDesc d; d.dst2 = nullptr;
    const int l = it / CV_LAYER; int r = it % CV_LAYER;
    if (r < CV_WIN) { const int kt = r / 112; int nt = r % 112; if (nt >= 48) nt += 8;
        const int n0 = nt * 64, drow = (n0 < 3072) ? n0 : n0 + 512;
        d.src = P.w_in + ((size_t)l * DM + kt * 64) * NIN_SRC + n0; d.ldsrc = NIN_SRC; d.dst = (bf16_t*)(P.ws + WS_WIN) + ((size_t)l * NIN + drow) * DM + kt * 64; d.ldd = DM; return d; }
    r -= CV_WIN;
    if (r < CV_PA) { const int kt = r >> 4, nt = r & 15;
        d.src = P.p_a + ((size_t)l * 1024 + kt * 64) * 1024 + nt * 64; d.ldsrc = 1024; d.dst = (bf16_t*)(P.ws + WS_PA) + ((size_t)l * 1024 + nt * 64) * 1024 + kt * 64; d.ldd = 1024; return d; }
    r -= CV_PA;
    if (r < CV_PB) { const int kt = r >> 4, nt = r & 15;
        d.src = P.p_b + ((size_t)l * 512 + kt * 64) * 1024 + nt * 64; d.ldsrc = 1024; d.dst = (bf16_t*)(P.ws + WS_PB) + ((size_t)l * 1024 + nt * 64) * 1024 + kt * 64; d.dst2 = d.dst + 512; d.ldd = 1024; return d; }
    r -= CV_PB;
    if (r < CV_PC) { const int kt = r >> 4, nt = r & 15;
        d.src = P.p_c + ((size_t)l * 512 + kt * 64) * 1024 + nt * 64; d.ldsrc = 1024; d.dst = (bf16_t*)(P.ws + WS_PC) + ((size_t)l * 1024 + nt * 64) * 512 + kt * 64; d.ldd = 512; return d; }
    r -= CV_PC;
    if (r < CV_WO) { const int kt = r >> 4, nt = r & 15;
        d.src = P.w_out + ((size_t)l * 1024 + kt * 64) * 1024 + nt * 64; d.ldsrc = 1024; d.dst = (bf16_t*)(P.ws + WS_WOUT) + ((size_t)l * 1024 + nt * 64) * 1024 + kt * 64; d.ldd = 1024; return d; }
    r -= CV_WO;
    const int e = r / CV_EXP; r %= CV_EXP;
    const size_t le = (size_t)l * NE + e;
    if (r < 1376) { const int which = r / 688; r %= 688; const int kt = r / 43, nt = r % 43;
        const int f0 = nt * 64, drow = (f0 >> 7) * 256 + which * 128 + (f0 & 127);
        d.src = (which ? P.w3 : P.w1) + (le * DM + kt * 64) * FF + f0; d.ldsrc = FF; d.dst = (bf16_t*)(P.ws + WS_W13) + (le * (NFT * 256) + drow) * DM + kt * 64; d.ldd = DM; return d; }
    r -= 1376;
    { const int kt = r >> 4, nt = r & 15;
        d.src = P.w2 + (le * FF + kt * 64) * DM + nt * 64; d.ldsrc = DM; d.dst = (bf16_t*)(P.ws + WS_W2) + (le * DM + nt * 64) * FFL + kt * 64; d.ldd = FFL; return d; }
}
__device__ __forceinline__ void tile_load(const TileDesc& d, f32x4 (&v)[16], int lane) {
    const float* p = d.src + (size_t)(lane >> 4) * d.ldsrc + (lane & 15) * 4;
#pragma unroll
    for (int i = 0; i < 16; ++i) v[i] = *(const f32x4*)(p + (size_t)(i * 4) * d.ldsrc);
}
__device__ __forceinline__ void tile_store(const TileDesc& d, const f32x4 (&v)[16], LAS float* scr, int lane) {
#pragma unroll
    for (int i = 0; i < 16; ++i) { LAS float* p = scr + (i * 4 + (lane >> 4)) * 65 + (lane & 15) * 4; p[0] = v[i][0]; p[1] = v[i][1]; p[2] = v[i][2]; p[3] = v[i][3]; }
    asm volatile("s_waitcnt lgkmcnt(0)" ::: "memory");
    const int c = lane & 7;
#pragma unroll
    for (int j = 0; j < 8; ++j) { const int n = (lane >> 3) + 8 * j; const LAS float* s = scr + (8 * c) * 65 + n;
        u32x4 o; o.x = cvtpk_c(s[0 * 65], s[1 * 65]); o.y = cvtpk_c(s[2 * 65], s[3 * 65]); o.z = cvtpk_c(s[4 * 65], s[5 * 65]); o.w = cvtpk_c(s[6 * 65], s[7 * 65]);
        *(u32x4*)(d.dst + (size_t)n * d.ldd + 8 * c) = o;
        if (d.dst2) *(u32x4*)(d.dst2 + (size_t)n * d.ldd + 8 * c) = o; }
    asm volatile("s_waitcnt lgkmcnt(0)" ::: "memory");
}
constexpr int PAD_CH_W13 = 128 * 128, PAD_CH_W2 = 1024 * 8, PAD_CH = PAD_CH_W13 + PAD_CH_W2;
__device__ __forceinline__ void pad_chunk(size_t idx, unsigned char* ws) {
    const size_t le = idx / PAD_CH; const int r = (int)(idx % PAD_CH);
    const u32x4 z = {0u, 0u, 0u, 0u};
    if (r < PAD_CH_W13) { const int row = r >> 7, ch = r & 127; const int drow = 21 * 256 + ((row < 64) ? 64 + row : 192 + (row - 64));
        *(u32x4*)((bf16_t*)(ws + WS_W13) + (le * (NFT * 256) + drow) * DM + ch * 8) = z; }
    else { const int q = r - PAD_CH_W13; const int row = q >> 3, ch = q & 7;
        *(u32x4*)((bf16_t*)(ws + WS_W2) + (le * DM + row) * FFL + FF + ch * 8) = z; }
}
__device__ __forceinline__ void fold_item(int item, const float* w_in, bf16_t* WIN, LAS float* scr, int tid) {
    const int kc = item & 15, g = (item >> 4) & 3, l = item >> 6;
    LAS float* wt = scr; LAS float* tc = scr + 64 * 129; LAS float* ts = tc + 128;
    __syncthreads();
    for (int i = tid; i < 64 * 128; i += 512) { const int kk = i >> 7, c = i & 127; wt[kk * 129 + c] = w_in[((size_t)l * DM + kc * 64 + kk) * NIN_SRC + 3072 + g * 128 + c]; }
    if (tid < 128) { double s, c; sincos_d((double)tid * (6.283185307179586476925 / 128.0), s, c); tc[tid] = (float)c; ts[tid] = (float)s; }
    __syncthreads();
    const int kk = tid & 63, og = tid >> 6;
    for (int oo = 0; oo < 32; ++oo) { const int o = og * 32 + oo, part = o >> 7, cp = o & 127;
        float acc = 0.f;
        for (int c = 0; c < 128; ++c) { const int j = (c * cp) & 127; acc += wt[kk * 129 + c] * (part ? ts[j] : tc[j]); }
        WIN[((size_t)l * NIN + 3072 + g * 256 + o) * DM + kc * 64 + kk] = (bf16_t)f2bf(acc); }
}

namespace pg8 {
#define PG8_LAS __attribute__((address_space(3)))
typedef unsigned short bf16_t;
typedef short bf16x8 __attribute__((ext_vector_type(8)));
typedef float f32x4 __attribute__((ext_vector_type(4)));
typedef unsigned u32x4 __attribute__((ext_vector_type(4)));
constexpr int BM = 256, BK = 64, HALF = 128, HTB = HALF * BK * 2  , STAGE_BYTES = 8 * HTB, NXCD = 8, WGM = 8;

__host__ __device__ __forceinline__ int lds_byte(int r, int c) { const int st = (r >> 4) * 2 + (c >> 5), rr = r & 15, cc = c & 31, ob = rr * 64 + cc * 2; return st * 1024 + (ob ^ (((ob >> 9) & 1) << 5)); }
__host__ __device__ __forceinline__ void stage_rc(int b, int& R, int& C) { const int st = b / 1024, sb = b % 1024, swz = sb ^ (((sb >> 9) & 1) << 5); R = (st >> 1) * 16 + swz / 64; C = (st & 1) * 32 + (swz % 64) / 2; }
__host__ __device__ __forceinline__ int perm32(int rho) { const int n = rho >> 4, i = rho & 15; return 8 * (i >> 2) + 4 * n + (i & 3); }

struct Unit { int pm, pn; };
struct Gemm { const bf16_t* A; const bf16_t* Bt; int M, N, K, ld; };

struct StaticOrder {
    int nM, nN, nwg, G, c, rev;
    __host__ __device__ void init(int M, int N, int G_, int c_) { nM = M / BM; nN = N / BM; nwg = nM * nN; G = G_; c = c_; rev = 0; }
    __host__ __device__ bool next(int i, Unit& u) const {
        const long L = (long)i * G + c; if (L >= nwg) return false;
        int wgid = (int)L; { const int q = nwg / NXCD, r = nwg % NXCD, xcd = wgid % NXCD, off = wgid / NXCD; wgid = (xcd < r ? xcd * (q + 1) : r * (q + 1) + (xcd - r) * q) + off; }
        const int nig = WGM * nN, gid = wgid / nig, fm = gid * WGM, gsz = (nM - fm) < WGM ? (nM - fm) : WGM;
        u.pm = fm + ((wgid % nig) % gsz); u.pn = (wgid % nig) / gsz;
        if (rev) u.pn = nN - 1 - u.pn;
        return true;
    }
    __device__ __forceinline__ void a_ready(const Unit&) const {}
    __device__ __forceinline__ void done(const Unit&) const {}
};

typedef float f32x2_t __attribute__((ext_vector_type(2))); typedef __bf16 bf16x2_t __attribute__((ext_vector_type(2)));
__device__ __forceinline__ unsigned cvt_pk_bf16(float lo, float hi) { f32x2_t v = {lo, hi}; bf16x2_t b = __builtin_convertvector(v, bf16x2_t); return __builtin_bit_cast(unsigned, b); }
__device__ __forceinline__ float fast_sigmoid(float v) { return __builtin_amdgcn_rcpf(1.0f + __builtin_amdgcn_exp2f(-1.4426950408889634f * v)); }
__device__ __forceinline__ float fast_gelu_tanh(float v) { return v * __builtin_amdgcn_rcpf(1.0f + __builtin_amdgcn_exp2f(-2.3022082f * (v + 0.044715f * v * v * v))); }
__device__ __forceinline__ u32x4 pack8(const f32x4& v0, const f32x4& v1) { u32x4 w; w.x = cvt_pk_bf16(v0[0], v0[1]); w.y = cvt_pk_bf16(v0[2], v0[3]); w.z = cvt_pk_bf16(v1[0], v1[1]); w.w = cvt_pk_bf16(v1[2], v1[3]); return w; }
__device__ __forceinline__ void unpack8(const u32x4& w, f32x4& v0, f32x4& v1) {
    v0[0] = __builtin_bit_cast(float, w.x << 16); v0[1] = __builtin_bit_cast(float, w.x & 0xffff0000u); v0[2] = __builtin_bit_cast(float, w.y << 16); v0[3] = __builtin_bit_cast(float, w.y & 0xffff0000u);
    v1[0] = __builtin_bit_cast(float, w.z << 16); v1[1] = __builtin_bit_cast(float, w.z & 0xffff0000u); v1[2] = __builtin_bit_cast(float, w.w << 16); v1[3] = __builtin_bit_cast(float, w.w & 0xffff0000u); }

struct GroupOrder {
    int nM, nN, per, nwg, G, c, amode;
    __host__ __device__ void init(int Z, int nM_, int nN_, int G_, int c_, int amode_) { nM = nM_; nN = nN_; per = nM * nN; nwg = Z * per; G = G_; c = c_; amode = amode_; }
    __host__ __device__ bool next(int i, Unit& u) const {
        const long L = (long)i * G + c; if (L >= nwg) return false;
        int wgid = (int)L; { const int q = nwg / NXCD, r = nwg % NXCD, xcd = wgid % NXCD, off = wgid / NXCD; wgid = (xcd < r ? xcd * (q + 1) : r * (q + 1) + (xcd - r) * q) + off; }
        const int z = wgid / per, rr = wgid % per;
        const int nig = WGM * nN, gid = rr / nig, fm = gid * WGM, gsz = (nM - fm) < WGM ? (nM - fm) : WGM;
        const int pml = fm + ((rr % nig) % gsz), pnl = (rr % nig) / gsz;
        u.pm = (amode ? (z & 1) : z) * nM + pml; u.pn = z * nN + pnl; return true;
    }
    __device__ __forceinline__ void a_ready(const Unit&) const {}
    __device__ __forceinline__ void done(const Unit&) const {}
};

struct EpiWin {
    static constexpr bool PERM = true, AFTER_DRAIN = false;
    bf16_t *Q, *YT, *UV, *GATES; const float* ROPE; PG8_LAS unsigned char* lds;
    __device__ __forceinline__ void operator()(const f32x4 (&acc)[2][2][4][2], const Unit& u, int wr, int wc, int fr, int fq) const {
        const int row0 = u.pm * BM + wr * 64 + fr, pn = u.pn;
#if (WIN_DBG & 0x6F) != 0x6F
        { const int br = pn < 4 ? 0 : (pn < 8 ? 5 : (pn < 12 ? 6 : (pn < 16 ? 1 : (pn < 20 ? 2 : 3)))); if (!((WIN_DBG >> br) & 1)) return; }
#endif
        if (pn < 12) {
            bf16_t* base = Q + (size_t)(pn >> 2) * (size_t)(16u << 20) + (pn & 3) * 256 + wc * 32 + 8 * fq;
            const bool rope = (pn < 8) && ((wc & 1) == 0) && !((WIN_DBG >> 4) & 1);
            const float sgn = (fq == 0) ? -1.f : 1.f;
            const bool ld = rope && fq < 2;
            f32x4 nc0 = {1.f, 1.f, 1.f, 1.f}, nc1 = nc0, ns0 = {0.f, 0.f, 0.f, 0.f}, ns1 = ns0;
            if (ld) { const f32x4* rp = (const f32x4*)(ROPE + (size_t)row0 * 16); nc0 = rp[0]; nc1 = rp[1]; ns0 = rp[2]; ns1 = rp[3]; }
#pragma unroll
            for (int c = 0; c < 8; ++c) { const int ai = c >> 2, m = c & 3; const int row = row0 + ai * HALF + m * 16;
                f32x4 cs0 = nc0, cs1 = nc1, sn0 = ns0 * sgn, sn1 = ns1 * sgn;
                if (ld && c + 1 < 8) { const int c2 = c + 1; const f32x4* rp = (const f32x4*)(ROPE + (size_t)(row0 + (c2 >> 2) * HALF + (c2 & 3) * 16) * 16); nc0 = rp[0]; nc1 = rp[1]; ns0 = rp[2]; ns1 = rp[3]; }
#pragma unroll
                for (int bj = 0; bj < 2; ++bj) { f32x4 v0 = acc[ai][bj][m][0], v1 = acc[ai][bj][m][1];
                    if (rope) { f32x4 p0, p1;
#pragma unroll
                        for (int j = 0; j < 4; ++j) { p0[j] = __shfl_xor(v0[j], 16); p1[j] = __shfl_xor(v1[j], 16); }
                        v0 = v0 * cs0 + p0 * sn0; v1 = v1 * cs1 + p1 * sn1; }
                    *(u32x4*)(base + (size_t)row * 1024 + bj * HALF) = pack8(v0, v1); } }
        } else if (pn < 16) {
            const int g = pn - 12, b = u.pm >> 3, lane = fq * 16 + fr;
            PG8_LAS unsigned char* p0 = lds + 3 * HTB + (wr * 4 + wc) * 1024;
            PG8_LAS unsigned short* wb = (PG8_LAS unsigned short*)(p0 + (fq >> 1) * 8192) + (8 * (fq & 1)) * 32 + fr;
            const PG8_LAS u32x4* rb = (const PG8_LAS u32x4*)p0 + lane;
#pragma unroll
            for (int bj = 0; bj < 2; ++bj) { bf16_t* yb = YT + ((size_t)(b * 2 + bj) * 512 + g * 128 + wc * 32 + (lane >> 2)) * 2048 + (u.pm & 7) * BM + wr * 64 + (lane & 3) * 8;
#pragma unroll
                for (int ai = 0; ai < 2; ++ai)
#pragma unroll
                    for (int mh = 0; mh < 2; ++mh) {
#pragma unroll
                        for (int mm = 0; mm < 2; ++mm)
#pragma unroll
                            for (int n = 0; n < 2; ++n) { const int m = 2 * mh + mm; const unsigned w0 = cvt_pk_bf16(acc[ai][bj][m][n][0], acc[ai][bj][m][n][1]), w1 = cvt_pk_bf16(acc[ai][bj][m][n][2], acc[ai][bj][m][n][3]);
                                PG8_LAS unsigned short* p = wb + (4 * n) * 32 + mm * 16;
                                p[0] = (unsigned short)(w0 & 0xffffu); p[32] = (unsigned short)(w0 >> 16); p[64] = (unsigned short)(w1 & 0xffffu); p[96] = (unsigned short)(w1 >> 16); }
                        const u32x4 r0 = rb[0], r1 = rb[512];
                        bf16_t* d = yb + ai * HALF + mh * 32;
                        *(u32x4*)d = r0; *(u32x4*)(d + (size_t)16 * 2048) = r1; } }
        } else if (pn < 20) {
            bf16_t* base = UV + (pn - 16) * 256 + wc * 32 + 8 * fq;
#pragma unroll
            for (int ai = 0; ai < 2; ++ai)
#pragma unroll
                for (int m = 0; m < 4; ++m) { const int row = row0 + ai * HALF + m * 16;
#pragma unroll
                    for (int bj = 0; bj < 2; ++bj) { f32x4 v0 = acc[ai][bj][m][0], v1 = acc[ai][bj][m][1];
#pragma unroll
                        for (int j = 0; j < 4; ++j) { v0[j] = fast_gelu_tanh(v0[j]); v1[j] = fast_gelu_tanh(v1[j]); }
                        *(u32x4*)(base + (size_t)row * 1024 + bj * HALF) = pack8(v0, v1); } }
        } else {
            bf16_t* base = GATES + (pn - 20) * 256 + wc * 32 + 8 * fq;
#pragma unroll
            for (int ai = 0; ai < 2; ++ai)
#pragma unroll
                for (int m = 0; m < 4; ++m) { const int row = row0 + ai * HALF + m * 16;
#pragma unroll
                    for (int bj = 0; bj < 2; ++bj) { f32x4 v0 = acc[ai][bj][m][0], v1 = acc[ai][bj][m][1];
#pragma unroll
                        for (int j = 0; j < 4; ++j) { v0[j] = fast_sigmoid(v0[j]); v1[j] = fast_sigmoid(v1[j]); }
                        __builtin_nontemporal_store(pack8(v0, v1), (u32x4*)(base + (size_t)row * 3072 + bj * HALF)); } }
        }
    }
};
struct EpiDft {
    static constexpr bool PERM = true, AFTER_DRAIN = false;
    bf16_t* BOUT;
    __device__ __forceinline__ void operator()(const f32x4 (&acc)[2][2][4][2], const Unit& u, int wr, int wc, int fr, int fq) const {
        const int part = u.pm >> 3, mt = u.pm & 7, b = u.pn >> 2, nt = u.pn & 1;
        bf16_t* base = BOUT + ((size_t)b * 2048 + mt * BM + wr * 64 + fr) * 1024 + part * 512 + nt * 256 + wc * 32 + 8 * fq;
#pragma unroll
        for (int ai = 0; ai < 2; ++ai)
#pragma unroll
            for (int m = 0; m < 4; ++m)
#pragma unroll
                for (int bj = 0; bj < 2; ++bj) *(u32x4*)(base + (size_t)(ai * HALF + m * 16) * 1024 + bj * HALF) = pack8(acc[ai][bj][m][0], acc[ai][bj][m][1]);
    }
};
template <int WHICH> struct EpiProj {
    static constexpr bool PERM = true, AFTER_DRAIN = false;
    const bf16_t* GATES; bf16_t* T1; bf16_t* T2; bf16_t* OUT;
    struct Ld { u32x4 ga, gb, gc, t1, t2; };
    __device__ __forceinline__ Ld load(size_t row, int col) const { Ld r; const bf16_t* g = GATES + row * 3072 + col; r.ga = *(const u32x4*)g; r.gb = *(const u32x4*)(g + 1024); r.gc = *(const u32x4*)(g + 2048);
        r.t1 = *(const u32x4*)(T1 + row * 1024 + col); r.t2 = *(const u32x4*)(T2 + row * 1024 + col); return r; }
    __device__ __forceinline__ void operator()(const f32x4 (&acc)[2][2][4][2], const Unit& u, int wr, int wc, int fr, int fq) const {
        const int row0 = u.pm * BM + wr * 64 + fr, col0 = u.pn * BM + wc * 32 + 8 * fq;
        if (WHICH < 2) {
            bf16_t* dst = (WHICH == 0 ? T1 : T2);
#pragma unroll
            for (int ai = 0; ai < 2; ++ai)
#pragma unroll
                for (int m = 0; m < 4; ++m)
#pragma unroll
                    for (int bj = 0; bj < 2; ++bj) *(u32x4*)(dst + (size_t)(row0 + ai * HALF + m * 16) * 1024 + col0 + bj * HALF) = pack8(acc[ai][bj][m][0], acc[ai][bj][m][1]);
        } else {
            Ld cur = load((size_t)row0, col0), nx1 = load((size_t)row0, col0 + HALF);
#pragma unroll
            for (int c = 0; c < 16; ++c) { const int ai = c >> 3, m = (c >> 1) & 3, bj = c & 1;
                const size_t row = (size_t)(row0 + ai * HALF + m * 16); const int col = col0 + bj * HALF;
                Ld nx2 = nx1;
                if (c + 2 < 16) { const int c2 = c + 2, ai2 = c2 >> 3, m2 = (c2 >> 1) & 3, bj2 = c2 & 1; nx2 = load((size_t)(row0 + ai2 * HALF + m2 * 16), col0 + bj2 * HALF); }
                f32x4 a0, a1, b0, b1, c0, c1, p0, p1, q0, q1;
                unpack8(cur.ga, a0, a1); unpack8(cur.gb, b0, b1); unpack8(cur.gc, c0, c1); unpack8(cur.t1, p0, p1); unpack8(cur.t2, q0, q1);
                const f32x4 v0 = a0 * p0 + b0 * q0 + c0 * acc[ai][bj][m][0], v1 = a1 * p1 + b1 * q1 + c1 * acc[ai][bj][m][1];
                *(u32x4*)(OUT + row * 1024 + col) = pack8(v0, v1);
                cur = nx1; nx1 = nx2; }
        }
    }
};
struct EpiWout {
    static constexpr bool PERM = false, AFTER_DRAIN = false;
    const float* Xin; float* Xout; const float* gt;
    __device__ __forceinline__ void operator()(const f32x4 (&acc)[2][2][4][2], const Unit& u, int wr, int wc, int fr, int fq) const {
        const int row0 = u.pm * BM + wr * 64 + fr, col0 = u.pn * BM + wc * 32 + 4 * fq, b = u.pm >> 3;
        f32x4 gv[2][2];
#pragma unroll
        for (int bj = 0; bj < 2; ++bj)
#pragma unroll
            for (int n = 0; n < 2; ++n) gv[bj][n] = *(const f32x4*)(gt + b * 6144 + col0 + bj * HALF + n * 16);
#pragma unroll
        for (int ai = 0; ai < 2; ++ai)
#pragma unroll
            for (int mh = 0; mh < 2; ++mh) { f32x4 xv[2][2][2];
#pragma unroll
                for (int mm = 0; mm < 2; ++mm)
#pragma unroll
                    for (int bj = 0; bj < 2; ++bj)
#pragma unroll
                        for (int n = 0; n < 2; ++n) xv[mm][bj][n] = *(const f32x4*)(Xin + (size_t)(row0 + ai * HALF + (mh * 2 + mm) * 16) * 1024 + col0 + bj * HALF + n * 16);
#pragma unroll
                for (int mm = 0; mm < 2; ++mm)
#pragma unroll
                    for (int bj = 0; bj < 2; ++bj)
#pragma unroll
                        for (int n = 0; n < 2; ++n) *(f32x4*)(Xout + (size_t)(row0 + ai * HALF + (mh * 2 + mm) * 16) * 1024 + col0 + bj * HALF + n * 16) = xv[mm][bj][n] + gv[bj][n] * acc[ai][bj][mh * 2 + mm][n]; }
    }
};
struct EpiG1 {
    static constexpr bool PERM = true, AFTER_DRAIN = false;
    bf16_t* HID;
    __device__ __forceinline__ void operator()(const f32x4 (&acc)[2][2][4][2], const Unit& u, int wr, int wc, int fr, int fq) const {
        const int ft = u.pn % 22;
        bf16_t* base = HID + ((size_t)u.pm * BM + wr * 64 + fr) * FFL + ft * 128 + wc * 32 + 8 * fq;
#pragma unroll
        for (int ai = 0; ai < 2; ++ai)
#pragma unroll
            for (int m = 0; m < 4; ++m) { f32x4 h0, h1;
#pragma unroll
                for (int j = 0; j < 4; ++j) { const float a0 = acc[ai][0][m][0][j], a1 = acc[ai][0][m][1][j]; h0[j] = a0 * fast_sigmoid(a0) * acc[ai][1][m][0][j]; h1[j] = a1 * fast_sigmoid(a1) * acc[ai][1][m][1][j]; }
                *(u32x4*)(base + (size_t)(ai * HALF + m * 16) * FFL) = pack8(h0, h1); }
    }
};
struct EpiG2 {
    static constexpr bool PERM = true, AFTER_DRAIN = false;
    bf16_t* YB;
    __device__ __forceinline__ void operator()(const f32x4 (&acc)[2][2][4][2], const Unit& u, int wr, int wc, int fr, int fq) const {
        bf16_t* base = YB + ((size_t)u.pm * BM + wr * 64 + fr) * 1024 + (u.pn & 3) * 256 + wc * 32 + 8 * fq;
#pragma unroll
        for (int ai = 0; ai < 2; ++ai)
#pragma unroll
            for (int m = 0; m < 4; ++m)
#pragma unroll
                for (int bj = 0; bj < 2; ++bj) *(u32x4*)(base + (size_t)(ai * HALF + m * 16) * 1024 + bj * HALF) = pack8(acc[ai][bj][m][0], acc[ai][bj][m][1]);
    }
};
template <class Epi, class Sched, bool ALIGN_EPI = false, bool SP2 = false>
__device__ __forceinline__ void gemm_phase(PG8_LAS unsigned char* lds, const Gemm g, const Sched& S, const Epi& E) {
    int tid_l = threadIdx.x; asm volatile("" : "+v"(tid_l));
    const int tid = tid_l, wid = __builtin_amdgcn_readfirstlane(tid >> 6), lane = tid & 63, wr = wid >> 2, wc = wid & 3, fr = lane & 15, fq = lane >> 4;
    const int K = g.K, nt = K / BK, LD = g.ld ? g.ld : K;
    unsigned voffA[2], voffB[2];
#pragma unroll
    for (int i = 0; i < 2; ++i) { int R, C; stage_rc(tid * 16 + i * 8192, R, C); const int Rb = Epi::PERM ? ((R & ~31) + perm32(R & 31)) : R;
        voffA[i] = (unsigned)(R * LD + C) * 2u; voffB[i] = (unsigned)(Rb * LD + C) * 2u; }
    const size_t kstep = (size_t)(BK * 2);
    const size_t hstep = (size_t)HALF * LD * 2;
    const size_t tstep = 2 * hstep;
    const unsigned ldsw = (unsigned)wid * 1024u;
    const int aoff = lds_byte(wr * 64 + fr, fq * 8), boff = lds_byte(wc * 32 + fr, fq * 8);
#define PG8_SA(b, h) (((b) * 2 + (h)) * HTB)
#define PG8_SB(b, h) ((4 + (b) * 2 + (h)) * HTB)
#define PG8_STAGE(bufoff, gbase, voff) do { _Pragma("unroll") for (int _i = 0; _i < 2; ++_i) \
        __builtin_amdgcn_global_load_lds((const unsigned*)((const char*)(gbase) + (voff)[_i]), (PG8_LAS unsigned*)(lds + (bufoff) + ldsw + _i * 8192), 16, 0, 0); } while (0)
#define PG8_LDA(dst, b, h) do { _Pragma("unroll") for (int m = 0; m < 4; ++m) _Pragma("unroll") for (int k = 0; k < 2; ++k) dst[m][k] = *(const PG8_LAS bf16x8*)(lds + PG8_SA(b, h) + aoff + m * 2048 + k * 1024); } while (0)
#define PG8_LDB(dst, b, h) do { _Pragma("unroll") for (int n = 0; n < 2; ++n) _Pragma("unroll") for (int k = 0; k < 2; ++k) dst[n][k] = *(const PG8_LAS bf16x8*)(lds + PG8_SB(b, h) + boff + n * 2048 + k * 1024); } while (0)
#define PG8_MMA(ai, bj, At, Bt) do { __builtin_amdgcn_s_setprio(1); _Pragma("unroll") for (int m = 0; m < 4; ++m) _Pragma("unroll") for (int n = 0; n < 2; ++n) _Pragma("unroll") for (int k = 0; k < 2; ++k) \
        acc[ai][bj][m][n] = __builtin_amdgcn_mfma_f32_16x16x32_bf16(Bt[n][k], At[m][k], acc[ai][bj][m][n], 0, 0, 0); __builtin_amdgcn_s_setprio(0); } while (0)
#define PG8_WAIT_V(n) asm volatile("s_waitcnt vmcnt(" #n ")" ::: "memory")
#define PG8_WAIT_L(n) asm volatile("s_waitcnt lgkmcnt(" #n ")" ::: "memory")
#define PG8_BAR __builtin_amdgcn_s_barrier()
#define PG8_SCHED __builtin_amdgcn_sched_barrier(0)
    Unit cur, nxt; int ui = 0;
    if (!S.next(0, cur)) return;
    f32x4 acc[2][2][4][2];
#pragma unroll
    for (int a = 0; a < 2; ++a)
#pragma unroll
        for (int b = 0; b < 2; ++b)
#pragma unroll
            for (int m = 0; m < 4; ++m)
#pragma unroll
                for (int n = 0; n < 2; ++n) acc[a][b][m][n] = (f32x4){0.f, 0.f, 0.f, 0.f};
    bf16x8 At[4][2], B0[2][2], B1[2][2];
    const char* cA = (const char*)g.A + (size_t)cur.pm * tstep; const char* cB = (const char*)g.Bt + (size_t)cur.pn * tstep;
    S.a_ready(cur);
    if constexpr (SP2) {
        PG8_STAGE(PG8_SB(0, 0), cB, voffB); PG8_STAGE(PG8_SB(0, 1), cB + hstep, voffB); PG8_STAGE(PG8_SA(0, 0), cA, voffA); PG8_STAGE(PG8_SA(0, 1), cA + hstep, voffA);
        if (wr == 1) PG8_BAR;
        PG8_WAIT_V(2); PG8_BAR;
        PG8_STAGE(PG8_SB(1, 0), cB + kstep, voffB); PG8_STAGE(PG8_SA(1, 0), cA + kstep, voffA); PG8_STAGE(PG8_SB(1, 1), cB + hstep + kstep, voffB);
        PG8_WAIT_V(6); PG8_BAR;
    } else {
        PG8_STAGE(PG8_SB(0, 0), cB, voffB); PG8_STAGE(PG8_SA(0, 0), cA, voffA); PG8_STAGE(PG8_SB(0, 1), cB + hstep, voffB); PG8_STAGE(PG8_SA(0, 1), cA + hstep, voffA);
        if (wr == 1) PG8_BAR;
        PG8_WAIT_V(4); PG8_BAR;
        PG8_STAGE(PG8_SB(1, 0), cB + kstep, voffB); PG8_STAGE(PG8_SA(1, 0), cA + kstep, voffA); PG8_STAGE(PG8_SB(1, 1), cB + hstep + kstep, voffB);
        PG8_WAIT_V(6); PG8_BAR;
    }
    for (;;) {
        const bool has_next = S.next(ui + 1, nxt);
        const char* nA = has_next ? (const char*)g.A + (size_t)nxt.pm * tstep : cA; const char* nB = has_next ? (const char*)g.Bt + (size_t)nxt.pn * tstep : cB;
        for (int t = 0; t < nt; t += 2) {
            const bool last = (t == nt - 2);
            const char* a1 = cA + (size_t)(t + 1) * kstep;
            const char* a2 = last ? nA : cA + (size_t)(t + 2) * kstep; const char* b2 = last ? nB : cB + (size_t)(t + 2) * kstep;
            const char* a3 = a2 + kstep; const char* b3 = b2 + kstep;
            if (last && has_next) S.a_ready(nxt);
            if constexpr (SP2) {
            PG8_LDB(B0, 0, 0); PG8_LDB(B1, 0, 1); PG8_SCHED; PG8_LDA(At, 0, 0); PG8_STAGE(PG8_SA(1, 1), a1 + hstep, voffA);
            PG8_WAIT_V(8); PG8_WAIT_L(0); PG8_BAR; PG8_MMA(0, 0, At, B0); PG8_MMA(0, 1, At, B1); PG8_BAR; PG8_SCHED;
            PG8_LDA(At, 0, 1); PG8_STAGE(PG8_SB(0, 0), b2, voffB); PG8_STAGE(PG8_SB(0, 1), b2 + hstep, voffB); PG8_STAGE(PG8_SA(0, 0), a2, voffA);
            PG8_WAIT_V(8); PG8_WAIT_L(0); PG8_BAR; PG8_MMA(1, 0, At, B0); PG8_MMA(1, 1, At, B1); PG8_BAR; PG8_SCHED;
            PG8_LDB(B0, 1, 0); PG8_LDB(B1, 1, 1); PG8_SCHED; PG8_LDA(At, 1, 0); PG8_STAGE(PG8_SA(0, 1), a2 + hstep, voffA);
            PG8_WAIT_V(8); PG8_WAIT_L(0); PG8_BAR; PG8_MMA(0, 0, At, B0); PG8_MMA(0, 1, At, B1); PG8_BAR; PG8_SCHED;
            PG8_LDA(At, 1, 1); PG8_STAGE(PG8_SB(1, 0), b3, voffB); PG8_STAGE(PG8_SB(1, 1), b3 + hstep, voffB); PG8_STAGE(PG8_SA(1, 0), a3, voffA);
            PG8_WAIT_V(8); PG8_WAIT_L(0); PG8_BAR; PG8_MMA(1, 0, At, B0); PG8_MMA(1, 1, At, B1); PG8_BAR; PG8_SCHED;
            } else {
            PG8_LDB(B0, 0, 0); PG8_SCHED; PG8_LDA(At, 0, 0); PG8_STAGE(PG8_SA(1, 1), a1 + hstep, voffA);
            PG8_WAIT_L(8); PG8_BAR; PG8_WAIT_L(0); PG8_MMA(0, 0, At, B0); PG8_BAR; PG8_SCHED;
            PG8_LDB(B1, 0, 1); PG8_STAGE(PG8_SB(0, 0), b2, voffB);
            PG8_BAR; PG8_WAIT_L(0); PG8_MMA(0, 1, At, B1); PG8_BAR;
            PG8_LDA(At, 0, 1); PG8_STAGE(PG8_SA(0, 0), a2, voffA);
            PG8_BAR; PG8_WAIT_L(0); PG8_MMA(1, 0, At, B0); PG8_BAR; PG8_SCHED;
            PG8_STAGE(PG8_SB(0, 1), b2 + hstep, voffB);
            PG8_WAIT_V(6); PG8_BAR; PG8_MMA(1, 1, At, B1); PG8_BAR;
            PG8_LDB(B0, 1, 0); PG8_SCHED; PG8_LDA(At, 1, 0); PG8_STAGE(PG8_SA(0, 1), a2 + hstep, voffA);
            PG8_WAIT_L(8); PG8_BAR; PG8_WAIT_L(0); PG8_MMA(0, 0, At, B0); PG8_BAR; PG8_SCHED;
            PG8_LDB(B1, 1, 1); PG8_STAGE(PG8_SB(1, 0), b3, voffB);
            PG8_BAR; PG8_WAIT_L(0); PG8_MMA(0, 1, At, B1); PG8_BAR;
            PG8_LDA(At, 1, 1); PG8_STAGE(PG8_SA(1, 0), a3, voffA);
            PG8_BAR; PG8_WAIT_L(0); PG8_MMA(1, 0, At, B0); PG8_BAR; PG8_SCHED;
            PG8_STAGE(PG8_SB(1, 1), b3 + hstep, voffB);
            PG8_WAIT_V(6); PG8_BAR; PG8_MMA(1, 1, At, B1); PG8_BAR;
            }
        }
        if constexpr (ALIGN_EPI) { if (wr == 0) PG8_BAR; }
        if constexpr (!Epi::AFTER_DRAIN) { int tz = threadIdx.x; asm volatile("" : "+v"(tz));
            const int lz = tz & 63; E(acc, cur, wr, wc, lz & 15, lz >> 4); S.done(cur); }
        if (!has_next) break;
#pragma unroll
        for (int a = 0; a < 2; ++a)
#pragma unroll
            for (int b = 0; b < 2; ++b)
#pragma unroll
                for (int m = 0; m < 4; ++m)
#pragma unroll
                    for (int n = 0; n < 2; ++n) acc[a][b][m][n] = (f32x4){0.f, 0.f, 0.f, 0.f};
        cur = nxt; cA = nA; cB = nB; ++ui;
        if constexpr (ALIGN_EPI) { if (wr == 1) PG8_BAR; }
    }
    PG8_WAIT_V(0);
    if constexpr (!ALIGN_EPI) { if (wr == 0) PG8_BAR; }
    PG8_BAR;
    if constexpr (Epi::AFTER_DRAIN) { E.fused(acc, cur, wr, wc, fr, fq, lds, wid, lane); S.done(cur); }
#undef PG8_SA
#undef PG8_SB
#undef PG8_STAGE
#undef PG8_LDA
#undef PG8_LDB
#undef PG8_MMA
#undef PG8_WAIT_V
#undef PG8_WAIT_L
#undef PG8_BAR
#undef PG8_SCHED
}
}
namespace att {
using bf16 = unsigned short;
constexpr int QBLK = 32, KVBLK = 64, LDR = 1024, NKT = 2048 / KVBLK;
constexpr float SCALE = 0.125f, THR = 8.f;
constexpr int SHM_V = KVBLK * 128 * 2, SHM_K = KVBLK * 128 * 2, LDS_BYTES = 2 * SHM_V + 2 * SHM_K + 8 * 64 * 4;
using bf16x8 = __attribute__((ext_vector_type(8))) short;
using s16x4  = __attribute__((ext_vector_type(4))) short;
using f32x16 = __attribute__((ext_vector_type(16))) float;
using u32x4  = __attribute__((ext_vector_type(4))) unsigned;
#define KSWZ(row, colB) ((row) * 256 + ((colB) ^ (((row) & 7) << 4)))
#define SBAR() __builtin_amdgcn_sched_barrier(0)
__device__ __forceinline__ int crow(int r, int hi) { return (r & 3) + 8 * (r >> 2) + 4 * hi; }
__device__ __forceinline__ unsigned cvtpk(float lo, float hi) { unsigned r; asm volatile("v_cvt_pk_bf16_f32 %0, %1, %2" : "=v"(r) : "v"(lo), "v"(hi)); return r; }
__device__ __forceinline__ void partialSM(f32x16& p0, f32x16& p1, float& m_reg, float& mn, float& alpha) {
  constexpr float C = SCALE * 1.4426950408889634f;
  float pmax = p0[0]; for (int r = 1; r < 16; ++r) pmax = fmaxf(pmax, p0[r]); for (int r = 0; r < 16; ++r) pmax = fmaxf(pmax, p1[r]);
  { auto rr = __builtin_amdgcn_permlane32_swap(__float_as_uint(pmax), __float_as_uint(pmax), false, false);
    pmax = fmaxf(__uint_as_float(rr[0]), __uint_as_float(rr[1])); }
  if (__builtin_expect(__all(pmax - m_reg <= THR / SCALE), 1)) { mn = m_reg; alpha = 1.f; }
  else { mn = fmaxf(m_reg, pmax); alpha = __builtin_amdgcn_exp2f((m_reg - mn) * C); m_reg = mn; }
  float mnC = -mn * C;
  for (int r = 0; r < 16; ++r) p0[r] = fmaf(p0[r], C, mnC); for (int r = 0; r < 16; ++r) p1[r] = fmaf(p1[r], C, mnC);
  for (int r = 0; r < 16; ++r) p0[r] = __builtin_amdgcn_exp2f(p0[r]);
}
__device__ __forceinline__ void finishSM(f32x16& p0, f32x16& p1, float alpha, float& l_reg, bf16x8& pa0, bf16x8& pa1, bf16x8& pa2, bf16x8& pa3) {
  for (int r = 0; r < 16; ++r) p1[r] = __builtin_amdgcn_exp2f(p1[r]);
  float ps = 0; for (int r = 0; r < 16; ++r) ps += p0[r]; for (int r = 0; r < 16; ++r) ps += p1[r];
  { auto rr = __builtin_amdgcn_permlane32_swap(__float_as_uint(ps), __float_as_uint(ps), false, false);
    ps = __uint_as_float(rr[0]) + __uint_as_float(rr[1]); }
  l_reg = l_reg * alpha + ps;
#define PK4(P, BASE, OUT) do { unsigned a0 = cvtpk(P[BASE + 0], P[BASE + 1]), a1 = cvtpk(P[BASE + 2], P[BASE + 3]);   \
    unsigned b0 = cvtpk(P[BASE + 4], P[BASE + 5]), b1 = cvtpk(P[BASE + 6], P[BASE + 7]);                              \
    auto r0 = __builtin_amdgcn_permlane32_swap(a0, b0, false, false); auto r1 = __builtin_amdgcn_permlane32_swap(a1, b1, false, false); \
    u32x4 w = {r0[0], r1[0], r0[1], r1[1]}; OUT = *reinterpret_cast<bf16x8*>(&w); } while (0)
  PK4(p0, 0, pa0); PK4(p0, 8, pa1); PK4(p1, 0, pa2); PK4(p1, 8, pa3);
#undef PK4
}
__device__ __forceinline__ void qkt(f32x16& p0, f32x16& p1, const bf16* Ks, const bf16x8* qr, int r32, int hi, int cofsB) {
  p0 = f32x16{}; p1 = f32x16{};
  for (int d0 = 0; d0 < 4; ++d0) { int cb = cofsB + (d0 * 16 + hi * 8) * 2;
    bf16x8 b0 = *reinterpret_cast<const bf16x8*>((const char*)Ks + KSWZ(r32, cb));
    bf16x8 b1 = *reinterpret_cast<const bf16x8*>((const char*)Ks + KSWZ(32 + r32, cb));
    p0 = __builtin_amdgcn_mfma_f32_32x32x16_bf16(b0, qr[d0], p0, 0, 0, 0);
    p1 = __builtin_amdgcn_mfma_f32_32x32x16_bf16(b1, qr[d0], p1, 0, 0, 0); }
}
__device__ __forceinline__ int v_st(int k, int c) { const int kk = (k & ~0xC) | ((k & 4) << 1) | ((k & 8) >> 1); return ((kk >> 3) * 4 + (c >> 5)) * 512 + ((kk & 7) * 32 + (c & 31)) * 2; }
__device__ __forceinline__ int v_rd_base(int lane) { return ((lane & 3) << 3) | (((lane >> 2) & 3) << 6) | (((lane >> 4) & 1) << 5) | (((lane >> 5) & 1) << 8); }
constexpr int v_rd_off(int d0, int ks, int half) { return d0 * 512 + ks * 4096 + half * 2048; }
template <int OFF> __device__ __forceinline__ s16x4 tr_read(int vb) {
  s16x4 r; asm volatile("ds_read_b64_tr_b16 %0, %1 offset:%2" : "=&v"(r) : "v"(vb), "i"(OFF) : "memory"); return r;
}
template <int D0> __device__ __forceinline__ void pv_one(f32x16& od, int vb, bf16x8 pa0, bf16x8 pa1, bf16x8 pa2, bf16x8 pa3) {
  const s16x4 l0 = tr_read<v_rd_off(D0, 0, 0)>(vb), h0 = tr_read<v_rd_off(D0, 0, 1)>(vb), l1 = tr_read<v_rd_off(D0, 1, 0)>(vb), h1 = tr_read<v_rd_off(D0, 1, 1)>(vb);
  const s16x4 l2 = tr_read<v_rd_off(D0, 2, 0)>(vb), h2 = tr_read<v_rd_off(D0, 2, 1)>(vb), l3 = tr_read<v_rd_off(D0, 3, 0)>(vb), h3 = tr_read<v_rd_off(D0, 3, 1)>(vb);
  asm volatile("s_waitcnt lgkmcnt(0)" ::: "memory"); SBAR();
#define PK(L, H) (bf16x8){L[0], L[1], L[2], L[3], H[0], H[1], H[2], H[3]}
  od = __builtin_amdgcn_mfma_f32_32x32x16_bf16(pa0, PK(l0, h0), od, 0, 0, 0);
  od = __builtin_amdgcn_mfma_f32_32x32x16_bf16(pa1, PK(l1, h1), od, 0, 0, 0);
  od = __builtin_amdgcn_mfma_f32_32x32x16_bf16(pa2, PK(l2, h2), od, 0, 0, 0);
  od = __builtin_amdgcn_mfma_f32_32x32x16_bf16(pa3, PK(l3, h3), od, 0, 0, 0);
#undef PK
}
__device__ __forceinline__ void pv_d0(f32x16* o, int vb, bf16x8 pa0, bf16x8 pa1, bf16x8 pa2, bf16x8 pa3) {
  pv_one<0>(o[0], vb, pa0, pa1, pa2, pa3); pv_one<1>(o[1], vb, pa0, pa1, pa2, pa3); pv_one<2>(o[2], vb, pa0, pa1, pa2, pa3); pv_one<3>(o[3], vb, pa0, pa1, pa2, pa3);
}
__device__ __forceinline__ void attn_item(const bf16* __restrict__ Qb, const bf16* __restrict__ Kh, const bf16* __restrict__ Vh, bf16* __restrict__ Ob,
                                          float lam, float oscale, const float* __restrict__ gain, char* lds) {
  int tid_l = threadIdx.x; asm volatile("" : "+v"(tid_l));
  const int tid = tid_l, wid = tid >> 6, lane = tid & 63, r32 = lane & 31, hi = lane >> 5, rg = wid >> 1, cm = wid & 1;
  bf16* V_lds = (bf16*)lds; bf16* K_lds = (bf16*)(lds + 2 * SHM_V);
  float* ws = (float*)(lds + 2 * SHM_V + 2 * SHM_K) + wid * 64; float* li_l = ws; float* al_l = ws + 32;
  float m_reg = -1e30f, l_reg = 0; f32x16 o[4] = {}; bf16x8 qr[4];
  const bf16* Qw = Qb + (long)(rg * QBLK + r32) * LDR + cm * 64 + hi * 8;
#pragma unroll
  for (int d0 = 0; d0 < 4; ++d0) qr[d0] = *reinterpret_cast<const bf16x8*>(Qw + d0 * 16);
  const int cofsB = cm * 128;
  const int sr = tid >> 4, sc = (tid & 15) * 8, vst0 = v_st(sr, sc), vst1 = v_st(32 + sr, sc);
  const int vb0 = (int)(uintptr_t)V_lds + v_rd_base(lane);
  struct { bf16x8 vs0, vs1, ks0, ks1; } sr_[2];
#define SLOAD(i, k0) do { sr_[i].vs0 = *reinterpret_cast<const bf16x8*>(&Vh[(long)((k0) + sr) * LDR + sc]); sr_[i].vs1 = *reinterpret_cast<const bf16x8*>(&Vh[(long)((k0) + 32 + sr) * LDR + sc]); \
    sr_[i].ks0 = *reinterpret_cast<const bf16x8*>(&Kh[(long)((k0) + sr) * LDR + sc]); sr_[i].ks1 = *reinterpret_cast<const bf16x8*>(&Kh[(long)((k0) + 32 + sr) * LDR + sc]); } while (0)
#define SWRITE(b, i) do { *(bf16x8*)((char*)V_lds + (b) * SHM_V + vst0) = sr_[i].vs0;          \
    *(bf16x8*)((char*)V_lds + (b) * SHM_V + vst1) = sr_[i].vs1; int kc = sc * 2;               \
    *(bf16x8*)((char*)K_lds + (b) * SHM_K + KSWZ(sr, kc)) = sr_[i].ks0;                       \
    *(bf16x8*)((char*)K_lds + (b) * SHM_K + KSWZ(32 + sr, kc)) = sr_[i].ks1; } while (0)
#define SWAIT() asm volatile("s_waitcnt vmcnt(4)" ::: "memory")
#define RESC(a) do { if (__any((a) < 1.f)) { if (hi == 0) al_l[r32] = (a); asm volatile("s_waitcnt lgkmcnt(0)" ::: "memory"); \
    for (int d = 0; d < 4; ++d) for (int r = 0; r < 16; ++r) o[d][r] *= al_l[crow(r, hi)]; } } while (0)
  f32x16 pA0, pA1, pB0, pB1; float mnA, mnB, alA, alB; bf16x8 pa0, pa1, pa2, pa3; const int NT = NKT;
  constexpr int SE = 0, SO = 1;
  SLOAD(SE, 0); asm volatile("s_waitcnt vmcnt(0)" ::: "memory"); SWRITE(0, SE); __syncthreads();
  qkt(pA0, pA1, K_lds, qr, r32, hi, cofsB); partialSM(pA0, pA1, m_reg, mnA, alA);
  SLOAD(SO, KVBLK); if (2 < NT) SLOAD(SE, 2 * KVBLK);
  SWAIT(); SWRITE(1, SO); __syncthreads();
  for (int j = 1; j + 1 < NT; j += 2) {
    SBAR(); qkt(pB0, pB1, (bf16*)((char*)K_lds + SHM_K), qr, r32, hi, cofsB);
    finishSM(pA0, pA1, alA, l_reg, pa0, pa1, pa2, pa3); SBAR();
    SLOAD(SO, (j + 2) * KVBLK); SBAR();
    pv_d0(o, vb0, pa0, pa1, pa2, pa3); partialSM(pB0, pB1, m_reg, mnB, alB);
    __syncthreads(); SWAIT(); SWRITE(0, SE);
    RESC(alB); __syncthreads();
    SBAR(); qkt(pA0, pA1, K_lds, qr, r32, hi, cofsB);
    finishSM(pB0, pB1, alB, l_reg, pa0, pa1, pa2, pa3); SBAR();
    if (j + 3 < NT) SLOAD(SE, (j + 3) * KVBLK); SBAR();
    pv_d0(o, vb0 + (int)SHM_V, pa0, pa1, pa2, pa3); partialSM(pA0, pA1, m_reg, mnA, alA);
    __syncthreads(); SWAIT(); SWRITE(1, SO);
    RESC(alA); __syncthreads();
  }
  SBAR(); qkt(pB0, pB1, (bf16*)((char*)K_lds + SHM_K), qr, r32, hi, cofsB);
  finishSM(pA0, pA1, alA, l_reg, pa0, pa1, pa2, pa3); SBAR();
  pv_d0(o, vb0, pa0, pa1, pa2, pa3); partialSM(pB0, pB1, m_reg, mnB, alB);
  __syncthreads(); RESC(alB);
  finishSM(pB0, pB1, alB, l_reg, pa0, pa1, pa2, pa3); SBAR();
  pv_d0(o, vb0 + (int)SHM_V, pa0, pa1, pa2, pa3);
  if (hi == 0) li_l[r32] = l_reg; asm volatile("s_waitcnt lgkmcnt(0)" ::: "memory");
  float rli[16];
#pragma unroll
  for (int r = 0; r < 16; ++r) rli[r] = __builtin_amdgcn_rcpf(li_l[crow(r, hi)]);
  __syncthreads();
  float* ex = (float*)lds + rg * 4096 + lane;
  if (cm == 1) {
#pragma unroll
    for (int d0 = 0; d0 < 4; ++d0)
#pragma unroll
      for (int r = 0; r < 16; ++r) ex[(d0 * 16 + r) * 64] = o[d0][r] * rli[r] * lam;
  }
  __syncthreads();
  if (cm == 0) {
    float ss[16];
#pragma unroll
    for (int r = 0; r < 16; ++r) { float s = 0.f;
#pragma unroll
      for (int d0 = 0; d0 < 4; ++d0) { const float v = o[d0][r] * rli[r] - ex[(d0 * 16 + r) * 64]; o[d0][r] = v; s += v * v; }
      ss[r] = s; }
#pragma unroll
    for (int r = 0; r < 16; ++r) { float s = ss[r]; s += __shfl_xor(s, 1); s += __shfl_xor(s, 2); s += __shfl_xor(s, 4); s += __shfl_xor(s, 8); s += __shfl_xor(s, 16);
      ss[r] = oscale / sqrtf(s * (1.0f / 128.0f) + 1e-6f); }
    float gn[4];
#pragma unroll
    for (int d0 = 0; d0 < 4; ++d0) gn[d0] = gain[d0 * 32 + r32];
#pragma unroll
    for (int r = 0; r < 16; ++r) { bf16* orow = Ob + (long)(rg * QBLK + crow(r, hi)) * LDR + r32;
#pragma unroll
      for (int d0 = 0; d0 < 4; ++d0) { const float v = o[d0][r] * ss[r] * gn[d0]; unsigned u = __builtin_bit_cast(unsigned, v); u = (u + 0x7fffu + ((u >> 16) & 1u)) >> 16; orow[d0 * 32] = (bf16)u; } }
  }
  __syncthreads();
#undef SLOAD
#undef SWRITE
#undef SWAIT
#undef RESC
}
#undef KSWZ
#undef SBAR
}
namespace att2 {
using namespace att;
constexpr int SHM_Q = 256 * 128 * 2;
constexpr int LDS_BYTES2 = 2 * SHM_V + 2 * SHM_K + SHM_Q + 8 * 64 * 4;
#define KSWZ(row, colB) ((row) * 256 + ((colB) ^ (((row) & 15) << 4)))
#define SBAR() __builtin_amdgcn_sched_barrier(0)
__device__ __forceinline__ void qkt2(f32x16& p0, f32x16& p1, const char* Ks, const char* Qs, int qrow, int r32, int hi, int cofsB) {
  p0 = f32x16{}; p1 = f32x16{};
#pragma unroll
  for (int d0 = 0; d0 < 4; ++d0) { const int cb = cofsB + (d0 * 16 + hi * 8) * 2;
    const bf16x8 q = *reinterpret_cast<const bf16x8*>(Qs + KSWZ(qrow, cb));
    const bf16x8 b0 = *reinterpret_cast<const bf16x8*>(Ks + KSWZ(r32, cb));
    const bf16x8 b1 = *reinterpret_cast<const bf16x8*>(Ks + KSWZ(32 + r32, cb));
    p0 = __builtin_amdgcn_mfma_f32_32x32x16_bf16(b0, q, p0, 0, 0, 0);
    p1 = __builtin_amdgcn_mfma_f32_32x32x16_bf16(b1, q, p1, 0, 0, 0); }
}
__device__ __forceinline__ void attn2_items(int first, int stride, const bf16* __restrict__ Q, const bf16* __restrict__ Kg, const bf16* __restrict__ Vg, bf16* __restrict__ O,
                                            float lam, float oscale, const float* __restrict__ gain, char* lds) {
  int tid_l = threadIdx.x; asm volatile("" : "+v"(tid_l));
  const int tid = tid_l, wid = tid >> 6, lane = tid & 63, r32 = lane & 31, hi = lane >> 5;
  char* V_lds = lds; char* K_lds = lds + 2 * SHM_V; char* Q_lds = lds + 2 * SHM_V + 2 * SHM_K;
  float* ws = (float*)(lds + 2 * SHM_V + 2 * SHM_K + SHM_Q) + wid * 64; float* li_l = ws; float* al_l = ws + 32;
  const int sr = tid >> 4, sc = (tid & 15) * 8, vst0 = v_st(sr, sc), vst1 = v_st(32 + sr, sc);
  const int vb0 = (int)(uintptr_t)V_lds + v_rd_base(lane);
  const int qrow = wid * 32 + r32;
  const unsigned kvoff0 = (unsigned)(sr * LDR + sc) * 2u;
  for (int it = first; it < 8 * 8 * 8; it += stride) {
    unsigned kvoff = kvoff0; asm volatile("" : "+v"(kvoff));
    const int qb = it & 7, h = (it >> 3) & 7, b = it >> 6;
    const bf16* Qb = Q + ((long)b * 2048 + qb * 256) * LDR + h * 128; const bf16* Kh = Kg + (long)b * 2048 * LDR + h * 128; const bf16* Vh = Vg + (long)b * 2048 * LDR + h * 128;
    bf16* Ob = O + ((long)b * 2048 + qb * 256) * LDR + h * 128;
    bf16x8 vs0, vs1, ks0, ks1;
#define SLOAD2(k0) do { const char* vb_ = (const char*)Vh + (size_t)(k0) * (LDR * 2); const char* kb_ = (const char*)Kh + (size_t)(k0) * (LDR * 2);     \
    vs0 = *reinterpret_cast<const bf16x8*>(vb_ + kvoff); vs1 = *reinterpret_cast<const bf16x8*>(vb_ + kvoff + (unsigned)(32 * LDR * 2)); \
    ks0 = *reinterpret_cast<const bf16x8*>(kb_ + kvoff); ks1 = *reinterpret_cast<const bf16x8*>(kb_ + kvoff + (unsigned)(32 * LDR * 2)); } while (0)
#define SWRITE2(bf) do { *(bf16x8*)(V_lds + (bf) * SHM_V + vst0) = vs0; *(bf16x8*)(V_lds + (bf) * SHM_V + vst1) = vs1; const int kc = sc * 2; \
    *(bf16x8*)(K_lds + (bf) * SHM_K + KSWZ(sr, kc)) = ks0; *(bf16x8*)(K_lds + (bf) * SHM_K + KSWZ(32 + sr, kc)) = ks1; } while (0)
#define RESC2(o, a) do { if (__any((a) < 1.f)) { if (hi == 0) al_l[r32] = (a); asm volatile("s_waitcnt lgkmcnt(0)" ::: "memory"); \
    for (int d = 0; d < 4; ++d) for (int r = 0; r < 16; ++r) o[d][r] *= al_l[crow(r, hi)]; } } while (0)
    SLOAD2(0);
    {
      bf16x8 qv[8]; int srz = sr; asm volatile("" : "+v"(srz));
      const unsigned qoff = (unsigned)(srz * LDR + sc) * 2u;
#pragma unroll
      for (int i = 0; i < 8; ++i) qv[i] = *reinterpret_cast<const bf16x8*>((const char*)Qb + qoff + (unsigned)(32 * i * LDR * 2));
#pragma unroll
      for (int i = 0; i < 8; ++i) *(bf16x8*)(Q_lds + KSWZ(srz + 32 * i, sc * 2)) = qv[i]; }
    SWRITE2(0);
    __syncthreads();
    f32x16 o0[4] = {}, o1[4] = {}; float m0 = -1e30f, l0 = 0.f, m1 = -1e30f, l1 = 0.f;
    for (int j = 0; j < NKT; ++j) {
      const int bf = j & 1;
      int qrow_l = qrow; asm volatile("" : "+v"(qrow_l));
      if (j + 1 < NKT) SLOAD2((j + 1) * KVBLK);
      const char* Ks = K_lds + bf * SHM_K; const int vb = vb0 + bf * SHM_V;
      { f32x16 p0, p1; float mn, al; bf16x8 pa0, pa1, pa2, pa3;
        qkt2(p0, p1, Ks, Q_lds, qrow_l, r32, hi, 0);
        partialSM(p0, p1, m0, mn, al); RESC2(o0, al);
        finishSM(p0, p1, al, l0, pa0, pa1, pa2, pa3); SBAR();
        pv_d0(o0, vb, pa0, pa1, pa2, pa3); }
      SBAR();
      { f32x16 p0, p1; float mn, al; bf16x8 pa0, pa1, pa2, pa3;
        qkt2(p0, p1, Ks, Q_lds, qrow_l, r32, hi, 128);
        partialSM(p0, p1, m1, mn, al); RESC2(o1, al);
        finishSM(p0, p1, al, l1, pa0, pa1, pa2, pa3); SBAR();
        pv_d0(o1, vb, pa0, pa1, pa2, pa3); }
      if (j + 1 < NKT) SWRITE2(bf ^ 1);
      __syncthreads();
    }
    {
    int lz = tid_l & 63; asm volatile("" : "+v"(lz));
    const int r32 = lz & 31, hi = lz >> 5;
    if (hi == 0) { li_l[r32] = l0; al_l[r32] = l1; } asm volatile("s_waitcnt lgkmcnt(0)" ::: "memory");
    float ss[16];
#pragma unroll
    for (int r = 0; r < 16; ++r) { const float ra = __builtin_amdgcn_rcpf(li_l[crow(r, hi)]), rb = lam * __builtin_amdgcn_rcpf(al_l[crow(r, hi)]); float s = 0.f;
#pragma unroll
      for (int d0 = 0; d0 < 4; ++d0) { const float v = o0[d0][r] * ra - o1[d0][r] * rb; o0[d0][r] = v; s += v * v; }
      ss[r] = s; }
#pragma unroll
    for (int r = 0; r < 16; ++r) { float s = ss[r]; s += __shfl_xor(s, 1); s += __shfl_xor(s, 2); s += __shfl_xor(s, 4); s += __shfl_xor(s, 8); s += __shfl_xor(s, 16);
      ss[r] = oscale / sqrtf(s * (1.0f / 128.0f) + 1e-6f); }
    float gn[4];
#pragma unroll
    for (int d0 = 0; d0 < 4; ++d0) gn[d0] = gain[d0 * 32 + r32];
#pragma unroll
    for (int r = 0; r < 16; ++r) { bf16* orow = Ob + (long)(wid * QBLK + crow(r, hi)) * LDR + r32;
#pragma unroll
      for (int d0 = 0; d0 < 4; ++d0) { const float v = o0[d0][r] * ss[r] * gn[d0]; unsigned u = __builtin_bit_cast(unsigned, v); u = (u + 0x7fffu + ((u >> 16) & 1u)) >> 16; orow[d0 * 32] = (bf16)u; } }
    }
    __syncthreads();
#undef SLOAD2
#undef SWRITE2
#undef RESC2
  }
}
#undef KSWZ
#undef SBAR
}
#define GAS __attribute__((address_space(1)))
typedef GAS unsigned gu32;
constexpr int NWAVES = 8;
constexpr int RING_BYTES = 131072, LDS_TOTAL = 147456, MISC_OFF = LDS_TOTAL - 256;
constexpr int CW_CONVQ = 1024;
constexpr int CW_BAR = 4096;
constexpr int N_PHASES = 2 + 9 * NL;

#define XB_TMO      128
#define XB_XCNT(j)  (256  + 64 * (j))
#define XB_XSUB(j)  (1280 + 64 * (j))
#define XB_XGEN(j)  (2304 + 64 * (j))
#define XB_TOP      3328
#define XB_TOPGEN   3392
#define XCD_BAR_WORDS 3456
#define XB_SPIN_CAP (1u << 18)
__device__ __forceinline__ unsigned xb_ld(unsigned* p)              { return __hip_atomic_load(p, __ATOMIC_RELAXED, __HIP_MEMORY_SCOPE_AGENT); }
__device__ __forceinline__ unsigned xb_add(unsigned* p, unsigned v) { return __hip_atomic_fetch_add(p, v, __ATOMIC_RELAXED, __HIP_MEMORY_SCOPE_AGENT); }
__device__ __forceinline__ unsigned xb_xcc_id() { return (unsigned)__builtin_amdgcn_s_getreg((3 << 11) | 20) & 0xFu; }
#define XB_SPIN(cond, bar) do { unsigned _sp = 0; while (cond) { __builtin_amdgcn_s_sleep(1); \
    if ((++_sp & 255u) == 0u) { if (xb_ld(&(bar)[XB_TMO])) break; if (_sp > XB_SPIN_CAP) { atomicAdd(&(bar)[XB_TMO], 1u); break; } } } } while (0)
struct XcdBarrier { unsigned* bar; unsigned x; volatile LAS unsigned* st; };
__device__ __forceinline__ XcdBarrier xcd_barrier_post(unsigned* bar, volatile LAS unsigned* st) {
    XcdBarrier b; b.bar = bar; b.x = xb_xcc_id(); b.st = st;
    if (threadIdx.x == 0) (void)xb_add(&bar[XB_XCNT(b.x)], 1u);
    return b;
}
__device__ __forceinline__ void xcd_barrier_complete(unsigned* bar, unsigned x, unsigned& nloc, unsigned& nx) {
    const unsigned G = gridDim.x * gridDim.y * gridDim.z;
    unsigned sum, cnt, mine, sp = 0u;
    for (;;) {
        sum = 0u; cnt = 0u; mine = 0u;
#pragma unroll
        for (unsigned j = 0; j < 16; ++j) { const unsigned c = xb_ld(&bar[XB_XCNT(j)]); sum += c; cnt += (c > 0u) ? 1u : 0u; mine = (j == x) ? c : mine; }
        if (sum == G) break;
        __builtin_amdgcn_s_sleep(1);
        if ((++sp & 255u) == 0u) { if (xb_ld(&bar[XB_TMO])) break; if (sp > XB_SPIN_CAP) { atomicAdd(&bar[XB_TMO], 1u); break; } }
    }
    nloc = mine > 0u ? mine : 1u; nx = cnt > 0u ? cnt : 1u;
}
__device__ __forceinline__ void xcd_barrier(const XcdBarrier& b) {
    asm volatile("s_waitcnt vmcnt(0)" ::: "memory");
    __syncthreads();
    if (threadIdx.x == 0) {
        unsigned* bar = b.bar;
        __builtin_amdgcn_s_waitcnt(0);
        unsigned nloc = b.st[0], nx = b.st[1];
        if (nloc == 0u) { xcd_barrier_complete(bar, b.x, nloc, nx); b.st[0] = nloc; b.st[1] = nx; }
        const unsigned old = xb_add(&bar[XB_XSUB(b.x)], 1u);
        const unsigned gen = old / nloc;
        if (old + 1u == (gen + 1u) * nloc) {
            __builtin_amdgcn_fence(__ATOMIC_RELEASE, "agent");
            asm volatile("s_waitcnt vmcnt(0)" ::: "memory");
            const unsigned og = xb_add(&bar[XB_TOP], 1u);
            const unsigned tg = og / nx;
            if (og + 1u == (tg + 1u) * nx) xb_add(&bar[XB_TOPGEN], 1u);
            else XB_SPIN(xb_ld(&bar[XB_TOPGEN]) == tg, bar);
            __builtin_amdgcn_fence(__ATOMIC_ACQUIRE, "agent");
            xb_add(&bar[XB_XGEN(b.x)], 1u);
            asm volatile("s_waitcnt vmcnt(0)" ::: "memory");
        } else {
            XB_SPIN(xb_ld(&bar[XB_XGEN(b.x)]) == gen, bar);
            __builtin_amdgcn_fence(__ATOMIC_ACQUIRE, "agent");
            asm volatile("s_waitcnt vmcnt(0)" ::: "memory");
        }
    }
    __syncthreads();
}

__device__ __forceinline__ void gmlp_item(int item, const bf16_t* __restrict__ UV, const float* __restrict__ w_s_l, const float* __restrict__ b_s_l, bf16_t* __restrict__ COUT, LAS unsigned char* lds, int tid) {
    const int g = item & 3, n = (item >> 2) & 15, b = item >> 6, lane = tid & 63, wave = tid >> 6, fr = lane & 15, fq = lane >> 4;
    const size_t t0 = (size_t)b * SEQ + n * 128;
    LAS bf16_t* vgT = (LAS bf16_t*)lds;
    LAS bf16_t* wsb = (LAS bf16_t*)(lds + 34816);
    __syncthreads();
    { const int q = tid >> 2, qt = tid & 3;
      const u32x4* src = (const u32x4*)(UV + (t0 + q) * 1024 + 512 + g * 128 + qt * 32);
      float v[32]; float ss = 0.f;
#pragma unroll
      for (int i = 0; i < 4; ++i) { const u32x4 w = src[i]; f32x4 a, c; pg8::unpack8(w, a, c);
#pragma unroll
          for (int j = 0; j < 4; ++j) { v[i * 8 + j] = a[j]; v[i * 8 + 4 + j] = c[j]; ss += a[j] * a[j] + c[j] * c[j]; } }
      ss += __shfl_xor(ss, 1); ss += __shfl_xor(ss, 2);
      const float r = 1.0f / sqrtf(ss * (1.0f / 128.0f) + EPS);
#pragma unroll
      for (int cc = 0; cc < 32; ++cc) vgT[(qt * 32 + cc) * 136 + q] = (bf16_t)f2bf(v[cc] * r);
      const f32x4* wsrc = (const f32x4*)(w_s_l + ((size_t)g * 128 + q) * 128 + qt * 32);
#pragma unroll
      for (int i = 0; i < 4; ++i) { const f32x4 a = wsrc[2 * i], c = wsrc[2 * i + 1]; *(LAS u32x4*)(wsb + q * 136 + qt * 32 + i * 8) = pg8::pack8(a, c); } }
    __syncthreads();
    f32x4 acc[8];
#pragma unroll
    for (int j = 0; j < 8; ++j) acc[j] = (f32x4){0.f, 0.f, 0.f, 0.f};
#pragma unroll
    for (int ks = 0; ks < 4; ++ks) { const bf16x8 wfrag = *(const LAS bf16x8*)(wsb + (16 * wave + fr) * 136 + ks * 32 + fq * 8);
#pragma unroll
        for (int j = 0; j < 8; ++j) { const bf16x8 vfrag = *(const LAS bf16x8*)(vgT + (16 * j + fr) * 136 + ks * 32 + fq * 8); acc[j] = __builtin_amdgcn_mfma_f32_16x16x32_bf16(vfrag, wfrag, acc[j], 0, 0, 0); } }
    { const int p = 16 * wave + fr; const float bias = b_s_l[g * 128 + p];
      const bf16_t* urow = UV + (t0 + p) * 1024 + g * 128 + 4 * fq; bf16_t* orow = COUT + (t0 + p) * 512 + g * 128 + 4 * fq;
      unsigned long long uu[8];
#pragma unroll
      for (int j = 0; j < 8; ++j) uu[j] = *(const unsigned long long*)(urow + 16 * j);
#pragma unroll
      for (int j = 0; j < 8; ++j) { const unsigned lo = (unsigned)uu[j], hi = (unsigned)(uu[j] >> 32);
          const float u0 = __builtin_bit_cast(float, lo << 16), u1 = __builtin_bit_cast(float, lo & 0xffff0000u), u2 = __builtin_bit_cast(float, hi << 16), u3 = __builtin_bit_cast(float, hi & 0xffff0000u);
          *(unsigned long long*)(orow + 16 * j) = (unsigned long long)pk2(u0 * (acc[j][0] + bias), u1 * (acc[j][1] + bias)) | ((unsigned long long)pk2(u2 * (acc[j][2] + bias), u3 * (acc[j][3] + bias)) << 32); } }
}
__device__ __forceinline__ void topk_gather_item(int pair, int half, const float* __restrict__ AFF, int* __restrict__ SEL, const bf16_t* __restrict__ H, bf16_t* __restrict__ XIN, LAS unsigned char* lds, int tid) {
    const int lane = tid & 63, wave = tid >> 6, b = pair >> 4, e = pair & 15;
    LAS int* cntA = (LAS int*)lds; LAS int* scanw = (LAS int*)(lds + 64); LAS int* idxs = (LAS int*)(lds + 128);
    const f32x4 xv = *(const f32x4*)(AFF + (size_t)pair * SEQ + tid * 4);
    unsigned u[4];
#pragma unroll
    for (int k = 0; k < 4; ++k) { const float f = xv[k]; u[k] = __float_as_uint(f); }
    unsigned T = 0u;
    __syncthreads();
    for (int bit = 30; bit >= 0; --bit) {
        const unsigned cand = T | (1u << bit); int c = 0;
#pragma unroll
        for (int k = 0; k < 4; ++k) c += __popcll(__ballot(u[k] >= cand));
        LAS int* buf = cntA + (bit & 1) * 8;
        if (lane == 0) buf[wave] = c;
        __syncthreads();
        int tot = 0;
#pragma unroll
        for (int w = 0; w < 8; ++w) tot += buf[w];
        if (tot >= CAP) T = cand;
    }
    int gt[4], eq[4], loc = 0;
#pragma unroll
    for (int k = 0; k < 4; ++k) { gt[k] = u[k] > T ? 1 : 0; eq[k] = u[k] == T ? 1 : 0; loc += gt[k] + (eq[k] << 16); }
    int inc = loc;
#pragma unroll
    for (int o = 1; o < 64; o <<= 1) { const int t = __shfl_up(inc, o); if (lane >= o) inc += t; }
    if (lane == 63) scanw[wave] = inc;
    __syncthreads();
    int base = 0, total = 0;
#pragma unroll
    for (int w = 0; w < 8; ++w) { const int s = scanw[w]; base += (w < wave) ? s : 0; total += s; }
    const int excl = base + inc - loc, need_eq = CAP - (total & 0xffff);
    int pg = excl & 0xffff, pe = excl >> 16, sl[4];
#pragma unroll
    for (int k = 0; k < 4; ++k) { const bool sel = gt[k] || (eq[k] && pe < need_eq); const int slot = pg + (pe < need_eq ? pe : need_eq);
        sl[k] = sel ? slot : -1; if (sel) idxs[slot] = tid * 4 + k; pg += gt[k]; pe += eq[k]; }
    if (half == 0) *(int __attribute__((ext_vector_type(4)))*)(SEL + (size_t)pair * SEQ + tid * 4) = (int __attribute__((ext_vector_type(4)))){sl[0], sl[1], sl[2], sl[3]};
    __syncthreads();
#pragma unroll
    for (int bt = 0; bt < 2; ++bt) { u32x4 r0[8], r1[8];
#pragma unroll
        for (int q = 0; q < 8; ++q) { const int s = idxs[half * 128 + wave * 16 + bt * 8 + q]; const u32x4* src = (const u32x4*)(H + ((size_t)b * SEQ + s) * DM); r0[q] = src[lane]; r1[q] = src[lane + 64]; }
#pragma unroll
        for (int q = 0; q < 8; ++q) { u32x4* dst = (u32x4*)(XIN + ((size_t)e * 2048 + b * CAP + half * 128 + wave * 16 + bt * 8 + q) * DM); dst[lane] = r0[q]; dst[lane + 64] = r1[q]; } }
}
__device__ __forceinline__ void stage_router(const float* __restrict__ w_router, LAS unsigned char* lds, int tid) {
    __syncthreads();
    for (int i = tid; i < DM * 4; i += 512) { const int k = i >> 2, e4 = i & 3; *(LAS f32x4*)(lds + (k >> 2) * 272 + (k & 3) * 64 + e4 * 16) = ((const f32x4*)w_router)[i]; }
    __syncthreads();
}
__device__ __forceinline__ void mod_load(f32x4 (&am)[4], f32x4 (&bm)[4], const float* __restrict__ gain, const float* __restrict__ ada_b, int sh_off, int sc_off, int lane) {
#pragma unroll
    for (int j = 0; j < 4; ++j) { const int col = 4 * lane + 256 * j; const f32x4 g4 = *(const f32x4*)(gain + col), sc = *(const f32x4*)(ada_b + sc_off + col); bm[j] = *(const f32x4*)(ada_b + sh_off + col); am[j] = g4 * (sc + 1.0f); }
}
template <bool ROUTER>
__device__ __forceinline__ void hprep_regs(const f32x4 (&v)[4], int t, int lane, const f32x4 (&am)[4], const f32x4 (&bm)[4], bf16_t* __restrict__ H, const LAS unsigned char* wl, float* __restrict__ AFF) {
    float ss = 0.f;
#pragma unroll
    for (int j = 0; j < 4; ++j) ss += (v[j].x * v[j].x + v[j].y * v[j].y) + (v[j].z * v[j].z + v[j].w * v[j].w);
    const float r = 1.0f / sqrtf(wave_sum(ss) * (1.0f / DM) + EPS);
    float lg[NE];
    if (ROUTER) {
#pragma unroll
        for (int e = 0; e < NE; ++e) lg[e] = 0.f; }
#pragma unroll
    for (int j = 0; j < 4; ++j) { const int col = 4 * lane + 256 * j;
        const f32x4 h = (v[j] * r) * am[j] + bm[j];
        *(unsigned long long*)(H + (size_t)t * DM + col) = (unsigned long long)pk2(h.x, h.y) | ((unsigned long long)pk2(h.z, h.w) << 32);
        if (ROUTER) {
#pragma unroll
            for (int q = 0; q < 4; ++q) { const float hv = h[q]; const LAS f32x4* wr = (const LAS f32x4*)(wl + (lane + 64 * j) * 272 + q * 64);
#pragma unroll
                for (int e4 = 0; e4 < 4; ++e4) { const f32x4 w = wr[e4]; lg[e4 * 4 + 0] += hv * w.x; lg[e4 * 4 + 1] += hv * w.y; lg[e4 * 4 + 2] += hv * w.z; lg[e4 * 4 + 3] += hv * w.w; } }
            __builtin_amdgcn_sched_barrier(0);
        }
    }
    if (ROUTER) {
        float a8[8], a4[4], a2[2], a1;
#pragma unroll
        for (int i = 0; i < 8; ++i) { const bool up = lane & 1; const float send = up ? lg[i] : lg[8 + i], keep = up ? lg[8 + i] : lg[i]; a8[i] = keep + __shfl_xor(send, 1); }
#pragma unroll
        for (int i = 0; i < 4; ++i) { const bool up = lane & 2; const float send = up ? a8[i] : a8[4 + i], keep = up ? a8[4 + i] : a8[i]; a4[i] = keep + __shfl_xor(send, 2); }
#pragma unroll
        for (int i = 0; i < 2; ++i) { const bool up = lane & 4; const float send = up ? a4[i] : a4[2 + i], keep = up ? a4[2 + i] : a4[i]; a2[i] = keep + __shfl_xor(send, 4); }
        { const bool up = lane & 8; const float send = up ? a2[0] : a2[1], keep = up ? a2[1] : a2[0]; a1 = keep + __shfl_xor(send, 8); }
        a1 += __shfl_xor(a1, 16); a1 += __shfl_xor(a1, 32);
        const int e_mine = ((lane & 1) << 3) | ((lane & 2) << 1) | ((lane & 4) >> 1) | ((lane & 8) >> 3);
        float mx = a1;
#pragma unroll
        for (int o = 1; o < 16; o <<= 1) mx = fmaxf(mx, __shfl_xor(mx, o));
        const float ex = expf(a1 - mx); float den = ex;
#pragma unroll
        for (int o = 1; o < 16; o <<= 1) den += __shfl_xor(den, o);
        const int b = t >> 11, s = t & 2047;
        if (lane < 16) AFF[((size_t)b * NE + e_mine) * SEQ + s] = ex / den;
    }
}

#define PHASE_IDS int tid_p_ = threadIdx.x; asm volatile("" : "+v"(tid_p_)); const int tid = tid_p_, lane = tid & 63, wave = __builtin_amdgcn_readfirstlane(tid >> 6), gw = vcu * NWAVES + wave; (void)tid; (void)lane; (void)wave; (void)gw
struct MArgs { const float* in[24]; float* out; unsigned char* ws; InvF invf; float lam_init[2]; int ph_lo, ph_hi, li, pad; };

__global__ void __launch_bounds__(NWAVES * 64, 2) mega(MArgs a) {
    extern __shared__ __attribute__((aligned(16))) unsigned char lds[];
    LAS unsigned char* L = (LAS unsigned char*)lds;
    volatile LAS unsigned* MISC = (volatile LAS unsigned*)(L + MISC_OFF);
    const int tid = threadIdx.x, lane = tid & 63, wave = __builtin_amdgcn_readfirstlane(tid >> 6);
    const int G = gridDim.x, bx = blockIdx.x, vcu = (G % 8 == 0) ? (bx % 8) * (G / 8) + bx / 8 : bx;
    unsigned char* ws = a.ws;
    if (tid < 64) MISC[tid] = 0u;
    __syncthreads();
    XcdBarrier bar = xcd_barrier_post((unsigned*)(ws + WS_CTL) + CW_BAR + a.li * XCD_BAR_WORDS, MISC + 8);
    const int lo = a.ph_lo, hi = a.ph_hi;
#define IN(k) (lo <= (k) && (k) < hi)
#ifndef REPEAT_MASK
#define REPEAT_MASK 0u
#endif
#define REPS(k) (int)(1u + ((REPEAT_MASK >> (k)) & 1u))
#ifndef REPEAT_L
#define REPEAT_L 0u
#endif
#define REPS_L(k) (int)(1u + ((REPEAT_L >> (k)) & 1u))
#define SEAM(k) do { if (IN(k) && IN((k) + 1)) xcd_barrier(bar); } while (0)
    const float* x_in = a.in[0]; const float* g_mix = a.in[5]; const float* g_ffn = a.in[6];
    float* X = (float*)(ws + WS_X); bf16_t* H = (bf16_t*)(ws + WS_H); const float* ADA = (const float*)(ws + WS_CTL + CTL_ADA);
    bf16_t *Q = (bf16_t*)(ws + WS_Q), *Kb = (bf16_t*)(ws + WS_K), *V = (bf16_t*)(ws + WS_V), *YT = (bf16_t*)(ws + WS_YT), *UV = (bf16_t*)(ws + WS_UV), *GATES = (bf16_t*)(ws + WS_GATES);
    bf16_t *AOUT = (bf16_t*)(ws + WS_AOUT), *BOUT = (bf16_t*)(ws + WS_BOUT), *COUT = (bf16_t*)(ws + WS_COUT), *T1 = (bf16_t*)(ws + WS_T1), *T2 = (bf16_t*)(ws + WS_T2), *MERGED = (bf16_t*)(ws + WS_MERGED);
    bf16_t *XIN = (bf16_t*)(ws + WS_XIN), *HID = (bf16_t*)(ws + WS_HID); float* Y = (float*)(ws + WS_Y);
    int* SEL = (int*)(ws + WS_SEL); float* AFF = (float*)(ws + WS_AFF);
    const int gw = vcu * NWAVES + wave, NGW = G * NWAVES;

    if (IN(0)) for (int rep_ = 0; rep_ < REPS(0); ++rep_) {

#ifndef SKIP_PRO
        const size_t gt = (size_t)bx * 512 + tid, GT = (size_t)G * 512;
        for (size_t i = gt; i < (size_t)MT * 8; i += GT) rope_entry((int)i, (const int*)a.in[2], (float*)(ws + WS_ROPE), a.invf);
        { LAS float* tc = (LAS float*)L; LAS float* tsn = tc + 2048;
          for (int j = tid; j < 2048; j += 512) { double sn, cs; sincos_d((double)j * (6.283185307179586476925 / 2048.0), sn, cs); tc[j] = (float)(cs * (1.0 / 512.0)); tsn[j] = (float)(-sn * (1.0 / 512.0)); }
          __syncthreads();
          for (size_t i = gt; i < (size_t)2048 * 256; i += GT) { const int m = (int)(i >> 8), k0 = (int)(i & 255) * 8; unsigned cw[4], sw[4];
#pragma unroll
              for (int j = 0; j < 4; ++j) { const int r0 = (m * (k0 + 2 * j)) & 2047, r1 = (m * (k0 + 2 * j + 1)) & 2047; cw[j] = cvtpk_c(tc[r0], tc[r1]); sw[j] = cvtpk_c(tsn[r0], tsn[r1]); }
              *(u32x4*)((bf16_t*)(ws + WS_DFTC) + (size_t)m * 2048 + k0) = (u32x4){cw[0], cw[1], cw[2], cw[3]};
              *(u32x4*)((bf16_t*)(ws + WS_DFTS) + (size_t)m * 2048 + k0) = (u32x4){sw[0], sw[1], sw[2], sw[3]}; }
          __syncthreads(); }
        for (size_t i = gt; i < (size_t)NL * NE * PAD_CH; i += GT) pad_chunk(i, ws);
        for (int it = bx; it < NL * 96; it += G) ada_item(it, a.in[1], a.in[3], a.in[4], (float*)(ws + WS_CTL + CTL_ADA), (LAS float*)L, tid);
        for (int it = G - 1 - bx; it < NL * 4 * 16; it += G) fold_item(it, a.in[7], (bf16_t*)(ws + WS_WIN), (LAS float*)L, tid);
        __syncthreads();
        ConvPtrs P{a.in[7], a.in[15], a.in[16], a.in[17], a.in[18], a.in[20], a.in[21], a.in[22], ws};
        LAS float* scr = (LAS float*)L + wave * (64 * 65);
#ifndef CONV_REPS
#define CONV_REPS 1
#endif
        for (int crep = 0; crep < CONV_REPS; ++crep) { __syncthreads();
        unsigned* qctr = (unsigned*)(ws + WS_CTL) + CW_CONVQ + 64 * crep;
        f32x4 va[16], vb[16]; TileDesc da, db;
        int base = 0, sub = 4, cur = CV_TOTAL;
#define CLAIM_NEXT(dst) do { if (sub == 4) { unsigned t_ = 0u; if (lane == 0) t_ = __hip_atomic_fetch_add(qctr, 4u, __ATOMIC_RELAXED, __HIP_MEMORY_SCOPE_AGENT); base = (int)__builtin_amdgcn_readfirstlane(t_); sub = 0; } \
            dst = base + sub; ++sub; } while (0)
        CLAIM_NEXT(cur);
        if (cur < CV_TOTAL) { da = conv_decode(cur, P); tile_load(da, va, lane);
            for (;;) { int nxt; CLAIM_NEXT(nxt); const bool hn = nxt < CV_TOTAL;
                if (hn) { db = conv_decode(nxt, P); tile_load(db, vb, lane); }
                tile_store(da, va, scr, lane);
                if (!hn) break;
                da = db;
#pragma unroll
                for (int i = 0; i < 16; ++i) va[i] = vb[i]; } }
        }
#undef CLAIM_NEXT
#endif

    }
    SEAM(0);
    if (IN(1)) for (int rep_ = 0; rep_ < REPS(1); ++rep_) {

#ifndef SKIP_HP1
        for (int t0 = 8 * gw; t0 < MT; t0 += 8 * NGW) {
            f32x4 am[4], bm[4]; mod_load(am, bm, g_mix, ADA + (size_t)(t0 >> 11) * 6144, 0, 1024, lane);
#pragma unroll 1
            for (int p = 0; p < 4; ++p) { const int t = t0 + 2 * p; const f32x4* xr = (const f32x4*)(x_in + (size_t)t * DM) + lane; f32x4 v[4], w[4];
#pragma unroll
                for (int j = 0; j < 4; ++j) { v[j] = xr[64 * j]; w[j] = xr[256 + 64 * j]; }
                hprep_regs<false>(v, t, lane, am, bm, H, (const LAS unsigned char*)nullptr, nullptr);
                hprep_regs<false>(w, t + 1, lane, am, bm, H, (const LAS unsigned char*)nullptr, nullptr); } }
#endif

    }
    SEAM(1);
    for (int l = 0; l < NL; ++l) {
        const int pb = 2 + 9 * l;
        const float* ada_l = ADA + (size_t)l * NB * 6144;
        asm volatile(".rept 11\n s_nop 0\n .endr");
        if (IN(pb + 0)) for (int rep_ = 0; rep_ < REPS_L(0); ++rep_) { PHASE_IDS;

#ifndef SKIP_WIN
            pg8::Gemm g{H, (const bf16_t*)(ws + WS_WIN) + (size_t)l * NIN * DM, MT, NIN, DM, 0}; pg8::StaticOrder S; S.init(MT, NIN, G, bx); S.rev = 1;
            pg8::EpiWin E{Q, YT, UV, GATES, (const float*)(ws + WS_ROPE), L};
            pg8::gemm_phase<pg8::EpiWin, pg8::StaticOrder, true, true>(L, g, S, E);
#endif

        }
        SEAM(pb + 0);
        asm volatile(".rept 10\n s_nop 0\n .endr");
        if (IN(pb + 1)) for (int rep_ = 0; rep_ < REPS_L(1); ++rep_) { PHASE_IDS;
            float lam;
            { const float* q1 = a.in[8] + l * 64; const float* k1 = a.in[9] + l * 64; const float* q2 = a.in[10] + l * 64; const float* k2 = a.in[11] + l * 64;
              float d1 = q1[lane] * k1[lane], d2 = q2[lane] * k2[lane]; d1 = wave_sum(d1); d2 = wave_sum(d2); lam = expf(d1) - expf(d2) + a.lam_init[l]; }
            const float oscale = 1.0f - a.lam_init[l];

#ifndef SKIP_ATT
#if ATT_DUAL
            for (int rep2_ = 0; rep2_ < REPS_L(9); ++rep2_) att2::attn2_items(vcu, G, Q, Kb, V, AOUT, lam, oscale, a.in[12] + l * 128, (char*)lds);
#else
            for (int rep2_ = 0; rep2_ < REPS_L(9); ++rep2_)
            for (int it = vcu; it < NB * 8 * 16; it += G) { const int qb = it & 15, h = (it >> 4) & 7, b = it >> 7;
                const size_t qo = ((size_t)b * SEQ + qb * 128) * DM + h * 128, ko = (size_t)b * SEQ * DM + h * 128;
                att::attn_item(Q + qo, Kb + ko, V + ko, AOUT + qo, lam, oscale, a.in[12] + l * 128, (char*)lds); }
#endif
#endif


#ifndef SKIP_DFT
            for (int rep3_ = 0; rep3_ < REPS_L(10); ++rep3_)
            { pg8::Gemm g{(const bf16_t*)(ws + WS_DFTC), YT, 4096, 8192, SEQ, 0}; pg8::GroupOrder S; S.init(16, 8, 2, G, bx, 1); pg8::EpiDft E{BOUT};
              pg8::gemm_phase<pg8::EpiDft, pg8::GroupOrder, true, true>(L, g, S, E); }
#endif


#ifndef SKIP_GMLP
            for (int rep4_ = 0; rep4_ < REPS_L(11); ++rep4_)
            for (int it = vcu; it < NB * 16 * 4; it += G) gmlp_item(it, UV, a.in[13] + (size_t)l * 4 * 128 * 128, a.in[14] + (size_t)l * 4 * 128, COUT, L, tid);
#endif

        }
        SEAM(pb + 1);
        if (IN(pb + 2)) for (int rep_ = 0; rep_ < REPS_L(2); ++rep_) { PHASE_IDS;
            pg8::StaticOrder S; S.init(MT, DM, G, bx);

#ifndef SKIP_PROJ
            { pg8::Gemm g{AOUT, (const bf16_t*)(ws + WS_PA) + (size_t)l * 1024 * 1024, MT, DM, 1024, 0}; pg8::EpiProj<0> E{GATES, T1, T2, MERGED}; pg8::gemm_phase<pg8::EpiProj<0>, pg8::StaticOrder, false, true>(L, g, S, E); }
            { pg8::Gemm g{BOUT, (const bf16_t*)(ws + WS_PB) + (size_t)l * 1024 * 1024, MT, DM, 1024, 0}; pg8::EpiProj<1> E{GATES, T1, T2, MERGED}; pg8::gemm_phase<pg8::EpiProj<1>, pg8::StaticOrder, false, true>(L, g, S, E); }
            { pg8::Gemm g{COUT, (const bf16_t*)(ws + WS_PC) + (size_t)l * 1024 * 512, MT, DM, 512, 0}; pg8::EpiProj<2> E{GATES, T1, T2, MERGED}; pg8::gemm_phase<pg8::EpiProj<2>, pg8::StaticOrder, false, true>(L, g, S, E); }
#endif

        }
        SEAM(pb + 2);
        if (IN(pb + 3)) for (int rep_ = 0; rep_ < REPS_L(3); ++rep_) { PHASE_IDS;
            pg8::Gemm g{MERGED, (const bf16_t*)(ws + WS_WOUT) + (size_t)l * 1024 * 1024, MT, DM, 1024, 0}; pg8::StaticOrder S; S.init(MT, DM, G, bx);

#ifndef SKIP_WOUT
            pg8::EpiWout E{l == 0 ? x_in : (const float*)X, X, ada_l + 2048};
            pg8::gemm_phase<pg8::EpiWout, pg8::StaticOrder, false, true>(L, g, S, E);
#endif

        }
        SEAM(pb + 3);
        if (IN(pb + 4)) for (int rep_ = 0; rep_ < REPS_L(4); ++rep_) { PHASE_IDS;

#ifndef SKIP_HP2
            stage_router(a.in[19] + (size_t)l * DM * NE, L, tid);
            for (int t0 = 8 * gw; t0 < MT; t0 += 8 * NGW) {
                f32x4 am[4], bm[4]; mod_load(am, bm, g_ffn + l * DM, ada_l + (size_t)(t0 >> 11) * 6144, 3072, 4096, lane);
#pragma unroll 1
                for (int p = 0; p < 4; ++p) { const int t = t0 + 2 * p; const f32x4* xr = (const f32x4*)(X + (size_t)t * DM) + lane; f32x4 v[4], w[4];
#pragma unroll
                    for (int j = 0; j < 4; ++j) { v[j] = xr[64 * j]; w[j] = xr[256 + 64 * j]; }
                    hprep_regs<true>(v, t, lane, am, bm, H, L, AFF);
                    hprep_regs<true>(w, t + 1, lane, am, bm, H, L, AFF); } }
#endif

        }
        SEAM(pb + 4);

#ifndef SKIP_TOPK
        if (IN(pb + 5)) for (int rep_ = 0; rep_ < REPS_L(5); ++rep_) { PHASE_IDS; for (int it = bx; it < 2 * NB * NE; it += G) topk_gather_item(it >> 1, it & 1, AFF, SEL, H, XIN, L, tid); }
#endif

        SEAM(pb + 5);
        asm volatile(".rept 2\n s_nop 0\n .endr");
        if (IN(pb + 6)) for (int rep_ = 0; rep_ < REPS_L(6); ++rep_) { PHASE_IDS;

#ifndef SKIP_G1
            pg8::Gemm g{XIN, (const bf16_t*)(ws + WS_W13) + (size_t)l * NE * NFT * 256 * DM, NE * 2048, NE * NFT * 256, DM, 0}; pg8::GroupOrder S; S.init(NE, 8, NFT, G, bx, 0); pg8::EpiG1 E{HID};
            pg8::gemm_phase<pg8::EpiG1, pg8::GroupOrder, true, true>(L, g, S, E);
#endif

        }
        SEAM(pb + 6);
        if (IN(pb + 7)) for (int rep_ = 0; rep_ < REPS_L(7); ++rep_) { PHASE_IDS;

#ifndef SKIP_G2
            pg8::Gemm g{HID, (const bf16_t*)(ws + WS_W2) + (size_t)l * NE * DM * FFL, NE * 2048, NE * DM, FFP, FFL}; pg8::GroupOrder S; S.init(NE, 8, 4, G, bx, 0); pg8::EpiG2 E{(bf16_t*)Y};
            pg8::gemm_phase<pg8::EpiG2, pg8::GroupOrder, true, true>(L, g, S, E);
#endif

        }
        SEAM(pb + 7);
        if (IN(pb + 8)) for (int rep_ = 0; rep_ < REPS_L(8); ++rep_) { PHASE_IDS;

#ifndef SKIP_COMB
            const bool last = (l + 1 == NL);
            for (int t0 = 8 * gw; t0 < MT; t0 += 8 * NGW) {
                const int b = t0 >> 11;
                f32x4 gr[4], am[4], bm[4];
#pragma unroll
                for (int q = 0; q < 4; ++q) gr[q] = *((const f32x4*)(ada_l + (size_t)b * 6144 + 5120) + lane + 64 * q);
                if (!last) mod_load(am, bm, g_mix + (l + 1) * DM, ADA + ((size_t)(l + 1) * NB + b) * 6144, 0, 1024, lane);
                else {
#pragma unroll
                    for (int q = 0; q < 4; ++q) { am[q] = *((const f32x4*)a.in[23] + lane + 64 * q); bm[q] = (f32x4){0.f, 0.f, 0.f, 0.f}; } }
                int jn = -1; float gn = 0.f; f32x4 xn[4];
                { const int s0 = t0 & 2047; if (lane < NE) { jn = SEL[((size_t)b * NE + lane) * SEQ + s0]; gn = AFF[((size_t)b * NE + lane) * SEQ + s0]; }
#pragma unroll
                  for (int q = 0; q < 4; ++q) xn[q] = *((const f32x4*)(X + (size_t)t0 * DM) + lane + 64 * q); }
#pragma unroll 1
                for (int i = 0; i < 8; ++i) { const int t = t0 + i;
                    const int jv = jn; const float gvv = gn; f32x4 xc[4];
#pragma unroll
                    for (int q = 0; q < 4; ++q) xc[q] = xn[q];
                    if (i + 1 < 8) { const int s1 = (t + 1) & 2047; if (lane < NE) { jn = SEL[((size_t)b * NE + lane) * SEQ + s1]; gn = AFF[((size_t)b * NE + lane) * SEQ + s1]; }
#pragma unroll
                        for (int q = 0; q < 4; ++q) xn[q] = *((const f32x4*)(X + (size_t)(t + 1) * DM) + lane + 64 * q); }
                    f32x4 acc[4];
#pragma unroll
                    for (int q = 0; q < 4; ++q) acc[q] = (f32x4){0.f, 0.f, 0.f, 0.f};
                    unsigned long long msk = __ballot(jv >= 0);
                    while (msk) {
                        const int e0 = __builtin_ctzll(msk); msk &= msk - 1; const bool two = msk != 0ull; const int e1 = two ? __builtin_ctzll(msk) : e0; if (two) msk &= msk - 1;
                        const int j0 = __builtin_amdgcn_readlane(jv, e0), j1 = __builtin_amdgcn_readlane(jv, e1);
                        const float g0 = __builtin_bit_cast(float, __builtin_amdgcn_readlane(__builtin_bit_cast(int, gvv), e0)), g1 = two ? __builtin_bit_cast(float, __builtin_amdgcn_readlane(__builtin_bit_cast(int, gvv), e1)) : 0.f;
                        const unsigned long long* y0 = (const unsigned long long*)((const bf16_t*)Y + ((size_t)e0 * 2048 + b * CAP + j0) * DM) + lane; const unsigned long long* y1 = (const unsigned long long*)((const bf16_t*)Y + ((size_t)e1 * 2048 + b * CAP + j1) * DM) + lane;
                        unsigned long long r0[4], r1[4];
#pragma unroll
                        for (int q = 0; q < 4; ++q) { r0[q] = y0[64 * q]; r1[q] = y1[64 * q]; }
#pragma unroll
                        for (int q = 0; q < 4; ++q) { const unsigned a0 = (unsigned)r0[q], a1 = (unsigned)(r0[q] >> 32), b0 = (unsigned)r1[q], b1 = (unsigned)(r1[q] >> 32);
                            const f32x4 ya = {__builtin_bit_cast(float, a0 << 16), __builtin_bit_cast(float, a0 & 0xffff0000u), __builtin_bit_cast(float, a1 << 16), __builtin_bit_cast(float, a1 & 0xffff0000u)};
                            const f32x4 yb = {__builtin_bit_cast(float, b0 << 16), __builtin_bit_cast(float, b0 & 0xffff0000u), __builtin_bit_cast(float, b1 << 16), __builtin_bit_cast(float, b1 & 0xffff0000u)};
                            acc[q] += ya * g0; acc[q] += yb * g1; }
                    }
                    f32x4 v[4];
#pragma unroll
                    for (int q = 0; q < 4; ++q) v[q] = xc[q] + gr[q] * acc[q];
                    if (!last) {
#pragma unroll
                        for (int q = 0; q < 4; ++q) *((f32x4*)(X + (size_t)t * DM) + lane + 64 * q) = v[q];
                        hprep_regs<false>(v, t, lane, am, bm, H, (const LAS unsigned char*)nullptr, nullptr);
                    } else {
                        float ss = 0.f;
#pragma unroll
                        for (int q = 0; q < 4; ++q) ss += (v[q].x * v[q].x + v[q].y * v[q].y) + (v[q].z * v[q].z + v[q].w * v[q].w);
                        const float r = 1.0f / sqrtf(wave_sum(ss) * (1.0f / DM) + EPS);
#pragma unroll
                        for (int q = 0; q < 4; ++q) ((f32x4*)(a.out + (size_t)t * DM))[lane + 64 * q] = v[q] * r * am[q];
                    }
                }
            }
#endif

        }
        if (l + 1 < NL) SEAM(pb + 8);
    }
#undef IN
#undef SEAM
}

__global__ __launch_bounds__(512) void k_prologue(const float* x, const float* c, const int* positions, const float* w_ada, const float* b_ada, ConvPtrs P, InvF IF) {
    extern __shared__ __attribute__((aligned(16))) unsigned char lds[];
    const int tid = threadIdx.x, lane = tid & 63, wave = tid >> 6;
    unsigned char* ws = P.ws;
    const size_t gt = (size_t)blockIdx.x * 512 + tid, GT = (size_t)gridDim.x * 512;
    for (size_t i = gt; i < (size_t)MT * DM / 4; i += GT) ((f32x4*)(ws + WS_X))[i] = ((const f32x4*)x)[i];
    for (size_t i = gt; i < (size_t)MT * 8; i += GT) rope_entry((int)i, positions, (float*)(ws + WS_ROPE), IF);
    for (size_t i = gt; i < (size_t)2048 * 256; i += GT) dft_entry8((int)i, (bf16_t*)(ws + WS_DFTC), (bf16_t*)(ws + WS_DFTS));
    for (size_t i = gt; i < (size_t)NL * NE * PAD_CH; i += GT) pad_chunk(i, ws);
    for (int it = blockIdx.x; it < NL * 96; it += gridDim.x) ada_item(it, c, w_ada, b_ada, (float*)(ws + WS_CTL + CTL_ADA), (LAS float*)lds, tid);
    for (int it = blockIdx.x; it < NL * 4 * 16; it += gridDim.x) fold_item(it, P.w_in, (bf16_t*)(ws + WS_WIN), (LAS float*)lds, tid);
    __syncthreads();
    LAS float* scr = (LAS float*)(lds) + wave * (64 * 65);
    for (int it = blockIdx.x * 8 + wave; it < CV_TOTAL; it += gridDim.x * 8) conv_item(it, P, scr, lane);
}

template <bool ROUTER>
__global__ __launch_bounds__(256) void k_hprep(const float* X, const float* gain, const float* ADA, int sh_off, int sc_off, bf16_t* H, const float* w_router, float* AFF) {
    const int lane = threadIdx.x & 63; const int gw = blockIdx.x * 4 + (threadIdx.x >> 6), NGW = gridDim.x * 4;
    for (int t = gw; t < MT; t += NGW) {
        const int b = t >> 11;
        const f32x4* xr = (const f32x4*)(X + (size_t)t * DM) + lane;
        f32x4 v[4]; float ss = 0.f;
#pragma unroll
        for (int j = 0; j < 4; ++j) { v[j] = xr[64 * j]; ss += (v[j].x * v[j].x + v[j].y * v[j].y) + (v[j].z * v[j].z + v[j].w * v[j].w); }
        const float r = 1.0f / sqrtf(wave_sum(ss) * (1.0f / DM) + EPS);
        float lg[NE];
        if (ROUTER) {
#pragma unroll
            for (int e = 0; e < NE; ++e) lg[e] = 0.f; }
#pragma unroll
        for (int j = 0; j < 4; ++j) { const int col = 4 * lane + 256 * j;
            const f32x4 g4 = *(const f32x4*)(gain + col), sh = *(const f32x4*)(ADA + b * 6144 + sh_off + col), sc = *(const f32x4*)(ADA + b * 6144 + sc_off + col);
            f32x4 h; h.x = v[j].x * r * g4.x * (1.f + sc.x) + sh.x; h.y = v[j].y * r * g4.y * (1.f + sc.y) + sh.y; h.z = v[j].z * r * g4.z * (1.f + sc.z) + sh.z; h.w = v[j].w * r * g4.w * (1.f + sc.w) + sh.w;
            *(unsigned long long*)(H + (size_t)t * DM + col) = (unsigned long long)pk2(h.x, h.y) | ((unsigned long long)pk2(h.z, h.w) << 32);
            if (ROUTER) {
#pragma unroll
                for (int q = 0; q < 4; ++q) { const float hv = h[q]; const f32x4* wr = (const f32x4*)(w_router + (size_t)(col + q) * NE);
#pragma unroll
                    for (int e4 = 0; e4 < 4; ++e4) { const f32x4 w = wr[e4]; lg[e4 * 4 + 0] += hv * w.x; lg[e4 * 4 + 1] += hv * w.y; lg[e4 * 4 + 2] += hv * w.z; lg[e4 * 4 + 3] += hv * w.w; } } }
        }
        if (ROUTER) {
            float mx = -1e30f;
#pragma unroll
            for (int e = 0; e < NE; ++e) { lg[e] = wave_sum(lg[e]); mx = fmaxf(mx, lg[e]); }
            float den = 0.f;
#pragma unroll
            for (int e = 0; e < NE; ++e) { lg[e] = expf(lg[e] - mx); den += lg[e]; }
            const float inv = 1.0f / den; const int s = t & 2047;
#pragma unroll
            for (int e = 0; e < NE; ++e) if (lane == e) AFF[((size_t)b * NE + e) * SEQ + s] = lg[e] * inv;
        }
    }
}

struct GemmP { const bf16_t* A; const bf16_t* Bt; size_t strideA, strideB; int K, lda, ldb, pad; };
template <class Epi, bool PAIR>
__global__ __launch_bounds__(256) void k_gemm(GemmP g, Epi epi) {
    const int tid = threadIdx.x, wid = tid >> 6, lane = tid & 63, wr = wid >> 1, wc = wid & 1, fr = lane & 15, fq = lane >> 4;
    const int z = blockIdx.z, bx = blockIdx.x;
    const bf16_t* A = g.A + (size_t)z * g.strideA; const bf16_t* Bt = g.Bt + (size_t)z * g.strideB;
    const int row0 = blockIdx.y * 128 + wr * 64;
    int bcol[4];
#pragma unroll
    for (int j = 0; j < 4; ++j) bcol[j] = PAIR ? ((bx >> 1) * 256 + (bx & 1) * 64 + wc * 32 + (j & 1) * 16 + (j >> 1) * 128) : (bx * 128 + wc * 64 + j * 16);
    f32x4 acc[4][4];
#pragma unroll
    for (int i = 0; i < 4; ++i)
#pragma unroll
        for (int j = 0; j < 4; ++j) acc[i][j] = (f32x4){0.f, 0.f, 0.f, 0.f};
    for (int k0 = 0; k0 < g.K; k0 += 32) {
        bf16x8 a[4], b[4];
#pragma unroll
        for (int i = 0; i < 4; ++i) a[i] = *(const bf16x8*)(A + (size_t)(row0 + i * 16 + fr) * g.lda + k0 + fq * 8);
#pragma unroll
        for (int j = 0; j < 4; ++j) b[j] = *(const bf16x8*)(Bt + (size_t)(bcol[j] + fr) * g.ldb + k0 + fq * 8);
#pragma unroll
        for (int i = 0; i < 4; ++i)
#pragma unroll
            for (int j = 0; j < 4; ++j) acc[i][j] = __builtin_amdgcn_mfma_f32_16x16x32_bf16(a[i], b[j], acc[i][j], 0, 0, 0);
    }
#pragma unroll
    for (int i = 0; i < 4; ++i)
#pragma unroll
        for (int r = 0; r < 4; ++r) { const int row = row0 + i * 16 + fq * 4 + r;
            if constexpr (PAIR) {
#pragma unroll
                for (int j = 0; j < 2; ++j) epi.pair(z, row, (bx >> 1) * 128 + (bx & 1) * 64 + wc * 32 + j * 16 + fr, acc[i][j][r], acc[i][j + 2][r]);
            } else {
#pragma unroll
                for (int j = 0; j < 4; ++j) epi(z, row, bcol[j] + fr, acc[i][j][r]);
            } }
}
struct EWin { bf16_t *Q, *K, *V, *YT, *UV, *GATES;
    __device__ __forceinline__ void operator()(int, int t, int n, float v) const {
        if (n < 1024) Q[(size_t)t * DM + n] = (bf16_t)f2bf(v);
        else if (n < 2048) K[(size_t)t * DM + n - 1024] = (bf16_t)f2bf(v);
        else if (n < 3072) V[(size_t)t * DM + n - 2048] = (bf16_t)f2bf(v);
        else if (n < 4096) { const int g = (n - 3072) >> 8, nl = n & 255, part = nl >> 7, cp = nl & 127, b = t >> 11, pos = t & 2047;
            YT[((size_t)(b * 2 + part) * 512 + g * 128 + cp) * SEQ + pos] = (bf16_t)f2bf(v); }
        else if (n < 5120) UV[(size_t)t * 1024 + n - 4096] = (bf16_t)f2bf(gelu_tanh_f(v));
        else GATES[(size_t)t * 3072 + n - 5120] = (bf16_t)f2bf(sigmoid_f(v)); } };
struct EDftP { bf16_t* BOUT; int part, pad;
    __device__ __forceinline__ void operator()(int b, int m, int n, float v) const { BOUT[((size_t)b * SEQ + m) * 1024 + part * 512 + n] = (bf16_t)f2bf(v); } };
template <int WHICH> struct EProj { const bf16_t* GATES; bf16_t* T1; bf16_t* OUT;
    __device__ __forceinline__ void operator()(int, int t, int n, float v) const {
        const float g = bf2f(GATES[(size_t)t * 3072 + WHICH * 1024 + n]); const size_t o = (size_t)t * DM + n;
        if (WHICH == 0) T1[o] = (bf16_t)f2bf(g * v); else if (WHICH == 1) T1[o] = (bf16_t)f2bf(bf2f(T1[o]) + g * v); else OUT[o] = (bf16_t)f2bf(bf2f(T1[o]) + g * v); } };
struct EWout { float* X; const float* gt;
    __device__ __forceinline__ void operator()(int, int t, int n, float v) const { X[(size_t)t * DM + n] += gt[(t >> 11) * 6144 + n] * v; } };
struct EG1 { bf16_t* HID;
    __device__ __forceinline__ void operator()(int, int, int, float) const {}
    __device__ __forceinline__ void pair(int e, int row, int f, float a, float b) const { HID[((size_t)e * 2048 + row) * FFL + f] = (bf16_t)f2bf(silu_f(a) * b); } };
struct EG2 { float* Y;
    __device__ __forceinline__ void operator()(int e, int row, int n, float v) const { Y[((size_t)e * 2048 + row) * DM + n] = v; } };

__global__ __launch_bounds__(256) void k_rope(bf16_t* Q, bf16_t* K, const float* ROPE) {
    const size_t idx = (size_t)blockIdx.x * 256 + threadIdx.x; if (idx >= (size_t)MT * 256) return;
    const int i = idx & 7, c = (idx >> 3) & 1, h = (idx >> 4) & 7, which = (idx >> 7) & 1; const size_t t = idx >> 8;
    bf16_t* p = (which ? K : Q) + t * DM + h * 128 + c * 64 + i;
    const float a = bf2f(p[0]), b = bf2f(p[8]), cs = ROPE[t * 16 + i], sn = ROPE[t * 16 + 8 + i];
    p[0] = (bf16_t)f2bf(a * cs - b * sn); p[8] = (bf16_t)f2bf(a * sn + b * cs);
}
__global__ __launch_bounds__(128) void k_attn_naive(const bf16_t* Q, const bf16_t* K, const bf16_t* V, bf16_t* AOUT, const float* lq1, const float* lk1, const float* lq2, const float* lk2, const float* a_norm_g, float lam_init) {
    __shared__ float smem[16384];
    float (*Ks)[32][64] = (float (*)[32][64])smem;
    float (*Vs)[128] = (float (*)[128])(smem + 4096);
    float (*Ox)[129] = (float (*)[129])smem;
    const int bx = blockIdx.x, qblk = bx & 31, h = (bx >> 5) & 7, b = bx >> 8, tid = threadIdx.x, c = tid >> 6, qi = tid & 63;
    const size_t t = (size_t)b * SEQ + qblk * 64 + qi;
    float q[64], o[128];
#pragma unroll
    for (int d = 0; d < 64; ++d) q[d] = bf2f(Q[t * DM + h * 128 + c * 64 + d]) * (0.125f * 1.4426950408889634f);
#pragma unroll
    for (int d = 0; d < 128; ++d) o[d] = 0.f;
    float m = -1e30f, lsum = 0.f;
    for (int kt = 0; kt < SEQ / 32; ++kt) {
        __syncthreads();
        for (int idx = tid; idx < 32 * 128; idx += 128) { const int key = idx >> 7, d = idx & 127; const size_t src = ((size_t)b * SEQ + kt * 32 + key) * DM + h * 128 + d;
            Ks[d >> 6][key][d & 63] = bf2f(K[src]); Vs[key][d] = bf2f(V[src]); }
        __syncthreads();
        for (int j = 0; j < 32; ++j) {
            float s = 0.f;
#pragma unroll
            for (int d = 0; d < 64; ++d) s += q[d] * Ks[c][j][d];
            if (s > m) { const float al = exp2f(m - s);
#pragma unroll
                for (int d = 0; d < 128; ++d) o[d] *= al;
                lsum *= al; m = s; }
            const float p = exp2f(s - m); lsum += p;
#pragma unroll
            for (int d = 0; d < 128; ++d) o[d] += p * Vs[j][d];
        }
    }
    const float inv = 1.0f / lsum;
    __syncthreads();
    if (c == 1) {
#pragma unroll
        for (int d = 0; d < 128; ++d) Ox[qi][d] = o[d] * inv; }
    __syncthreads();
    if (c == 0) {
        float d1 = 0.f, d2 = 0.f;
        for (int d = 0; d < 64; ++d) { d1 += lq1[d] * lk1[d]; d2 += lq2[d] * lk2[d]; }
        const float lam = expf(d1) - expf(d2) + lam_init;
        float ss = 0.f;
#pragma unroll
        for (int d = 0; d < 128; ++d) { o[d] = o[d] * inv - lam * Ox[qi][d]; ss += o[d] * o[d]; }
        const float r = (1.0f - lam_init) / sqrtf(ss * (1.0f / 128.0f) + EPS);
#pragma unroll
        for (int d = 0; d < 128; ++d) AOUT[t * DM + h * 128 + d] = (bf16_t)f2bf(o[d] * r * a_norm_g[d]);
    }
}
__global__ __launch_bounds__(256) void k_gmlp_naive(const bf16_t* UV, const float* w_s, const float* b_s, bf16_t* COUT) {
    __shared__ float vg[128][128];
    const int bx = blockIdx.x, g = bx & 3, n = (bx >> 2) & 15, b = bx >> 6, tid = threadIdx.x;
    const size_t t0 = (size_t)b * SEQ + n * 128;
    { const int qr = tid >> 1, hf = tid & 1; float v[64]; float ss = 0.f;
#pragma unroll
      for (int cc = 0; cc < 64; ++cc) { v[cc] = bf2f(UV[(t0 + qr) * 1024 + 512 + g * 128 + hf * 64 + cc]); ss += v[cc] * v[cc]; }
      ss += __shfl_xor(ss, 1);
      const float r = 1.0f / sqrtf(ss * (1.0f / 128.0f) + EPS);
#pragma unroll
      for (int cc = 0; cc < 64; ++cc) vg[qr][hf * 64 + cc] = v[cc] * r; }
    __syncthreads();
    const int p = tid >> 1, ch0 = (tid & 1) * 64;
    float acc[64];
#pragma unroll
    for (int cc = 0; cc < 64; ++cc) acc[cc] = 0.f;
    const float* wrow = w_s + ((size_t)g * 128 + p) * 128;
    for (int qq = 0; qq < 128; ++qq) { const float w = wrow[qq];
#pragma unroll
        for (int cc = 0; cc < 64; ++cc) acc[cc] += w * vg[qq][ch0 + cc]; }
    const float bias = b_s[g * 128 + p];
#pragma unroll
    for (int cc = 0; cc < 64; ++cc) { const float u = bf2f(UV[(t0 + p) * 1024 + g * 128 + ch0 + cc]); COUT[(t0 + p) * 512 + g * 128 + ch0 + cc] = (bf16_t)f2bf(u * (acc[cc] + bias)); }
}
__global__ __launch_bounds__(512) void k_topk(const float* AFF, int* SEL, int* IDX) {
    __shared__ float v[SEQ];
    const int pair = blockIdx.x >> 1, half = blockIdx.x & 1, tid = threadIdx.x;
    for (int i = tid; i < SEQ; i += 512) v[i] = AFF[(size_t)pair * SEQ + i];
    __syncthreads();
    for (int ii = 0; ii < 2; ++ii) { const int i = half * 1024 + ii * 512 + tid; const float x = v[i]; int rank = 0;
        for (int j = 0; j < SEQ; ++j) { const float y = v[j]; rank += ((y > x) || (y == x && j < i)) ? 1 : 0; }
        SEL[(size_t)pair * SEQ + i] = rank < CAP ? rank : -1;
        if (rank < CAP) IDX[pair * CAP + rank] = i; }
}
__global__ __launch_bounds__(256) void k_gather(const bf16_t* H, const int* IDX, bf16_t* XIN) {
    const int lane = threadIdx.x & 63; const int gw = blockIdx.x * 4 + (threadIdx.x >> 6), NGW = gridDim.x * 4;
    for (int r = gw; r < NE * 2048; r += NGW) { const int e = r >> 11, b = (r >> 8) & 7, j = r & 255; const int s = IDX[(b * NE + e) * CAP + j];
        const u32x4* src = (const u32x4*)(H + ((size_t)b * SEQ + s) * DM); u32x4* dst = (u32x4*)(XIN + (size_t)r * DM);
        dst[lane] = src[lane]; dst[lane + 64] = src[lane + 64]; }
}
__global__ __launch_bounds__(256) void k_combine(float* X, const float* Y, const int* SEL, const float* AFF, const float* gt2) {
    const int lane = threadIdx.x & 63; const int gw = blockIdx.x * 4 + (threadIdx.x >> 6), NGW = gridDim.x * 4;
    for (int t = gw; t < MT; t += NGW) { const int b = t >> 11, s = t & 2047;
        f32x4 acc[4];
#pragma unroll
        for (int j = 0; j < 4; ++j) acc[j] = (f32x4){0.f, 0.f, 0.f, 0.f};
        for (int e = 0; e < NE; ++e) { const int j = SEL[((size_t)b * NE + e) * SEQ + s];
            if (j >= 0) { const float g = AFF[((size_t)b * NE + e) * SEQ + s]; const f32x4* yr = (const f32x4*)(Y + ((size_t)e * 2048 + b * 256 + j) * DM) + lane;
#pragma unroll
                for (int q = 0; q < 4; ++q) acc[q] += yr[64 * q] * g; } }
        f32x4* xr = (f32x4*)(X + (size_t)t * DM) + lane; const f32x4* gr = (const f32x4*)(gt2 + b * 6144) + lane;
#pragma unroll
        for (int q = 0; q < 4; ++q) xr[64 * q] = xr[64 * q] + gr[64 * q] * acc[q];
    }
}
__global__ __launch_bounds__(256) void k_final(const float* X, const float* gain, float* out) {
    const int lane = threadIdx.x & 63; const int gw = blockIdx.x * 4 + (threadIdx.x >> 6), NGW = gridDim.x * 4;
    for (int t = gw; t < MT; t += NGW) {
        const f32x4* xr = (const f32x4*)(X + (size_t)t * DM) + lane; f32x4 v[4]; float ss = 0.f;
#pragma unroll
        for (int j = 0; j < 4; ++j) { v[j] = xr[64 * j]; ss += (v[j].x * v[j].x + v[j].y * v[j].y) + (v[j].z * v[j].z + v[j].w * v[j].w); }
        const float r = 1.0f / sqrtf(wave_sum(ss) * (1.0f / DM) + EPS);
#pragma unroll
        for (int j = 0; j < 4; ++j) { const f32x4 g4 = *((const f32x4*)gain + lane + 64 * j); ((f32x4*)(out + (size_t)t * DM))[lane + 64 * j] = v[j] * r * g4; }
    }
}

#ifndef MEGA_MASK
#define MEGA_MASK 0x7fbff
#endif
#ifndef MEGA_MERGE
#define MEGA_MERGE 0
#endif
static void v1_launch(void* const* d_in, void* d_out, unsigned char* ws, InvF IF, hipStream_t stream, unsigned mask, int merge, MArgs a, int grid) {
    const float* x = (const float*)d_in[0]; const float* c = (const float*)d_in[1]; const int* positions = (const int*)d_in[2];
    const float* w_ada = (const float*)d_in[3]; const float* b_ada = (const float*)d_in[4]; const float* g_mix = (const float*)d_in[5]; const float* g_ffn = (const float*)d_in[6];
    const float* w_in = (const float*)d_in[7]; const float* lq1 = (const float*)d_in[8]; const float* lk1 = (const float*)d_in[9]; const float* lq2 = (const float*)d_in[10]; const float* lk2 = (const float*)d_in[11];
    const float* a_norm_g = (const float*)d_in[12]; const float* w_s = (const float*)d_in[13]; const float* b_s = (const float*)d_in[14];
    const float* p_a = (const float*)d_in[15]; const float* p_b = (const float*)d_in[16]; const float* p_c = (const float*)d_in[17]; const float* w_out = (const float*)d_in[18];
    const float* w_router = (const float*)d_in[19]; const float* w1 = (const float*)d_in[20]; const float* w3 = (const float*)d_in[21]; const float* w2 = (const float*)d_in[22]; const float* g_final = (const float*)d_in[23];
    ConvPtrs P{w_in, p_a, p_b, p_c, w_out, w1, w3, w2, ws};
    float* X = (float*)(ws + WS_X); bf16_t* H = (bf16_t*)(ws + WS_H); float* ADA = (float*)(ws + WS_CTL + CTL_ADA); float* ROPE = (float*)(ws + WS_ROPE);
    bf16_t *Q = (bf16_t*)(ws + WS_Q), *K = (bf16_t*)(ws + WS_K), *V = (bf16_t*)(ws + WS_V), *YT = (bf16_t*)(ws + WS_YT), *UV = (bf16_t*)(ws + WS_UV), *GATES = (bf16_t*)(ws + WS_GATES);
    bf16_t *AOUT = (bf16_t*)(ws + WS_AOUT), *BOUT = (bf16_t*)(ws + WS_BOUT), *COUT = (bf16_t*)(ws + WS_COUT), *T1 = (bf16_t*)(ws + WS_T1), *MERGED = (bf16_t*)(ws + WS_MERGED);
    bf16_t *XIN = (bf16_t*)(ws + WS_XIN), *HID = (bf16_t*)(ws + WS_HID); float* Y = (float*)(ws + WS_Y);
    int* SEL = (int*)(ws + WS_SEL); int* IDX = (int*)(ws + WS_IDX); float* AFF = (float*)(ws + WS_AFF);
    int n_mega = 0;
    for (int ph = 0; ph < N_PHASES; ++ph) {
        if ((mask >> ph) & 1u) {
#if (WIN_DBG & 0x6F) != 0x6F
            if (ph >= 2 && (ph - 2) % 9 == 0) { const int l = (ph - 2) / 9; GemmP g{H, (const bf16_t*)(ws + WS_WIN) + (size_t)l * NIN * DM, 0, 0, DM, DM, DM, 0}; EWin e{Q, K, V, YT, UV, GATES};
                hipLaunchKernelGGL((k_gemm<EWin, false>), dim3(NIN / 128, MT / 128, 1), dim3(256), 0, stream, g, e);
                hipLaunchKernelGGL(k_rope, dim3(MT), dim3(256), 0, stream, Q, K, (const float*)ROPE); }
#endif
            int hi = ph + 1; if (merge) while (hi < N_PHASES && ((mask >> hi) & 1u)) ++hi;
            a.ph_lo = ph; a.ph_hi = hi; a.li = n_mega++; a.pad = 0;
            hipLaunchKernelGGL(mega, dim3(grid), dim3(NWAVES * 64), LDS_TOTAL, stream, a);
#if (WIN_DBG >> 4) & 1
            if (ph >= 2 && (ph - 2) % 9 == 0) hipLaunchKernelGGL(k_rope, dim3(MT), dim3(256), 0, stream, Q, K, (const float*)ROPE);
#endif
            ph = hi - 1; continue;
        }
        if (ph == 0) { hipLaunchKernelGGL(k_prologue, dim3(1024), dim3(512), 8 * 64 * 65 * 4, stream, x, c, positions, w_ada, b_ada, P, IF); continue; }
        if (ph == 1) { hipLaunchKernelGGL(k_hprep<false>, dim3(1024), dim3(256), 0, stream, x, g_mix, (const float*)ADA, 0, 1024, H, (const float*)nullptr, (float*)nullptr); continue; }
        const int l = (ph - 2) / 9, k = (ph - 2) % 9;
        const float* ada_l = ADA + (size_t)l * NB * 6144;
        const float lam_init = (float)(0.8 - 0.6 * exp(-0.3 * (double)l));
        if (k == 0) { GemmP g{H, (const bf16_t*)(ws + WS_WIN) + (size_t)l * NIN * DM, 0, 0, DM, DM, DM, 0}; EWin e{Q, K, V, YT, UV, GATES};
            hipLaunchKernelGGL((k_gemm<EWin, false>), dim3(NIN / 128, MT / 128, 1), dim3(256), 0, stream, g, e);
            hipLaunchKernelGGL(k_rope, dim3(MT), dim3(256), 0, stream, Q, K, (const float*)ROPE); }
        else if (k == 1) {
            hipLaunchKernelGGL(k_attn_naive, dim3(NB * 8 * 32), dim3(128), 0, stream, (const bf16_t*)Q, (const bf16_t*)K, (const bf16_t*)V, AOUT, lq1 + l * 64, lk1 + l * 64, lq2 + l * 64, lk2 + l * 64, a_norm_g + l * 128, lam_init);
            for (int part = 0; part < 2; ++part) { GemmP gp{(const bf16_t*)(ws + (part ? WS_DFTS : WS_DFTC)), YT + (size_t)part * 512 * SEQ, 0, (size_t)2 * 512 * SEQ, SEQ, SEQ, SEQ, 0}; EDftP ep{BOUT, part, 0};
                hipLaunchKernelGGL((k_gemm<EDftP, false>), dim3(512 / 128, SEQ / 128, NB), dim3(256), 0, stream, gp, ep); }
            hipLaunchKernelGGL(k_gmlp_naive, dim3(NB * 16 * 4), dim3(256), 0, stream, (const bf16_t*)UV, w_s + (size_t)l * 4 * 128 * 128, b_s + (size_t)l * 4 * 128, COUT); }
        else if (k == 2) {
            { GemmP g{AOUT, (const bf16_t*)(ws + WS_PA) + (size_t)l * 1024 * 1024, 0, 0, 1024, 1024, 1024, 0}; EProj<0> e{GATES, T1, MERGED}; hipLaunchKernelGGL((k_gemm<EProj<0>, false>), dim3(8, MT / 128, 1), dim3(256), 0, stream, g, e); }
            { GemmP g{BOUT, (const bf16_t*)(ws + WS_PB) + (size_t)l * 1024 * 1024, 0, 0, 1024, 1024, 1024, 0}; EProj<1> e{GATES, T1, MERGED}; hipLaunchKernelGGL((k_gemm<EProj<1>, false>), dim3(8, MT / 128, 1), dim3(256), 0, stream, g, e); }
            { GemmP g{COUT, (const bf16_t*)(ws + WS_PC) + (size_t)l * 1024 * 512, 0, 0, 512, 512, 512, 0}; EProj<2> e{GATES, T1, MERGED}; hipLaunchKernelGGL((k_gemm<EProj<2>, false>), dim3(8, MT / 128, 1), dim3(256), 0, stream, g, e); } }
        else if (k == 3) { if (l == 0) (void)hipMemcpyAsync(X, x, (size_t)MT * DM * 4, hipMemcpyDeviceToDevice, stream);
            GemmP g{MERGED, (const bf16_t*)(ws + WS_WOUT) + (size_t)l * 1024 * 1024, 0, 0, 1024, 1024, 1024, 0}; EWout e{X, ada_l + 2048};
            hipLaunchKernelGGL((k_gemm<EWout, false>), dim3(8, MT / 128, 1), dim3(256), 0, stream, g, e); }
        else if (k == 4) hipLaunchKernelGGL(k_hprep<true>, dim3(1024), dim3(256), 0, stream, (const float*)X, g_ffn + l * DM, ada_l, 3072, 4096, H, w_router + (size_t)l * DM * NE, AFF);
        else if (k == 5) { hipLaunchKernelGGL(k_topk, dim3(NB * NE * 2), dim3(512), 0, stream, (const float*)AFF, SEL, IDX);
            hipLaunchKernelGGL(k_gather, dim3(1024), dim3(256), 0, stream, (const bf16_t*)H, (const int*)IDX, XIN); }
        else if (k == 6) { GemmP g{XIN, (const bf16_t*)(ws + WS_W13) + (size_t)l * NE * NFT * 256 * DM, (size_t)2048 * DM, (size_t)NFT * 256 * DM, DM, DM, DM, 0}; EG1 e{HID};
            hipLaunchKernelGGL((k_gemm<EG1, true>), dim3(NFT * 2, 2048 / 128, NE), dim3(256), 0, stream, g, e); }
        else if (k == 7) { GemmP g{HID, (const bf16_t*)(ws + WS_W2) + (size_t)l * NE * DM * FFL, (size_t)2048 * FFL, (size_t)DM * FFL, FFP, FFL, FFL, 0}; EG2 e{Y};
            hipLaunchKernelGGL((k_gemm<EG2, false>), dim3(8, 2048 / 128, NE), dim3(256), 0, stream, g, e); }
        else { hipLaunchKernelGGL(k_combine, dim3(1024), dim3(256), 0, stream, X, (const float*)Y, (const int*)SEL, (const float*)AFF, ada_l + 5120);
            if (l + 1 < NL) hipLaunchKernelGGL(k_hprep<false>, dim3(1024), dim3(256), 0, stream, (const float*)X, g_mix + (l + 1) * DM, (const float*)(ADA + (size_t)(l + 1) * NB * 6144), 0, 1024, H, (const float*)nullptr, (float*)nullptr);
            else hipLaunchKernelGGL(k_final, dim3(1024), dim3(256), 0, stream, (const float*)X, g_final, (float*)d_out); }
    }
}

#ifndef KMODE
#define KMODE 0
#endif
extern "C" void kernel_launch(void* const* d_in, const int* in_sizes, int n_in, void* d_out, int out_size, void* d_ws, size_t ws_size, hipStream_t stream) {
    static int grid = 0;
    if (grid == 0) {
        if (n_in != 24 || in_sizes[0] != MT * DM || out_size != MT * DM || ws_size < WS_END) { fprintf(stderr, "kernel_launch: unexpected shapes (n_in %d, in0 %d, out %d, ws %zu)\n", n_in, n_in > 0 ? in_sizes[0] : -1, out_size, ws_size); grid = -1; return; }
        int dev = 0, cus = 0, per_cu = 0;
        if (hipGetDevice(&dev) != hipSuccess || hipDeviceGetAttribute(&cus, hipDeviceAttributeMultiprocessorCount, dev) != hipSuccess) { grid = -1; return; }
        if (hipFuncSetAttribute((const void*)k_prologue, hipFuncAttributeMaxDynamicSharedMemorySize, 8 * 64 * 65 * 4) != hipSuccess) { fprintf(stderr, "kernel_launch: hipFuncSetAttribute failed\n"); grid = -1; return; }
        if (hipFuncSetAttribute((const void*)mega, hipFuncAttributeMaxDynamicSharedMemorySize, LDS_TOTAL) != hipSuccess) { fprintf(stderr, "kernel_launch: hipFuncSetAttribute(mega) failed\n"); grid = -1; return; }
        if (hipOccupancyMaxActiveBlocksPerMultiprocessor(&per_cu, (const void*)mega, NWAVES * 64, LDS_TOTAL) != hipSuccess || per_cu < 1) fprintf(stderr, "kernel_launch: note: occupancy query reports %d workgroups per CU\n", per_cu);
        (void)hipGetLastError();
        grid = cus;
    }
    if (grid < 0) return;
    unsigned char* ws = (unsigned char*)d_ws;
    (void)hipMemsetAsync(ws + WS_CTL, 0, CTL_ZERO_BYTES, stream);
    InvF IF{}; for (int i = 0; i < 8; ++i) IF.v[i] = (float)pow(500000.0, -(double)i / 8.0);
    MArgs a{};
    for (int i = 0; i < 24; ++i) a.in[i] = (const float*)d_in[i];
    a.out = (float*)d_out; a.ws = ws; a.invf = IF;
    for (int l = 0; l < NL; ++l) a.lam_init[l] = (float)(0.8 - 0.6 * exp(-0.3 * (double)l));
#if KMODE == 0
    a.ph_lo = 0; a.ph_hi = N_PHASES; a.li = 0;
    hipLaunchKernelGGL(mega, dim3(grid), dim3(NWAVES * 64), LDS_TOTAL, stream, a);
    { const hipError_t le = hipPeekAtLastError(); if (le != hipSuccess) fprintf(stderr, "kernel_launch: launch failed: %s\n", hipGetErrorName(le)); }
#elif KMODE == 1
    v1_launch(d_in, d_out, ws, IF, stream, 0u, 0, a, grid);
#else
    v1_launch(d_in, d_out, ws, IF, stream, (unsigned)(MEGA_MASK), MEGA_MERGE, a, grid);
#endif
}
```

```cpp
#include <hip/hip_runtime.h>
#include <cstdio>
#include <cstdint>
#include <cmath>

#ifndef ATT_DUAL
#define ATT_DUAL 1
#endif
#ifndef WIN_DBG
#define WIN_DBG 0x6F
#endif
#define LAS __attribute__((address_space(3)))
typedef unsigned short bf16_t;
typedef short bf16x8 __attribute__((ext_vector_type(8)));
typedef float f32x4 __attribute__((ext_vector_type(4)));
typedef unsigned u32x4 __attribute__((ext_vector_type(4)));

constexpr int NB = 8, SEQ = 2048, DM = 1024, NL = 2, MT = NB * SEQ;
constexpr int NIN = 8192, NIN_SRC = 7680;
constexpr int NE = 16, FF = 2752, FFP = 2816, FFL = 2880, CAP = 256, NFT = 22;
constexpr float EPS = 1e-6f;

constexpr size_t MiB = 1u << 20;
constexpr size_t WS_CTL = 0, CTL_ZERO_BYTES = 1 * MiB;
constexpr size_t CTL_ADA = 256 * 1024;
constexpr size_t WS_ROPE = 2 * MiB;
constexpr size_t WS_SEL = 3 * MiB;
constexpr size_t WS_AFF = 4 * MiB;
constexpr size_t WS_IDX = 5 * MiB;
constexpr size_t WS_WIN = 8 * MiB;
constexpr size_t WS_PA = 40 * MiB, WS_PB = 44 * MiB, WS_PC = 48 * MiB, WS_WOUT = 50 * MiB;
constexpr size_t WS_DFTC = 56 * MiB, WS_DFTS = 64 * MiB;
constexpr size_t WS_W13 = 72 * MiB;
constexpr size_t WS_W2 = 424 * MiB;
constexpr size_t WS_X = 608 * MiB;
constexpr size_t WS_H = 672 * MiB;
constexpr size_t WS_Q = 704 * MiB, WS_K = 736 * MiB, WS_V = 768 * MiB;
constexpr size_t WS_YT = 800 * MiB;
constexpr size_t WS_UV = 832 * MiB;
constexpr size_t WS_GATES = 864 * MiB;
constexpr size_t WS_AOUT = 960 * MiB, WS_BOUT = 992 * MiB, WS_COUT = 1024 * MiB;
constexpr size_t WS_T1 = 1040 * MiB, WS_MERGED = 1072 * MiB;
static_assert(WS_K - WS_Q == (32u << 20) && WS_V - WS_K == (32u << 20), "EpiWin: Q|K|V 32 MiB apart");
constexpr size_t WS_XIN = 704 * MiB;
constexpr size_t WS_HID = 768 * MiB;
constexpr size_t WS_Y = 952 * MiB;
constexpr size_t WS_T2 = 1104 * MiB;
constexpr size_t WS_END = 1136 * MiB;

__device__ __forceinline__ unsigned f2bf(float f) { unsigned u = __builtin_bit_cast(unsigned, f); return (u + 0x7fffu + ((u >> 16) & 1u)) >> 16; }
__device__ __forceinline__ unsigned pk2(float lo, float hi) { return f2bf(lo) | (f2bf(hi) << 16); }
__device__ __forceinline__ float bf2f(unsigned short b) { return __builtin_bit_cast(float, ((unsigned)b) << 16); }
__device__ __forceinline__ float wave_sum(float v) {
#pragma unroll
    for (int o = 1; o < 64; o <<= 1) v += __shfl_xor(v, o);
    return v;
}
__device__ __forceinline__ float sigmoid_f(float v) { return 1.0f / (1.0f + __expf(-v)); }
__device__ __forceinline__ float silu_f(float v) { return v / (1.0f + __expf(-v)); }
__device__ __forceinline__ float gelu_tanh_f(float v) {
    const float u = 0.7978845608028654f * (v + 0.044715f * v * v * v);
    const float e = __expf(2.0f * u);
    const float th = 1.0f - 2.0f / (e + 1.0f);
    return 0.5f * v * (1.0f + th);
}
__device__ inline void sincos_d(double x, double& s, double& c) {
    const double n = __builtin_rint(x * 0.63661977236758134308);
    double r = (x - n * 1.57079632673412561417e+00) - n * 6.07710050650619224932e-11;
    const double z = r * r;
    const double sp = r + r * z * (-1.66666666666666324348e-01 + z * (8.33333333332248946124e-03 + z * (-1.98412698298579493134e-04 + z * (2.75573137070700676789e-06 + z * (-2.50507602534068634195e-08 + z * 1.58969099521155010221e-10)))));
    const double cp = 1.0 - 0.5 * z + z * z * (4.16666666666666019037e-02 + z * (-1.38888888888741095749e-03 + z * (2.48015872894767294178e-05 + z * (-2.75573143513906633035e-07 + z * (2.08757232129817482790e-09 + z * -1.13596475577881948265e-11)))));
    const int q = ((int)n) & 3;
    s = (q == 0) ? sp : (q == 1) ? cp : (q == 2) ? -sp : -cp;
    c = (q == 0) ? cp : (q == 1) ? -sp : (q == 2) ? -cp : sp;
}

__device__ __forceinline__ void ada_item(int item, const float* c, const float* w_ada, const float* b_ada, float* ADA, LAS float* scr, int tid) {
    const int nc = item % 96, l = item / 96;
    LAS float* cact = scr; LAS float* part = scr + NB * DM;
    __syncthreads();
    for (int i = tid; i < NB * DM; i += 512) cact[i] = silu_f(c[i]);
    __syncthreads();
    { const int col = tid & 63, kp = tid >> 6; const int n = nc * 64 + col;
      float acc[NB];
#pragma unroll
      for (int b = 0; b < NB; ++b) acc[b] = 0.f;
      const float* wp = w_ada + ((size_t)l * DM + kp * 128) * 6144 + n;
      for (int k0 = 0; k0 < 128; k0 += 16) { float w[16];
#pragma unroll
          for (int i = 0; i < 16; ++i) w[i] = wp[(size_t)(k0 + i) * 6144];
#pragma unroll
          for (int i = 0; i < 16; ++i) {
#pragma unroll
              for (int b = 0; b < NB; ++b) acc[b] += cact[b * DM + kp * 128 + k0 + i] * w[i]; } }
#pragma unroll
      for (int b = 0; b < NB; ++b) part[(kp * NB + b) * 64 + col] = acc[b]; }
    __syncthreads();
    { const int col = tid & 63, b = tid >> 6; const int n = nc * 64 + col; float sum = b_ada[l * 6144 + n];
#pragma unroll
      for (int kp = 0; kp < 8; ++kp) sum += part[(kp * NB + b) * 64 + col];
      ADA[((size_t)l * NB + b) * 6144 + n] = sum; }
}
struct InvF { float v[8]; };
__device__ __forceinline__ void rope_entry(int idx, const int* positions, float* ROPE, const InvF& F) {
    const int t = idx >> 3, i = idx & 7;
    float invf = F.v[0];
#pragma unroll
    for (int q = 1; q < 8; ++q) invf = (i == q) ? F.v[q] : invf;
    const float ang = (float)positions[t] * invf;
    double s, c; sincos_d((double)ang, s, c);
    ROPE[t * 16 + i] = (float)c; ROPE[t * 16 + 8 + i] = (float)s;
}
__device__ __forceinline__ void dft_entry8(int idx, bf16_t* DFTC, bf16_t* DFTS) {
    const int m = idx >> 8, k0 = (idx & 255) * 8;
    unsigned cw[4], sw[4];
#pragma unroll
    for (int j = 0; j < 4; ++j) {
        float cv[2], sv[2];
#pragma unroll
        for (int e = 0; e < 2; ++e) { const int k = k0 + 2 * j + e; const int r = (m * k) & 2047; double s, c; sincos_d((double)r * (6.283185307179586476925 / 2048.0), s, c);
            cv[e] = (float)(c * (1.0 / 512.0)); sv[e] = (float)(-s * (1.0 / 512.0)); }
        cw[j] = pk2(cv[0], cv[1]); sw[j] = pk2(sv[0], sv[1]);
    }
    *(u32x4*)(DFTC + (size_t)m * 2048 + k0) = (u32x4){cw[0], cw[1], cw[2], cw[3]};
    *(u32x4*)(DFTS + (size_t)m * 2048 + k0) = (u32x4){sw[0], sw[1], sw[2], sw[3]};
}
__device__ __forceinline__ void transpose_tile(const float* __restrict__ src, size_t ldsrc, int k0, int n0, bf16_t* __restrict__ dst, size_t ldd, bf16_t* __restrict__ dst2, LAS float* scr, int lane) {
    f32x4 v[16];
#pragma unroll
    for (int i = 0; i < 16; ++i) v[i] = *(const f32x4*)(src + (size_t)(k0 + i * 4 + (lane >> 4)) * ldsrc + n0 + (lane & 15) * 4);
#pragma unroll
    for (int i = 0; i < 16; ++i) { LAS float* p = scr + (i * 4 + (lane >> 4)) * 65 + (lane & 15) * 4; p[0] = v[i][0]; p[1] = v[i][1]; p[2] = v[i][2]; p[3] = v[i][3]; }
    asm volatile("s_waitcnt lgkmcnt(0)" ::: "memory");
    const int c = lane & 7;
#pragma unroll
    for (int j = 0; j < 8; ++j) { const int n = (lane >> 3) + 8 * j; const LAS float* s = scr + (8 * c) * 65 + n;
        u32x4 o; o.x = pk2(s[0 * 65], s[1 * 65]); o.y = pk2(s[2 * 65], s[3 * 65]); o.z = pk2(s[4 * 65], s[5 * 65]); o.w = pk2(s[6 * 65], s[7 * 65]);
        *(u32x4*)(dst + (size_t)n * ldd + 8 * c) = o;
        if (dst2) *(u32x4*)(dst2 + (size_t)n * ldd + 8 * c) = o; }
    asm volatile("s_waitcnt lgkmcnt(0)" ::: "memory");
}
struct ConvPtrs { const float *w_in, *p_a, *p_b, *p_c, *w_out, *w1, *w3, *w2; unsigned char* ws; };
constexpr int CV_WIN = 16 * 112, CV_PA = 256, CV_PB = 128, CV_PC = 128, CV_WO = 256, CV_SMALL = CV_WIN + CV_PA + CV_PB + CV_PC + CV_WO;
constexpr int CV_EXP = 688 * 3, CV_LAYER = CV_SMALL + NE * CV_EXP, CV_TOTAL = NL * CV_LAYER;
__device__ __forceinline__ void conv_item(int it, const ConvPtrs& P, LAS float* scr, int lane) {
    const int l = it / CV_LAYER; int r = it % CV_LAYER;
    if (r < CV_WIN) { const int kt = r & 15; int nt = r >> 4; if (nt >= 48) nt += 8;
        const int n0 = nt * 64, drow = (n0 < 3072) ? n0 : n0 + 512;
        transpose_tile(P.w_in + (size_t)l * DM * NIN_SRC, NIN_SRC, kt * 64, n0, (bf16_t*)(P.ws + WS_WIN) + ((size_t)l * NIN + drow) * DM + kt * 64, DM, nullptr, scr, lane); return; }
    r -= CV_WIN;
    if (r < CV_PA) { const int kt = r & 15, nt = r >> 4;
        transpose_tile(P.p_a + (size_t)l * 1024 * 1024, 1024, kt * 64, nt * 64, (bf16_t*)(P.ws + WS_PA) + ((size_t)l * 1024 + nt * 64) * 1024 + kt * 64, 1024, nullptr, scr, lane); return; }
    r -= CV_PA;
    if (r < CV_PB) { const int kt = r & 7, nt = r >> 3;
        bf16_t* d = (bf16_t*)(P.ws + WS_PB) + ((size_t)l * 1024 + nt * 64) * 1024 + kt * 64;
        transpose_tile(P.p_b + (size_t)l * 512 * 1024, 1024, kt * 64, nt * 64, d, 1024, d + 512, scr, lane); return; }
    r -= CV_PB;
    if (r < CV_PC) { const int kt = r & 7, nt = r >> 3;
        transpose_tile(P.p_c + (size_t)l * 512 * 1024, 1024, kt * 64, nt * 64, (bf16_t*)(P.ws + WS_PC) + ((size_t)l * 1024 + nt * 64) * 512 + kt * 64, 512, nullptr, scr, lane); return; }
    r -= CV_PC;
    if (r < CV_WO) { const int kt = r & 15, nt = r >> 4;
        transpose_tile(P.w_out + (size_t)l * 1024 * 1024, 1024, kt * 64, nt * 64, (bf16_t*)(P.ws + WS_WOUT) + ((size_t)l * 1024 + nt * 64) * 1024 + kt * 64, 1024, nullptr, scr, lane); return; }
    r -= CV_WO;
    const int e = r / CV_EXP; r %= CV_EXP;
    const size_t le = (size_t)l * NE + e;
    if (r < 1376) { const int which = r / 688; r %= 688; const int kt = r & 15, nt = r >> 4;
        const int f0 = nt * 64, drow = (f0 >> 7) * 256 + which * 128 + (f0 & 127);
        transpose_tile((which ? P.w3 : P.w1) + le * DM * FF, FF, kt * 64, f0, (bf16_t*)(P.ws + WS_W13) + (le * (NFT * 256) + drow) * DM + kt * 64, DM, nullptr, scr, lane); return; }
    r -= 1376;
    { const int kt = r % 43, nt = r / 43;
        transpose_tile(P.w2 + le * FF * DM, DM, kt * 64, nt * 64, (bf16_t*)(P.ws + WS_W2) + (le * DM + nt * 64) * FFL + kt * 64, FFL, nullptr, scr, lane); }
}
typedef float f32x2_c __attribute__((ext_vector_type(2))); typedef __bf16 bf16x2_c __attribute__((ext_vector_type(2)));
__device__ __forceinline__ unsigned cvtpk_c(float lo, float hi) { f32x2_c v = {lo, hi}; bf16x2_c b = __builtin_convertvector(v, bf16x2_c); return __builtin_bit_cast(unsigned, b); }
struct TileDesc { const float* src; bf16_t* dst; bf16_t* dst2; unsigned ldsrc, ldd; };
__device__ __forceinline__ TileDesc conv_decode(int it, const ConvPtrs& P) {
    TileDesc d; d.dst2 = nullptr;
    const int l = it / CV_LAYER; int r = it % CV_LAYER;
    if (r < CV_WIN) { const int kt = r / 112; int nt = r % 112; if (nt >= 48) nt += 8;
        const int n0 = nt * 64, drow = (n0 < 3072) ? n0 : n0 + 512;
        d.src = P.w_in + ((size_t)l * DM + kt * 64) * NIN_SRC + n0; d.ldsrc = NIN_SRC; d.dst = (bf16_t*)(P.ws + WS_WIN) + ((size_t)l * NIN + drow) * DM + kt * 64; d.ldd = DM; return d; }
    r -= CV_WIN;
    if (r < CV_PA) { const int kt = r >> 4, nt = r & 15;
        d.src = P.p_a + ((size_t)l * 1024 + kt * 64) * 1024 + nt * 64; d.ldsrc = 1024; d.dst = (bf16_t*)(P.ws + WS_PA) + ((size_t)l * 1024 + nt * 64) * 1024 + kt * 64; d.ldd = 1024; return d; }
    r -= CV_PA;
    if (r < CV_PB) { const int kt = r >> 4, nt = r & 15;
        d.src = P.p_b + ((size_t)l * 512 + kt * 64) * 1024 + nt * 64; d.ldsrc = 1024; d.dst = (bf16_t*)(P.ws + WS_PB) + ((size_t)l * 1024 + nt * 64) * 1024 + kt * 64; d.dst2 = d.dst + 512; d.ldd = 1024; return d; }
    r -= CV_PB;
    if (r < CV_PC) { const int kt = r >> 4, nt = r & 15;
        d.src = P.p_c + ((size_t)l * 512 + kt * 64) * 1024 + nt * 64; d.ldsrc = 1024; d.dst = (bf16_t*)(P.ws + WS_PC) + ((size_t)l * 1024 + nt * 64) * 512 + kt * 64; d.ldd = 512; return d; }
    r -= CV_PC;
    if (r < CV_WO) { const int kt = r >> 4, nt = r & 15;
        d.src = P.w_out + ((size_t)l * 1024 + kt * 64) * 1024 + nt * 64; d.ldsrc = 1024; d.dst = (bf16_t*)(P.ws + WS_WOUT) + ((size_t)l * 1024 + nt * 64) * 1024 + kt * 64; d.ldd = 1024; return d; }
    r -= CV_WO;
    const int e = r / CV_EXP; r %= CV_EXP;
    const size_t le = (size_t)l * NE + e;
    if (r < 1376) { const int which = r / 688; r %= 688; const int kt = r / 43, nt = r % 43;
        const int f0 = nt * 64, drow = (f0 >> 7) * 256 + which * 128 + (f0 & 127);
        d.src = (which ? P.w3 : P.w1) + (le * DM + kt * 64) * FF + f0; d.ldsrc = FF; d.dst = (bf16_t*)(P.ws + WS_W13) + (le * (NFT * 256) + drow) * DM + kt * 64; d.ldd = DM; return d; }
    r -= 1376;
    { const int kt = r >> 4, nt = r & 15;
        d.src = P.w2 + (le * FF + kt * 64) * DM + nt * 64; d.ldsrc = DM; d.dst = (bf16_t*)(P.ws + WS_W2) + (le * DM + nt * 64) * FFL + kt * 64; d.ldd = FFL; return d; }
}
__device__ __forceinline__ void tile_load(const TileDesc& d, f32x4 (&v)[16], int lane) {
    const float* p = d.src + (size_t)(lane >> 4) * d.ldsrc + (lane & 15) * 4;
#pragma unroll
    for (int i = 0; i < 16; ++i) v[i] = *(const f32x4*)(p + (size_t)(i * 4) * d.ldsrc);
}
__device__ __forceinline__ void tile_store(const TileDesc& d, const f32x4 (&v)[16], LAS float* scr, int lane) {
#pragma unroll
    for (int i = 0; i < 16; ++i) { LAS float* p = scr + (i * 4 + (lane >> 4)) * 65 + (lane & 15) * 4; p[0] = v[i][0]; p[1] = v[i][1]; p[2] = v[i][2]; p[3] = v[i][3]; }
    asm volatile("s_waitcnt lgkmcnt(0)" ::: "memory");
    const int c = lane & 7;
#pragma unroll
    for (int j = 0; j < 8; ++j) { const int n = (lane >> 3) + 8 * j; const LAS float* s = scr + (8 * c) * 65 + n;
        u32x4 o; o.x = cvtpk_c(s[0 * 65], s[1 * 65]); o.y = cvtpk_c(s[2 * 65], s[3 * 65]); o.z = cvtpk_c(s[4 * 65], s[5 * 65]); o.w = cvtpk_c(s[6 * 65], s[7 * 65]);
        *(u32x4*)(d.dst + (size_t)n * d.ldd + 8 * c) = o;
        if (d.dst2) *(u32x4*)(d.dst2 + (size_t)n * d.ldd + 8 * c) = o; }
    asm volatile("s_waitcnt lgkmcnt(0)" ::: "memory");
}
constexpr int PAD_CH_W13 = 128 * 128, PAD_CH_W2 = 1024 * 8, PAD_CH = PAD_CH_W13 + PAD_CH_W2;
__device__ __forceinline__ void pad_chunk(size_t idx, unsigned char* ws) {
    const size_t le = idx / PAD_CH; const int r = (int)(idx % PAD_CH);
    const u32x4 z = {0u, 0u, 0u, 0u};
    if (r < PAD_CH_W13) { const int row = r >> 7, ch = r & 127; const int drow = 21 * 256 + ((row < 64) ? 64 + row : 192 + (row - 64));
        *(u32x4*)((bf16_t*)(ws + WS_W13) + (le * (NFT * 256) + drow) * DM + ch * 8) = z; }
    else { const int q = r - PAD_CH_W13; const int row = q >> 3, ch = q & 7;
        *(u32x4*)((bf16_t*)(ws + WS_W2) + (le * DM + row) * FFL + FF + ch * 8) = z; }
}
__device__ __forceinline__ void fold_item(int item, const float* w_in, bf16_t* WIN, LAS float* scr, int tid) {
    const int kc = item & 15, g = (item >> 4) & 3, l = item >> 6;
    LAS float* wt = scr; LAS float* tc = scr + 64 * 129; LAS float* ts = tc + 128;
    __syncthreads();
    for (int i = tid; i < 64 * 128; i += 512) { const int kk = i >> 7, c = i & 127; wt[kk * 129 + c] = w_in[((size_t)l * DM + kc * 64 + kk) * NIN_SRC + 3072 + g * 128 + c]; }
    if (tid < 128) { double s, c; sincos_d((double)tid * (6.283185307179586476925 / 128.0), s, c); tc[tid] = (float)c; ts[tid] = (float)s; }
    __syncthreads();
    const int kk = tid & 63, og = tid >> 6;
    for (int oo = 0; oo < 32; ++oo) { const int o = og * 32 + oo, part = o >> 7, cp = o & 127;
        float acc = 0.f;
        for (int c = 0; c < 128; ++c) { const int j = (c * cp) & 127; acc += wt[kk * 129 + c] * (part ? ts[j] : tc[j]); }
        WIN[((size_t)l * NIN + 3072 + g * 256 + o) * DM + kc * 64 + kk] = (bf16_t)f2bf(acc); }
}

namespace pg8 {
#define PG8_LAS __attribute__((address_space(3)))
typedef unsigned short bf16_t;
typedef short bf16x8 __attribute__((ext_vector_type(8)));
typedef float f32x4 __attribute__((ext_vector_type(4)));
typedef unsigned u32x4 __attribute__((ext_vector_type(4)));
constexpr int BM = 256, BK = 64, HALF = 128, HTB = HALF * BK * 2  , STAGE_BYTES = 8 * HTB, NXCD = 8, WGM = 8;

__host__ __device__ __forceinline__ int lds_byte(int r, int c) { const int st = (r >> 4) * 2 + (c >> 5), rr = r & 15, cc = c & 31, ob = rr * 64 + cc * 2; return st * 1024 + (ob ^ (((ob >> 9) & 1) << 5)); }
__host__ __device__ __forceinline__ void stage_rc(int b, int& R, int& C) { const int st = b / 1024, sb = b % 1024, swz = sb ^ (((sb >> 9) & 1) << 5); R = (st >> 1) * 16 + swz / 64; C = (st & 1) * 32 + (swz % 64) / 2; }
__host__ __device__ __forceinline__ int perm32(int rho) { const int n = rho >> 4, i = rho & 15; return 8 * (i >> 2) + 4 * n + (i & 3); }

struct Unit { int pm, pn; };
struct Gemm { const bf16_t* A; const bf16_t* Bt; int M, N, K, ld; };

struct StaticOrder {
    int nM, nN, nwg, G, c, rev;
    __host__ __device__ void init(int M, int N, int G_, int c_) { nM = M / BM; nN = N / BM; nwg = nM * nN; G = G_; c = c_; rev = 0; }
    __host__ __device__ bool next(int i, Unit& u) const {
        const long L = (long)i * G + c; if (L >= nwg) return false;
        int wgid = (int)L; { const int q = nwg / NXCD, r = nwg % NXCD, xcd = wgid % NXCD, off = wgid / NXCD; wgid = (xcd < r ? xcd * (q + 1) : r * (q + 1) + (xcd - r) * q) + off; }
        const int nig = WGM * nN, gid = wgid / nig, fm = gid * WGM, gsz = (nM - fm) < WGM ? (nM - fm) : WGM;
        u.pm = fm + ((wgid % nig) % gsz); u.pn = (wgid % nig) / gsz;
        if (rev) u.pn = nN - 1 - u.pn;
        return true;
    }
    __device__ __forceinline__ void a_ready(const Unit&) const {}
    __device__ __forceinline__ void done(const Unit&) const {}
};

typedef float f32x2_t __attribute__((ext_vector_type(2))); typedef __bf16 bf16x2_t __attribute__((ext_vector_type(2)));
__device__ __forceinline__ unsigned cvt_pk_bf16(float lo, float hi) { f32x2_t v = {lo, hi}; bf16x2_t b = __builtin_convertvector(v, bf16x2_t); return __builtin_bit_cast(unsigned, b); }
__device__ __forceinline__ float fast_sigmoid(float v) { return __builtin_amdgcn_rcpf(1.0f + __builtin_amdgcn_exp2f(-1.4426950408889634f * v)); }
__device__ __forceinline__ float fast_gelu_tanh(float v) { return v * __builtin_amdgcn_rcpf(1.0f + __builtin_amdgcn_exp2f(-2.3022082f * (v + 0.044715f * v * v * v))); }
__device__ __forceinline__ u32x4 pack8(const f32x4& v0, const f32x4& v1) { u32x4 w; w.x = cvt_pk_bf16(v0[0], v0[1]); w.y = cvt_pk_bf16(v0[2], v0[3]); w.z = cvt_pk_bf16(v1[0], v1[1]); w.w = cvt_pk_bf16(v1[2], v1[3]); return w; }
__device__ __forceinline__ void unpack8(const u32x4& w, f32x4& v0, f32x4& v1) {
    v0[0] = __builtin_bit_cast(float, w.x << 16); v0[1] = __builtin_bit_cast(float, w.x & 0xffff0000u); v0[2] = __builtin_bit_cast(float, w.y << 16); v0[3] = __builtin_bit_cast(float, w.y & 0xffff0000u);
    v1[0] = __builtin_bit_cast(float, w.z << 16); v1[1] = __builtin_bit_cast(float, w.z & 0xffff0000u); v1[2] = __builtin_bit_cast(float, w.w << 16); v1[3] = __builtin_bit_cast(float, w.w & 0xffff0000u); }

struct GroupOrder {
    int nM, nN, per, nwg, G, c, amode;
    __host__ __device__ void init(int Z, int nM_, int nN_, int G_, int c_, int amode_) { nM = nM_; nN = nN_; per = nM * nN; nwg = Z * per; G = G_; c = c_; amode = amode_; }
    __host__ __device__ bool next(int i, Unit& u) const {
        const long L = (long)i * G + c; if (L >= nwg) return false;
        int wgid = (int)L; { const int q = nwg / NXCD, r = nwg % NXCD, xcd = wgid % NXCD, off = wgid / NXCD; wgid = (xcd < r ? xcd * (q + 1) : r * (q + 1) + (xcd - r) * q) + off; }
        const int z = wgid / per, rr = wgid % per;
        const int nig = WGM * nN, gid = rr / nig, fm = gid * WGM, gsz = (nM - fm) < WGM ? (nM - fm) : WGM;
        const int pml = fm + ((rr % nig) % gsz), pnl = (rr % nig) / gsz;
        u.pm = (amode ? (z & 1) : z) * nM + pml; u.pn = z * nN + pnl; return true;
    }
    __device__ __forceinline__ void a_ready(const Unit&) const {}
    __device__ __forceinline__ void done(const Unit&) const {}
};

struct EpiWin {
    static constexpr bool PERM = true, AFTER_DRAIN = false;
    bf16_t *Q, *YT, *UV, *GATES; const float* ROPE;
    __device__ __forceinline__ void operator()(const f32x4 (&acc)[2][2][4][2], const Unit& u, int wr, int wc, int fr, int fq) const {
        const int row0 = u.pm * BM + wr * 64 + fr, pn = u.pn;
#if (WIN_DBG & 0x6F) != 0x6F
        { const int br = pn < 4 ? 0 : (pn < 8 ? 5 : (pn < 12 ? 6 : (pn < 16 ? 1 : (pn < 20 ? 2 : 3)))); if (!((WIN_DBG >> br) & 1)) return; }
#endif
        if (pn < 12) {
            bf16_t* base = Q + (size_t)(pn >> 2) * (size_t)(16u << 20) + (pn & 3) * 256 + wc * 32 + 8 * fq;
            const bool rope = (pn < 8) && ((wc & 1) == 0) && !((WIN_DBG >> 4) & 1);
            const float sgn = (fq == 0) ? -1.f : 1.f;
            const bool ld = rope && fq < 2;
            f32x4 nc0 = {1.f, 1.f, 1.f, 1.f}, nc1 = nc0, ns0 = {0.f, 0.f, 0.f, 0.f}, ns1 = ns0;
            if (ld) { const f32x4* rp = (const f32x4*)(ROPE + (size_t)row0 * 16); nc0 = rp[0]; nc1 = rp[1]; ns0 = rp[2]; ns1 = rp[3]; }
#pragma unroll
            for (int c = 0; c < 8; ++c) { const int ai = c >> 2, m = c & 3; const int row = row0 + ai * HALF + m * 16;
                f32x4 cs0 = nc0, cs1 = nc1, sn0 = ns0 * sgn, sn1 = ns1 * sgn;
                if (ld && c + 1 < 8) { const int c2 = c + 1; const f32x4* rp = (const f32x4*)(ROPE + (size_t)(row0 + (c2 >> 2) * HALF + (c2 & 3) * 16) * 16); nc0 = rp[0]; nc1 = rp[1]; ns0 = rp[2]; ns1 = rp[3]; }
#pragma unroll
                for (int bj = 0; bj < 2; ++bj) { f32x4 v0 = acc[ai][bj][m][0], v1 = acc[ai][bj][m][1];
                    if (rope) { f32x4 p0, p1;
#pragma unroll
                        for (int j = 0; j < 4; ++j) { p0[j] = __shfl_xor(v0[j], 16); p1[j] = __shfl_xor(v1[j], 16); }
                        v0 = v0 * cs0 + p0 * sn0; v1 = v1 * cs1 + p1 * sn1; }
                    *(u32x4*)(base + (size_t)row * 1024 + bj * HALF) = pack8(v0, v1); } }
        } else if (pn < 16) {
            const int g = pn - 12, b = u.pm >> 3, pos0 = (u.pm & 7) * BM + wr * 64 + fr;
#pragma unroll
            for (int bj = 0; bj < 2; ++bj) { bf16_t* yb = YT + ((size_t)(b * 2 + bj) * 512 + g * 128 + wc * 32 + 8 * fq) * 2048 + pos0;
#pragma unroll
                for (int ai = 0; ai < 2; ++ai)
#pragma unroll
                    for (int m = 0; m < 4; ++m)
#pragma unroll
                        for (int n = 0; n < 2; ++n) { const u32x4 dummy = {0u, 0u, 0u, 0u}; (void)dummy; const unsigned w0 = cvt_pk_bf16(acc[ai][bj][m][n][0], acc[ai][bj][m][n][1]), w1 = cvt_pk_bf16(acc[ai][bj][m][n][2], acc[ai][bj][m][n][3]);
                            bf16_t* p = yb + (size_t)(4 * n) * 2048 + ai * HALF + m * 16;
                            p[0] = (bf16_t)(w0 & 0xffffu); p[2048] = (bf16_t)(w0 >> 16); p[2 * 2048] = (bf16_t)(w1 & 0xffffu); p[3 * 2048] = (bf16_t)(w1 >> 16); } }
        } else if (pn < 20) {
            bf16_t* base = UV + (pn - 16) * 256 + wc * 32 + 8 * fq;
#pragma unroll
            for (int ai = 0; ai < 2; ++ai)
#pragma unroll
                for (int m = 0; m < 4; ++m) { const int row = row0 + ai * HALF + m * 16;
#pragma unroll
                    for (int bj = 0; bj < 2; ++bj) { f32x4 v0 = acc[ai][bj][m][0], v1 = acc[ai][bj][m][1];
#pragma unroll
                        for (int j = 0; j < 4; ++j) { v0[j] = fast_gelu_tanh(v0[j]); v1[j] = fast_gelu_tanh(v1[j]); }
                        *(u32x4*)(base + (size_t)row * 1024 + bj * HALF) = pack8(v0, v1); } }
        } else {
            bf16_t* base = GATES + (pn - 20) * 256 + wc * 32 + 8 * fq;
#pragma unroll
            for (int ai = 0; ai < 2; ++ai)
#pragma unroll
                for (int m = 0; m < 4; ++m) { const int row = row0 + ai * HALF + m * 16;
#pragma unroll
                    for (int bj = 0; bj < 2; ++bj) { f32x4 v0 = acc[ai][bj][m][0], v1 = acc[ai][bj][m][1];
#pragma unroll
                        for (int j = 0; j < 4; ++j) { v0[j] = fast_sigmoid(v0[j]); v1[j] = fast_sigmoid(v1[j]); }
                        __builtin_nontemporal_store(pack8(v0, v1), (u32x4*)(base + (size_t)row * 3072 + bj * HALF)); } }
        }
    }
};
struct EpiDft {
    static constexpr bool PERM = true, AFTER_DRAIN = false;
    bf16_t* BOUT;
    __device__ __forceinline__ void operator()(const f32x4 (&acc)[2][2][4][2], const Unit& u, int wr, int wc, int fr, int fq) const {
        const int part = u.pm >> 3, mt = u.pm & 7, b = u.pn >> 2, nt = u.pn & 1;
        bf16_t* base = BOUT + ((size_t)b * 2048 + mt * BM + wr * 64 + fr) * 1024 + part * 512 + nt * 256 + wc * 32 + 8 * fq;
#pragma unroll
        for (int ai = 0; ai < 2; ++ai)
#pragma unroll
            for (int m = 0; m < 4; ++m)
#pragma unroll
                for (int bj = 0; bj < 2; ++bj) *(u32x4*)(base + (size_t)(ai * HALF + m * 16) * 1024 + bj * HALF) = pack8(acc[ai][bj][m][0], acc[ai][bj][m][1]);
    }
};
template <int WHICH> struct EpiProj {
    static constexpr bool PERM = true, AFTER_DRAIN = false;
    const bf16_t* GATES; bf16_t* T1; bf16_t* T2; bf16_t* OUT;
    struct Ld { u32x4 ga, gb, gc, t1, t2; };
    __device__ __forceinline__ Ld load(size_t row, int col) const { Ld r; const bf16_t* g = GATES + row * 3072 + col; r.ga = *(const u32x4*)g; r.gb = *(const u32x4*)(g + 1024); r.gc = *(const u32x4*)(g + 2048);
        r.t1 = *(const u32x4*)(T1 + row * 1024 + col); r.t2 = *(const u32x4*)(T2 + row * 1024 + col); return r; }
    __device__ __forceinline__ void operator()(const f32x4 (&acc)[2][2][4][2], const Unit& u, int wr, int wc, int fr, int fq) const {
        const int row0 = u.pm * BM + wr * 64 + fr, col0 = u.pn * BM + wc * 32 + 8 * fq;
        if (WHICH < 2) {
            bf16_t* dst = (WHICH == 0 ? T1 : T2);
#pragma unroll
            for (int ai = 0; ai < 2; ++ai)
#pragma unroll
                for (int m = 0; m < 4; ++m)
#pragma unroll
                    for (int bj = 0; bj < 2; ++bj) *(u32x4*)(dst + (size_t)(row0 + ai * HALF + m * 16) * 1024 + col0 + bj * HALF) = pack8(acc[ai][bj][m][0], acc[ai][bj][m][1]);
        } else {
            Ld cur = load((size_t)row0, col0), nx1 = load((size_t)row0, col0 + HALF);
#pragma unroll
            for (int c = 0; c < 16; ++c) { const int ai = c >> 3, m = (c >> 1) & 3, bj = c & 1;
                const size_t row = (size_t)(row0 + ai * HALF + m * 16); const int col = col0 + bj * HALF;
                Ld nx2 = nx1;
                if (c + 2 < 16) { const int c2 = c + 2, ai2 = c2 >> 3, m2 = (c2 >> 1) & 3, bj2 = c2 & 1; nx2 = load((size_t)(row0 + ai2 * HALF + m2 * 16), col0 + bj2 * HALF); }
                f32x4 a0, a1, b0, b1, c0, c1, p0, p1, q0, q1;
                unpack8(cur.ga, a0, a1); unpack8(cur.gb, b0, b1); unpack8(cur.gc, c0, c1); unpack8(cur.t1, p0, p1); unpack8(cur.t2, q0, q1);
                const f32x4 v0 = a0 * p0 + b0 * q0 + c0 * acc[ai][bj][m][0], v1 = a1 * p1 + b1 * q1 + c1 * acc[ai][bj][m][1];
                *(u32x4*)(OUT + row * 1024 + col) = pack8(v0, v1);
                cur = nx1; nx1 = nx2; }
        }
    }
};
struct EpiWout {
    static constexpr bool PERM = false, AFTER_DRAIN = false;
    const float* Xin; float* Xout; const float* gt;
    __device__ __forceinline__ void operator()(const f32x4 (&acc)[2][2][4][2], const Unit& u, int wr, int wc, int fr, int fq) const {
        const int row0 = u.pm * BM + wr * 64 + fr, col0 = u.pn * BM + wc * 32 + 4 * fq, b = u.pm >> 3;
        f32x4 gv[2][2];
#pragma unroll
        for (int bj = 0; bj < 2; ++bj)
#pragma unroll
            for (int n = 0; n < 2; ++n) gv[bj][n] = *(const f32x4*)(gt + b * 6144 + col0 + bj * HALF + n * 16);
#pragma unroll
        for (int ai = 0; ai < 2; ++ai)
#pragma unroll
            for (int mh = 0; mh < 2; ++mh) { f32x4 xv[2][2][2];
#pragma unroll
                for (int mm = 0; mm < 2; ++mm)
#pragma unroll
                    for (int bj = 0; bj < 2; ++bj)
#pragma unroll
                        for (int n = 0; n < 2; ++n) xv[mm][bj][n] = *(const f32x4*)(Xin + (size_t)(row0 + ai * HALF + (mh * 2 + mm) * 16) * 1024 + col0 + bj * HALF + n * 16);
#pragma unroll
                for (int mm = 0; mm < 2; ++mm)
#pragma unroll
                    for (int bj = 0; bj < 2; ++bj)
#pragma unroll
                        for (int n = 0; n < 2; ++n) *(f32x4*)(Xout + (size_t)(row0 + ai * HALF + (mh * 2 + mm) * 16) * 1024 + col0 + bj * HALF + n * 16) = xv[mm][bj][n] + gv[bj][n] * acc[ai][bj][mh * 2 + mm][n]; }
    }
};
struct EpiG1 {
    static constexpr bool PERM = true, AFTER_DRAIN = false;
    bf16_t* HID;
    __device__ __forceinline__ void operator()(const f32x4 (&acc)[2][2][4][2], const Unit& u, int wr, int wc, int fr, int fq) const {
        const int ft = u.pn % 22;
        bf16_t* base = HID + ((size_t)u.pm * BM + wr * 64 + fr) * FFL + ft * 128 + wc * 32 + 8 * fq;
#pragma unroll
        for (int ai = 0; ai < 2; ++ai)
#pragma unroll
            for (int m = 0; m < 4; ++m) { f32x4 h0, h1;
#pragma unroll
                for (int j = 0; j < 4; ++j) { const float a0 = acc[ai][0][m][0][j], a1 = acc[ai][0][m][1][j]; h0[j] = a0 * fast_sigmoid(a0) * acc[ai][1][m][0][j]; h1[j] = a1 * fast_sigmoid(a1) * acc[ai][1][m][1][j]; }
                *(u32x4*)(base + (size_t)(ai * HALF + m * 16) * FFL) = pack8(h0, h1); }
    }
};
struct EpiG2 {
    static constexpr bool PERM = true, AFTER_DRAIN = false;
    bf16_t* YB;
    __device__ __forceinline__ void operator()(const f32x4 (&acc)[2][2][4][2], const Unit& u, int wr, int wc, int fr, int fq) const {
        bf16_t* base = YB + ((size_t)u.pm * BM + wr * 64 + fr) * 1024 + (u.pn & 3) * 256 + wc * 32 + 8 * fq;
#pragma unroll
        for (int ai = 0; ai < 2; ++ai)
#pragma unroll
            for (int m = 0; m < 4; ++m)
#pragma unroll
                for (int bj = 0; bj < 2; ++bj) *(u32x4*)(base + (size_t)(ai * HALF + m * 16) * 1024 + bj * HALF) = pack8(acc[ai][bj][m][0], acc[ai][bj][m][1]);
    }
};
template <class Epi, class Sched, bool ALIGN_EPI = false, bool SP2 = false, bool GATHER = false>
__device__ __forceinline__ void gemm_phase(PG8_LAS unsigned char* lds, const Gemm g, const Sched& S, const Epi& E) {
    int tid_l = threadIdx.x; asm volatile("" : "+v"(tid_l));
    const int tid = tid_l, wid = __builtin_amdgcn_readfirstlane(tid >> 6), lane = tid & 63, wr = wid >> 2, wc = wid & 3, fr = lane & 15, fq = lane >> 4;
    const int K = g.K, nt = K / BK, LD = g.ld ? g.ld : K;
    unsigned voffA[2], voffA1[2], voffB[2]; int gR[2], gC[2];
#pragma unroll
    for (int i = 0; i < 2; ++i) { int R, C; stage_rc(tid * 16 + i * 8192, R, C); const int Rb = Epi::PERM ? ((R & ~31) + perm32(R & 31)) : R;
        voffA[i] = (unsigned)(R * LD + C) * 2u; voffA1[i] = voffA[i]; voffB[i] = (unsigned)(Rb * LD + C) * 2u; gR[i] = R; gC[i] = C * 2; }
    const PG8_LAS unsigned* gtab = (const PG8_LAS unsigned*)(lds + STAGE_BYTES);
#define PG8_GLOAD(u_) do { if constexpr (GATHER) { _Pragma("unroll") for (int _i = 0; _i < 2; ++_i) { voffA[_i] = gtab[(u_) * 256 + gR[_i]] + (unsigned)gC[_i]; voffA1[_i] = gtab[(u_) * 256 + HALF + gR[_i]] + (unsigned)gC[_i]; } } } while (0)
    const size_t kstep = (size_t)(BK * 2);
    const size_t hstep = (size_t)HALF * LD * 2;
    const size_t tstep = 2 * hstep;
    const size_t hstepA = GATHER ? 0 : hstep, tstepA = GATHER ? 0 : tstep;
    const unsigned ldsw = (unsigned)wid * 1024u;
    const int aoff = lds_byte(wr * 64 + fr, fq * 8), boff = lds_byte(wc * 32 + fr, fq * 8);
#define PG8_SA(b, h) (((b) * 2 + (h)) * HTB)
#define PG8_SB(b, h) ((4 + (b) * 2 + (h)) * HTB)
#define PG8_STAGE(bufoff, gbase, voff) do { _Pragma("unroll") for (int _i = 0; _i < 2; ++_i) \
        __builtin_amdgcn_global_load_lds((const unsigned*)((const char*)(gbase) + (voff)[_i]), (PG8_LAS unsigned*)(lds + (bufoff) + ldsw + _i * 8192), 16, 0, 0); } while (0)
#define PG8_LDA(dst, b, h) do { _Pragma("unroll") for (int m = 0; m < 4; ++m) _Pragma("unroll") for (int k = 0; k < 2; ++k) dst[m][k] = *(const PG8_LAS bf16x8*)(lds + PG8_SA(b, h) + aoff + m * 2048 + k * 1024); } while (0)
#define PG8_LDB(dst, b, h) do { _Pragma("unroll") for (int n = 0; n < 2; ++n) _Pragma("unroll") for (int k = 0; k < 2; ++k) dst[n][k] = *(const PG8_LAS bf16x8*)(lds + PG8_SB(b, h) + boff + n * 2048 + k * 1024); } while (0)
#define PG8_MMA(ai, bj, At, Bt) do { __builtin_amdgcn_s_setprio(1); _Pragma("unroll") for (int m = 0; m < 4; ++m) _Pragma("unroll") for (int n = 0; n < 2; ++n) _Pragma("unroll") for (int k = 0; k < 2; ++k) \
        acc[ai][bj][m][n] = __builtin_amdgcn_mfma_f32_16x16x32_bf16(Bt[n][k], At[m][k], acc[ai][bj][m][n], 0, 0, 0); __builtin_amdgcn_s_setprio(0); } while (0)
#define PG8_WAIT_V(n) asm volatile("s_waitcnt vmcnt(" #n ")" ::: "memory")
#define PG8_WAIT_L(n) asm volatile("s_waitcnt lgkmcnt(" #n ")" ::: "memory")
#define PG8_BAR __builtin_amdgcn_s_barrier()
#define PG8_SCHED __builtin_amdgcn_sched_barrier(0)
    Unit cur, nxt; int ui = 0;
    if (!S.next(0, cur)) return;
    f32x4 acc[2][2][4][2];
#pragma unroll
    for (int a = 0; a < 2; ++a)
#pragma unroll
        for (int b = 0; b < 2; ++b)
#pragma unroll
            for (int m = 0; m < 4; ++m)
#pragma unroll
                for (int n = 0; n < 2; ++n) acc[a][b][m][n] = (f32x4){0.f, 0.f, 0.f, 0.f};
    bf16x8 At[4][2], B0[2][2], B1[2][2];
    static_assert(!GATHER || SP2, "gathered A: SP2 schedule only");
    const char* cA = (const char*)g.A + (size_t)cur.pm * tstepA; const char* cB = (const char*)g.Bt + (size_t)cur.pn * tstep;
    S.a_ready(cur);
    PG8_GLOAD(0);
    if constexpr (SP2) {
        PG8_STAGE(PG8_SB(0, 0), cB, voffB); PG8_STAGE(PG8_SB(0, 1), cB + hstep, voffB); PG8_STAGE(PG8_SA(0, 0), cA, voffA); PG8_STAGE(PG8_SA(0, 1), cA + hstepA, voffA1);
        if (wr == 1) PG8_BAR;
        PG8_WAIT_V(2); PG8_BAR;
        PG8_STAGE(PG8_SB(1, 0), cB + kstep, voffB); PG8_STAGE(PG8_SA(1, 0), cA + kstep, voffA); PG8_STAGE(PG8_SB(1, 1), cB + hstep + kstep, voffB);
        PG8_WAIT_V(6); PG8_BAR;
    } else {
        PG8_STAGE(PG8_SB(0, 0), cB, voffB); PG8_STAGE(PG8_SA(0, 0), cA, voffA); PG8_STAGE(PG8_SB(0, 1), cB + hstep, voffB); PG8_STAGE(PG8_SA(0, 1), cA + hstep, voffA);
        if (wr == 1) PG8_BAR;
        PG8_WAIT_V(4); PG8_BAR;
        PG8_STAGE(PG8_SB(1, 0), cB + kstep, voffB); PG8_STAGE(PG8_SA(1, 0), cA + kstep, voffA); PG8_STAGE(PG8_SB(1, 1), cB + hstep + kstep, voffB);
        PG8_WAIT_V(6); PG8_BAR;
    }
    for (;;) {
        const bool has_next = S.next(ui + 1, nxt);
        const char* nA = has_next ? (const char*)g.A + (size_t)nxt.pm * tstepA : cA; const char* nB = has_next ? (const char*)g.Bt + (size_t)nxt.pn * tstep : cB;
        for (int t = 0; t < nt; t += 2) {
            const bool last = (t == nt - 2);
            const char* a1 = cA + (size_t)(t + 1) * kstep;
            const char* a2 = last ? nA : cA + (size_t)(t + 2) * kstep; const char* b2 = last ? nB : cB + (size_t)(t + 2) * kstep;
            const char* a3 = a2 + kstep; const char* b3 = b2 + kstep;
            if (last && has_next) S.a_ready(nxt);
            if constexpr (SP2) {
            PG8_LDB(B0, 0, 0); PG8_LDB(B1, 0, 1); PG8_SCHED; PG8_LDA(At, 0, 0); PG8_STAGE(PG8_SA(1, 1), a1 + hstepA, voffA1);
            if constexpr (GATHER) { const int un_ = ui + (int)(last & has_next); PG8_GLOAD(un_); }
            PG8_WAIT_V(8); PG8_WAIT_L(0); PG8_BAR; PG8_MMA(0, 0, At, B0); PG8_MMA(0, 1, At, B1); PG8_BAR; PG8_SCHED;
            PG8_LDA(At, 0, 1); PG8_STAGE(PG8_SB(0, 0), b2, voffB); PG8_STAGE(PG8_SB(0, 1), b2 + hstep, voffB); PG8_STAGE(PG8_SA(0, 0), a2, voffA);
            PG8_WAIT_V(8); PG8_WAIT_L(0); PG8_BAR; PG8_MMA(1, 0, At, B0); PG8_MMA(1, 1, At, B1); PG8_BAR; PG8_SCHED;
            PG8_LDB(B0, 1, 0); PG8_LDB(B1, 1, 1); PG8_SCHED; PG8_LDA(At, 1, 0); PG8_STAGE(PG8_SA(0, 1), a2 + hstepA, voffA1);
            PG8_WAIT_V(8); PG8_WAIT_L(0); PG8_BAR; PG8_MMA(0, 0, At, B0); PG8_MMA(0, 1, At, B1); PG8_BAR; PG8_SCHED;
            PG8_LDA(At, 1, 1); PG8_STAGE(PG8_SB(1, 0), b3, voffB); PG8_STAGE(PG8_SB(1, 1), b3 + hstep, voffB); PG8_STAGE(PG8_SA(1, 0), a3, voffA);
            PG8_WAIT_V(8); PG8_WAIT_L(0); PG8_BAR; PG8_MMA(1, 0, At, B0); PG8_MMA(1, 1, At, B1); PG8_BAR; PG8_SCHED;
            } else {
            PG8_LDB(B0, 0, 0); PG8_SCHED; PG8_LDA(At, 0, 0); PG8_STAGE(PG8_SA(1, 1), a1 + hstep, voffA);
            PG8_WAIT_L(8); PG8_BAR; PG8_WAIT_L(0); PG8_MMA(0, 0, At, B0); PG8_BAR; PG8_SCHED;
            PG8_LDB(B1, 0, 1); PG8_STAGE(PG8_SB(0, 0), b2, voffB);
            PG8_BAR; PG8_WAIT_L(0); PG8_MMA(0, 1, At, B1); PG8_BAR;
            PG8_LDA(At, 0, 1); PG8_STAGE(PG8_SA(0, 0), a2, voffA);
            PG8_BAR; PG8_WAIT_L(0); PG8_MMA(1, 0, At, B0); PG8_BAR; PG8_SCHED;
            PG8_STAGE(PG8_SB(0, 1), b2 + hstep, voffB);
            PG8_WAIT_V(6); PG8_BAR; PG8_MMA(1, 1, At, B1); PG8_BAR;
            PG8_LDB(B0, 1, 0); PG8_SCHED; PG8_LDA(At, 1, 0); PG8_STAGE(PG8_SA(0, 1), a2 + hstep, voffA);
            PG8_WAIT_L(8); PG8_BAR; PG8_WAIT_L(0); PG8_MMA(0, 0, At, B0); PG8_BAR; PG8_SCHED;
            PG8_LDB(B1, 1, 1); PG8_STAGE(PG8_SB(1, 0), b3, voffB);
            PG8_BAR; PG8_WAIT_L(0); PG8_MMA(0, 1, At, B1); PG8_BAR;
            PG8_LDA(At, 1, 1); PG8_STAGE(PG8_SA(1, 0), a3, voffA);
            PG8_BAR; PG8_WAIT_L(0); PG8_MMA(1, 0, At, B0); PG8_BAR; PG8_SCHED;
            PG8_STAGE(PG8_SB(1, 1), b3 + hstep, voffB);
            PG8_WAIT_V(6); PG8_BAR; PG8_MMA(1, 1, At, B1); PG8_BAR;
            }
        }
        if constexpr (ALIGN_EPI) { if (wr == 0) PG8_BAR; }
        if constexpr (!Epi::AFTER_DRAIN) { int tz = threadIdx.x; asm volatile("" : "+v"(tz));
            const int lz = tz & 63; E(acc, cur, wr, wc, lz & 15, lz >> 4); S.done(cur); }
        if (!has_next) break;
#pragma unroll
        for (int a = 0; a < 2; ++a)
#pragma unroll
            for (int b = 0; b < 2; ++b)
#pragma unroll
                for (int m = 0; m < 4; ++m)
#pragma unroll
                    for (int n = 0; n < 2; ++n) acc[a][b][m][n] = (f32x4){0.f, 0.f, 0.f, 0.f};
        cur = nxt; cA = nA; cB = nB; ++ui;
        if constexpr (ALIGN_EPI) { if (wr == 1) PG8_BAR; }
    }
    PG8_WAIT_V(0);
    if constexpr (!ALIGN_EPI) { if (wr == 0) PG8_BAR; }
    PG8_BAR;
    if constexpr (Epi::AFTER_DRAIN) { E.fused(acc, cur, wr, wc, fr, fq, lds, wid, lane); S.done(cur); }
#undef PG8_GLOAD
#undef PG8_SA
#undef PG8_SB
#undef PG8_STAGE
#undef PG8_LDA
#undef PG8_LDB
#undef PG8_MMA
#undef PG8_WAIT_V
#undef PG8_WAIT_L
#undef PG8_BAR
#undef PG8_SCHED
}
}
namespace att {
using bf16 = unsigned short;
constexpr int QBLK = 32, KVBLK = 64, LDR = 1024, NKT = 2048 / KVBLK;
constexpr float SCALE = 0.125f, THR = 8.f;
constexpr int SHM_V = KVBLK * 128 * 2, SHM_K = KVBLK * 128 * 2, LDS_BYTES = 2 * SHM_V + 2 * SHM_K + 8 * 64 * 4;
using bf16x8 = __attribute__((ext_vector_type(8))) short;
using s16x4  = __attribute__((ext_vector_type(4))) short;
using f32x16 = __attribute__((ext_vector_type(16))) float;
using u32x4  = __attribute__((ext_vector_type(4))) unsigned;
#define KSWZ(row, colB) ((row) * 256 + ((colB) ^ (((row) & 7) << 4)))
#define SBAR() __builtin_amdgcn_sched_barrier(0)
__device__ __forceinline__ int crow(int r, int hi) { return (r & 3) + 8 * (r >> 2) + 4 * hi; }
__device__ __forceinline__ unsigned cvtpk(float lo, float hi) { unsigned r; asm volatile("v_cvt_pk_bf16_f32 %0, %1, %2" : "=v"(r) : "v"(lo), "v"(hi)); return r; }
__device__ __forceinline__ void partialSM(f32x16& p0, f32x16& p1, float& m_reg, float& mn, float& alpha) {
  constexpr float C = SCALE * 1.4426950408889634f;
  float pmax = p0[0]; for (int r = 1; r < 16; ++r) pmax = fmaxf(pmax, p0[r]); for (int r = 0; r < 16; ++r) pmax = fmaxf(pmax, p1[r]);
  { auto rr = __builtin_amdgcn_permlane32_swap(__float_as_uint(pmax), __float_as_uint(pmax), false, false);
    pmax = fmaxf(__uint_as_float(rr[0]), __uint_as_float(rr[1])); }
  if (__builtin_expect(__all(pmax - m_reg <= THR / SCALE), 1)) { mn = m_reg; alpha = 1.f; }
  else { mn = fmaxf(m_reg, pmax); alpha = __builtin_amdgcn_exp2f((m_reg - mn) * C); m_reg = mn; }
  float mnC = -mn * C;
  for (int r = 0; r < 16; ++r) p0[r] = fmaf(p0[r], C, mnC); for (int r = 0; r < 16; ++r) p1[r] = fmaf(p1[r], C, mnC);
  for (int r = 0; r < 16; ++r) p0[r] = __builtin_amdgcn_exp2f(p0[r]);
}
__device__ __forceinline__ void finishSM(f32x16& p0, f32x16& p1, float alpha, float& l_reg, bf16x8& pa0, bf16x8& pa1, bf16x8& pa2, bf16x8& pa3) {
  for (int r = 0; r < 16; ++r) p1[r] = __builtin_amdgcn_exp2f(p1[r]);
  float ps = 0; for (int r = 0; r < 16; ++r) ps += p0[r]; for (int r = 0; r < 16; ++r) ps += p1[r];
  { auto rr = __builtin_amdgcn_permlane32_swap(__float_as_uint(ps), __float_as_uint(ps), false, false);
    ps = __uint_as_float(rr[0]) + __uint_as_float(rr[1]); }
  l_reg = l_reg * alpha + ps;
#define PK4(P, BASE, OUT) do { unsigned a0 = cvtpk(P[BASE + 0], P[BASE + 1]), a1 = cvtpk(P[BASE + 2], P[BASE + 3]);   \
    unsigned b0 = cvtpk(P[BASE + 4], P[BASE + 5]), b1 = cvtpk(P[BASE + 6], P[BASE + 7]);                              \
    auto r0 = __builtin_amdgcn_permlane32_swap(a0, b0, false, false); auto r1 = __builtin_amdgcn_permlane32_swap(a1, b1, false, false); \
    u32x4 w = {r0[0], r1[0], r0[1], r1[1]}; OUT = *reinterpret_cast<bf16x8*>(&w); } while (0)
  PK4(p0, 0, pa0); PK4(p0, 8, pa1); PK4(p1, 0, pa2); PK4(p1, 8, pa3);
#undef PK4
}
__device__ __forceinline__ void qkt(f32x16& p0, f32x16& p1, const bf16* Ks, const bf16x8* qr, int r32, int hi, int cofsB) {
  p0 = f32x16{}; p1 = f32x16{};
  for (int d0 = 0; d0 < 4; ++d0) { int cb = cofsB + (d0 * 16 + hi * 8) * 2;
    bf16x8 b0 = *reinterpret_cast<const bf16x8*>((const char*)Ks + KSWZ(r32, cb));
    bf16x8 b1 = *reinterpret_cast<const bf16x8*>((const char*)Ks + KSWZ(32 + r32, cb));
    p0 = __builtin_amdgcn_mfma_f32_32x32x16_bf16(b0, qr[d0], p0, 0, 0, 0);
    p1 = __builtin_amdgcn_mfma_f32_32x32x16_bf16(b1, qr[d0], p1, 0, 0, 0); }
}
__device__ __forceinline__ int v_st(int k, int c) { const int kk = (k & ~0xC) | ((k & 4) << 1) | ((k & 8) >> 1); return ((kk >> 3) * 4 + (c >> 5)) * 512 + ((kk & 7) * 32 + (c & 31)) * 2; }
__device__ __forceinline__ int v_rd_base(int lane) { return ((lane & 3) << 3) | (((lane >> 2) & 3) << 6) | (((lane >> 4) & 1) << 5) | (((lane >> 5) & 1) << 8); }
constexpr int v_rd_off(int d0, int ks, int half) { return d0 * 512 + ks * 4096 + half * 2048; }
template <int OFF> __device__ __forceinline__ s16x4 tr_read(int vb) {
  s16x4 r; asm volatile("ds_read_b64_tr_b16 %0, %1 offset:%2" : "=&v"(r) : "v"(vb), "i"(OFF) : "memory"); return r;
}
template <int D0> __device__ __forceinline__ void pv_one(f32x16& od, int vb, bf16x8 pa0, bf16x8 pa1, bf16x8 pa2, bf16x8 pa3) {
  const s16x4 l0 = tr_read<v_rd_off(D0, 0, 0)>(vb), h0 = tr_read<v_rd_off(D0, 0, 1)>(vb), l1 = tr_read<v_rd_off(D0, 1, 0)>(vb), h1 = tr_read<v_rd_off(D0, 1, 1)>(vb);
  const s16x4 l2 = tr_read<v_rd_off(D0, 2, 0)>(vb), h2 = tr_read<v_rd_off(D0, 2, 1)>(vb), l3 = tr_read<v_rd_off(D0, 3, 0)>(vb), h3 = tr_read<v_rd_off(D0, 3, 1)>(vb);
  asm volatile("s_waitcnt lgkmcnt(0)" ::: "memory"); SBAR();
#define PK(L, H) (bf16x8){L[0], L[1], L[2], L[3], H[0], H[1], H[2], H[3]}
  od = __builtin_amdgcn_mfma_f32_32x32x16_bf16(pa0, PK(l0, h0), od, 0, 0, 0);
  od = __builtin_amdgcn_mfma_f32_32x32x16_bf16(pa1, PK(l1, h1), od, 0, 0, 0);
  od = __builtin_amdgcn_mfma_f32_32x32x16_bf16(pa2, PK(l2, h2), od, 0, 0, 0);
  od = __builtin_amdgcn_mfma_f32_32x32x16_bf16(pa3, PK(l3, h3), od, 0, 0, 0);
#undef PK
}
__device__ __forceinline__ void pv_d0(f32x16* o, int vb, bf16x8 pa0, bf16x8 pa1, bf16x8 pa2, bf16x8 pa3) {
  pv_one<0>(o[0], vb, pa0, pa1, pa2, pa3); pv_one<1>(o[1], vb, pa0, pa1, pa2, pa3); pv_one<2>(o[2], vb, pa0, pa1, pa2, pa3); pv_one<3>(o[3], vb, pa0, pa1, pa2, pa3);
}
__device__ __forceinline__ void attn_item(const bf16* __restrict__ Qb, const bf16* __restrict__ Kh, const bf16* __restrict__ Vh, bf16* __restrict__ Ob,
                                          float lam, float oscale, const float* __restrict__ gain, char* lds) {
  int tid_l = threadIdx.x; asm volatile("" : "+v"(tid_l));
  const int tid = tid_l, wid = tid >> 6, lane = tid & 63, r32 = lane & 31, hi = lane >> 5, rg = wid >> 1, cm = wid & 1;
  bf16* V_lds = (bf16*)lds; bf16* K_lds = (bf16*)(lds + 2 * SHM_V);
  float* ws = (float*)(lds + 2 * SHM_V + 2 * SHM_K) + wid * 64; float* li_l = ws; float* al_l = ws + 32;
  float m_reg = -1e30f, l_reg = 0; f32x16 o[4] = {}; bf16x8 qr[4];
  const bf16* Qw = Qb + (long)(rg * QBLK + r32) * LDR + cm * 64 + hi * 8;
#pragma unroll
  for (int d0 = 0; d0 < 4; ++d0) qr[d0] = *reinterpret_cast<const bf16x8*>(Qw + d0 * 16);
  const int cofsB = cm * 128;
  const int sr = tid >> 4, sc = (tid & 15) * 8, vst0 = v_st(sr, sc), vst1 = v_st(32 + sr, sc);
  const int vb0 = (int)(uintptr_t)V_lds + v_rd_base(lane);
  struct { bf16x8 vs0, vs1, ks0, ks1; } sr_[2];
#define SLOAD(i, k0) do { sr_[i].vs0 = *reinterpret_cast<const bf16x8*>(&Vh[(long)((k0) + sr) * LDR + sc]); sr_[i].vs1 = *reinterpret_cast<const bf16x8*>(&Vh[(long)((k0) + 32 + sr) * LDR + sc]); \
    sr_[i].ks0 = *reinterpret_cast<const bf16x8*>(&Kh[(long)((k0) + sr) * LDR + sc]); sr_[i].ks1 = *reinterpret_cast<const bf16x8*>(&Kh[(long)((k0) + 32 + sr) * LDR + sc]); } while (0)
#define SWRITE(b, i) do { *(bf16x8*)((char*)V_lds + (b) * SHM_V + vst0) = sr_[i].vs0;          \
    *(bf16x8*)((char*)V_lds + (b) * SHM_V + vst1) = sr_[i].vs1; int kc = sc * 2;               \
    *(bf16x8*)((char*)K_lds + (b) * SHM_K + KSWZ(sr, kc)) = sr_[i].ks0;                       \
    *(bf16x8*)((char*)K_lds + (b) * SHM_K + KSWZ(32 + sr, kc)) = sr_[i].ks1; } while (0)
#define SWAIT() asm volatile("s_waitcnt vmcnt(4)" ::: "memory")
#define RESC(a) do { if (__any((a) < 1.f)) { if (hi == 0) al_l[r32] = (a); asm volatile("s_waitcnt lgkmcnt(0)" ::: "memory"); \
    for (int d = 0; d < 4; ++d) for (int r = 0; r < 16; ++r) o[d][r] *= al_l[crow(r, hi)]; } } while (0)
  f32x16 pA0, pA1, pB0, pB1; float mnA, mnB, alA, alB; bf16x8 pa0, pa1, pa2, pa3; const int NT = NKT;
  constexpr int SE = 0, SO = 1;
  SLOAD(SE, 0); asm volatile("s_waitcnt vmcnt(0)" ::: "memory"); SWRITE(0, SE); __syncthreads();
  qkt(pA0, pA1, K_lds, qr, r32, hi, cofsB); partialSM(pA0, pA1, m_reg, mnA, alA);
  SLOAD(SO, KVBLK); if (2 < NT) SLOAD(SE, 2 * KVBLK);
  SWAIT(); SWRITE(1, SO); __syncthreads();
  for (int j = 1; j + 1 < NT; j += 2) {
    SBAR(); qkt(pB0, pB1, (bf16*)((char*)K_lds + SHM_K), qr, r32, hi, cofsB);
    finishSM(pA0, pA1, alA, l_reg, pa0, pa1, pa2, pa3); SBAR();
    SLOAD(SO, (j + 2) * KVBLK); SBAR();
    pv_d0(o, vb0, pa0, pa1, pa2, pa3); partialSM(pB0, pB1, m_reg, mnB, alB);
    __syncthreads(); SWAIT(); SWRITE(0, SE);
    RESC(alB); __syncthreads();
    SBAR(); qkt(pA0, pA1, K_lds, qr, r32, hi, cofsB);
    finishSM(pB0, pB1, alB, l_reg, pa0, pa1, pa2, pa3); SBAR();
    if (j + 3 < NT) SLOAD(SE, (j + 3) * KVBLK); SBAR();
    pv_d0(o, vb0 + (int)SHM_V, pa0, pa1, pa2, pa3); partialSM(pA0, pA1, m_reg, mnA, alA);
    __syncthreads(); SWAIT(); SWRITE(1, SO);
    RESC(alA); __syncthreads();
  }
  SBAR(); qkt(pB0, pB1, (bf16*)((char*)K_lds + SHM_K), qr, r32, hi, cofsB);
  finishSM(pA0, pA1, alA, l_reg, pa0, pa1, pa2, pa3); SBAR();
  pv_d0(o, vb0, pa0, pa1, pa2, pa3); partialSM(pB0, pB1, m_reg, mnB, alB);
  __syncthreads(); RESC(alB);
  finishSM(pB0, pB1, alB, l_reg, pa0, pa1, pa2, pa3); SBAR();
  pv_d0(o, vb0 + (int)SHM_V, pa0, pa1, pa2, pa3);
  if (hi == 0) li_l[r32] = l_reg; asm volatile("s_waitcnt lgkmcnt(0)" ::: "memory");
  float rli[16];
#pragma unroll
  for (int r = 0; r < 16; ++r) rli[r] = __builtin_amdgcn_rcpf(li_l[crow(r, hi)]);
  __syncthreads();
  float* ex = (float*)lds + rg * 4096 + lane;
  if (cm == 1) {
#pragma unroll
    for (int d0 = 0; d0 < 4; ++d0)
#pragma unroll
      for (int r = 0; r < 16; ++r) ex[(d0 * 16 + r) * 64] = o[d0][r] * rli[r] * lam;
  }
  __syncthreads();
  if (cm == 0) {
    float ss[16];
#pragma unroll
    for (int r = 0; r < 16; ++r) { float s = 0.f;
#pragma unroll
      for (int d0 = 0; d0 < 4; ++d0) { const float v = o[d0][r] * rli[r] - ex[(d0 * 16 + r) * 64]; o[d0][r] = v; s += v * v; }
      ss[r] = s; }
#pragma unroll
    for (int r = 0; r < 16; ++r) { float s = ss[r]; s += __shfl_xor(s, 1); s += __shfl_xor(s, 2); s += __shfl_xor(s, 4); s += __shfl_xor(s, 8); s += __shfl_xor(s, 16);
      ss[r] = oscale / sqrtf(s * (1.0f / 128.0f) + 1e-6f); }
    float gn[4];
#pragma unroll
    for (int d0 = 0; d0 < 4; ++d0) gn[d0] = gain[d0 * 32 + r32];
#pragma unroll
    for (int r = 0; r < 16; ++r) { bf16* orow = Ob + (long)(rg * QBLK + crow(r, hi)) * LDR + r32;
#pragma unroll
      for (int d0 = 0; d0 < 4; ++d0) { const float v = o[d0][r] * ss[r] * gn[d0]; unsigned u = __builtin_bit_cast(unsigned, v); u = (u + 0x7fffu + ((u >> 16) & 1u)) >> 16; orow[d0 * 32] = (bf16)u; } }
  }
  __syncthreads();
#undef SLOAD
#undef SWRITE
#undef SWAIT
#undef RESC
}
#undef KSWZ
#undef SBAR
}
namespace att2 {
using namespace att;
constexpr int SHM_Q = 256 * 128 * 2;
constexpr int LDS_BYTES2 = 2 * SHM_V + 2 * SHM_K + SHM_Q + 8 * 64 * 4;
#define KSWZ(row, colB) ((row) * 256 + ((colB) ^ (((row) & 15) << 4)))
#define SBAR() __builtin_amdgcn_sched_barrier(0)
__device__ __forceinline__ void qkt2(f32x16& p0, f32x16& p1, const char* Ks, const char* Qs, int qrow, int r32, int hi, int cofsB) {
  p0 = f32x16{}; p1 = f32x16{};
#pragma unroll
  for (int d0 = 0; d0 < 4; ++d0) { const int cb = cofsB + (d0 * 16 + hi * 8) * 2;
    const bf16x8 q = *reinterpret_cast<const bf16x8*>(Qs + KSWZ(qrow, cb));
    const bf16x8 b0 = *reinterpret_cast<const bf16x8*>(Ks + KSWZ(r32, cb));
    const bf16x8 b1 = *reinterpret_cast<const bf16x8*>(Ks + KSWZ(32 + r32, cb));
    p0 = __builtin_amdgcn_mfma_f32_32x32x16_bf16(b0, q, p0, 0, 0, 0);
    p1 = __builtin_amdgcn_mfma_f32_32x32x16_bf16(b1, q, p1, 0, 0, 0); }
}
__device__ __forceinline__ void attn2_items(int first, int stride, const bf16* __restrict__ Q, const bf16* __restrict__ Kg, const bf16* __restrict__ Vg, bf16* __restrict__ O,
                                            float lam, float oscale, const float* __restrict__ gain, char* lds) {
  int tid_l = threadIdx.x; asm volatile("" : "+v"(tid_l));
  const int tid = tid_l, wid = tid >> 6, lane = tid & 63, r32 = lane & 31, hi = lane >> 5;
  char* V_lds = lds; char* K_lds = lds + 2 * SHM_V; char* Q_lds = lds + 2 * SHM_V + 2 * SHM_K;
  float* ws = (float*)(lds + 2 * SHM_V + 2 * SHM_K + SHM_Q) + wid * 64; float* li_l = ws; float* al_l = ws + 32;
  const int sr = tid >> 4, sc = (tid & 15) * 8, vst0 = v_st(sr, sc), vst1 = v_st(32 + sr, sc);
  const int vb0 = (int)(uintptr_t)V_lds + v_rd_base(lane);
  const int qrow = wid * 32 + r32;
  const unsigned kvoff0 = (unsigned)(sr * LDR + sc) * 2u;
  for (int it = first; it < 8 * 8 * 8; it += stride) {
    unsigned kvoff = kvoff0; asm volatile("" : "+v"(kvoff));
    const int qb = it & 7, h = (it >> 3) & 7, b = it >> 6;
    const bf16* Qb = Q + ((long)b * 2048 + qb * 256) * LDR + h * 128; const bf16* Kh = Kg + (long)b * 2048 * LDR + h * 128; const bf16* Vh = Vg + (long)b * 2048 * LDR + h * 128;
    bf16* Ob = O + ((long)b * 2048 + qb * 256) * LDR + h * 128;
    bf16x8 vs0, vs1, ks0, ks1;
#define SLOAD2(k0) do { const char* vb_ = (const char*)Vh + (size_t)(k0) * (LDR * 2); const char* kb_ = (const char*)Kh + (size_t)(k0) * (LDR * 2);     \
    vs0 = *reinterpret_cast<const bf16x8*>(vb_ + kvoff); vs1 = *reinterpret_cast<const bf16x8*>(vb_ + kvoff + (unsigned)(32 * LDR * 2)); \
    ks0 = *reinterpret_cast<const bf16x8*>(kb_ + kvoff); ks1 = *reinterpret_cast<const bf16x8*>(kb_ + kvoff + (unsigned)(32 * LDR * 2)); } while (0)
#define SWRITE2(bf) do { *(bf16x8*)(V_lds + (bf) * SHM_V + vst0) = vs0; *(bf16x8*)(V_lds + (bf) * SHM_V + vst1) = vs1; const int kc = sc * 2; \
    *(bf16x8*)(K_lds + (bf) * SHM_K + KSWZ(sr, kc)) = ks0; *(bf16x8*)(K_lds + (bf) * SHM_K + KSWZ(32 + sr, kc)) = ks1; } while (0)
#define RESC2(o, a) do { if (__any((a) < 1.f)) { if (hi == 0) al_l[r32] = (a); asm volatile("s_waitcnt lgkmcnt(0)" ::: "memory"); \
    for (int d = 0; d < 4; ++d) for (int r = 0; r < 16; ++r) o[d][r] *= al_l[crow(r, hi)]; } } while (0)
    SLOAD2(0);
    {
      bf16x8 qv[8]; int srz = sr; asm volatile("" : "+v"(srz));
      const unsigned qoff = (unsigned)(srz * LDR + sc) * 2u;
#pragma unroll
      for (int i = 0; i < 8; ++i) qv[i] = *reinterpret_cast<const bf16x8*>((const char*)Qb + qoff + (unsigned)(32 * i * LDR * 2));
#pragma unroll
      for (int i = 0; i < 8; ++i) *(bf16x8*)(Q_lds + KSWZ(srz + 32 * i, sc * 2)) = qv[i]; }
    SWRITE2(0);
    __syncthreads();
    f32x16 o0[4] = {}, o1[4] = {}; float m0 = -1e30f, l0 = 0.f, m1 = -1e30f, l1 = 0.f;
    for (int j = 0; j < NKT; ++j) {
      const int bf = j & 1;
      int qrow_l = qrow; asm volatile("" : "+v"(qrow_l));
      if (j + 1 < NKT) SLOAD2((j + 1) * KVBLK);
      const char* Ks = K_lds + bf * SHM_K; const int vb = vb0 + bf * SHM_V;
      { f32x16 p0, p1; float mn, al; bf16x8 pa0, pa1, pa2, pa3;
        qkt2(p0, p1, Ks, Q_lds, qrow_l, r32, hi, 0);
        partialSM(p0, p1, m0, mn, al); RESC2(o0, al);
        finishSM(p0, p1, al, l0, pa0, pa1, pa2, pa3); SBAR();
        pv_d0(o0, vb, pa0, pa1, pa2, pa3); }
      SBAR();
      { f32x16 p0, p1; float mn, al; bf16x8 pa0, pa1, pa2, pa3;
        qkt2(p0, p1, Ks, Q_lds, qrow_l, r32, hi, 128);
        partialSM(p0, p1, m1, mn, al); RESC2(o1, al);
        finishSM(p0, p1, al, l1, pa0, pa1, pa2, pa3); SBAR();
        pv_d0(o1, vb, pa0, pa1, pa2, pa3); }
      if (j + 1 < NKT) SWRITE2(bf ^ 1);
      __syncthreads();
    }
    {
    int lz = tid_l & 63; asm volatile("" : "+v"(lz));
    const int r32 = lz & 31, hi = lz >> 5;
    if (hi == 0) { li_l[r32] = l0; al_l[r32] = l1; } asm volatile("s_waitcnt lgkmcnt(0)" ::: "memory");
    float ss[16];
#pragma unroll
    for (int r = 0; r < 16; ++r) { const float ra = __builtin_amdgcn_rcpf(li_l[crow(r, hi)]), rb = lam * __builtin_amdgcn_rcpf(al_l[crow(r, hi)]); float s = 0.f;
#pragma unroll
      for (int d0 = 0; d0 < 4; ++d0) { const float v = o0[d0][r] * ra - o1[d0][r] * rb; o0[d0][r] = v; s += v * v; }
      ss[r] = s; }
#pragma unroll
    for (int r = 0; r < 16; ++r) { float s = ss[r]; s += __shfl_xor(s, 1); s += __shfl_xor(s, 2); s += __shfl_xor(s, 4); s += __shfl_xor(s, 8); s += __shfl_xor(s, 16);
      ss[r] = oscale / sqrtf(s * (1.0f / 128.0f) + 1e-6f); }
    float gn[4];
#pragma unroll
    for (int d0 = 0; d0 < 4; ++d0) gn[d0] = gain[d0 * 32 + r32];
#pragma unroll
    for (int r = 0; r < 16; ++r) { bf16* orow = Ob + (long)(wid * QBLK + crow(r, hi)) * LDR + r32;
#pragma unroll
      for (int d0 = 0; d0 < 4; ++d0) { const float v = o0[d0][r] * ss[r] * gn[d0]; unsigned u = __builtin_bit_cast(unsigned, v); u = (u + 0x7fffu + ((u >> 16) & 1u)) >> 16; orow[d0 * 32] = (bf16)u; } }
    }
    __syncthreads();
#undef SLOAD2
#undef SWRITE2
#undef RESC2
  }
}
#undef KSWZ
#undef SBAR
}
#define GAS __attribute__((address_space(1)))
typedef GAS unsigned gu32;
constexpr int NWAVES = 8;
constexpr int RING_BYTES = 131072, LDS_TOTAL = 147456, MISC_OFF = LDS_TOTAL - 256;
constexpr int CW_CONVQ = 1024;
constexpr int CW_BAR = 4096;
constexpr int N_PHASES = 2 + 9 * NL;

#define XB_TMO      128
#define XB_XCNT(j)  (256  + 64 * (j))
#define XB_XSUB(j)  (1280 + 64 * (j))
#define XB_XGEN(j)  (2304 + 64 * (j))
#define XB_TOP      3328
#define XB_TOPGEN   3392
#define XCD_BAR_WORDS 3456
#define XB_SPIN_CAP (1u << 18)
__device__ __forceinline__ unsigned xb_ld(unsigned* p)              { return __hip_atomic_load(p, __ATOMIC_RELAXED, __HIP_MEMORY_SCOPE_AGENT); }
__device__ __forceinline__ unsigned xb_add(unsigned* p, unsigned v) { return __hip_atomic_fetch_add(p, v, __ATOMIC_RELAXED, __HIP_MEMORY_SCOPE_AGENT); }
__device__ __forceinline__ unsigned xb_xcc_id() { return (unsigned)__builtin_amdgcn_s_getreg((3 << 11) | 20) & 0xFu; }
#define XB_SPIN(cond, bar) do { unsigned _sp = 0; while (cond) { __builtin_amdgcn_s_sleep(1); \
    if ((++_sp & 255u) == 0u) { if (xb_ld(&(bar)[XB_TMO])) break; if (_sp > XB_SPIN_CAP) { atomicAdd(&(bar)[XB_TMO], 1u); break; } } } } while (0)
struct XcdBarrier { unsigned* bar; unsigned x; volatile LAS unsigned* st; };
__device__ __forceinline__ XcdBarrier xcd_barrier_post(unsigned* bar, volatile LAS unsigned* st) {
    XcdBarrier b; b.bar = bar; b.x = xb_xcc_id(); b.st = st;
    if (threadIdx.x == 0) (void)xb_add(&bar[XB_XCNT(b.x)], 1u);
    return b;
}
__device__ __forceinline__ void xcd_barrier_complete(unsigned* bar, unsigned x, unsigned& nloc, unsigned& nx) {
    const unsigned G = gridDim.x * gridDim.y * gridDim.z;
    unsigned sum, cnt, mine, sp = 0u;
    for (;;) {
        sum = 0u; cnt = 0u; mine = 0u;
#pragma unroll
        for (unsigned j = 0; j < 16; ++j) { const unsigned c = xb_ld(&bar[XB_XCNT(j)]); sum += c; cnt += (c > 0u) ? 1u : 0u; mine = (j == x) ? c : mine; }
        if (sum == G) break;
        __builtin_amdgcn_s_sleep(1);
        if ((++sp & 255u) == 0u) { if (xb_ld(&bar[XB_TMO])) break; if (sp > XB_SPIN_CAP) { atomicAdd(&bar[XB_TMO], 1u); break; } }
    }
    nloc = mine > 0u ? mine : 1u; nx = cnt > 0u ? cnt : 1u;
}
__device__ __forceinline__ void xcd_barrier(const XcdBarrier& b) {
    asm volatile("s_waitcnt vmcnt(0)" ::: "memory");
    __syncthreads();
    if (threadIdx.x == 0) {
        unsigned* bar = b.bar;
        __builtin_amdgcn_s_waitcnt(0);
        unsigned nloc = b.st[0], nx = b.st[1];
        if (nloc == 0u) { xcd_barrier_complete(bar, b.x, nloc, nx); b.st[0] = nloc; b.st[1] = nx; }
        const unsigned old = xb_add(&bar[XB_XSUB(b.x)], 1u);
        const unsigned gen = old / nloc;
        if (old + 1u == (gen + 1u) * nloc) {
            __builtin_amdgcn_fence(__ATOMIC_RELEASE, "agent");
            asm volatile("s_waitcnt vmcnt(0)" ::: "memory");
            const unsigned og = xb_add(&bar[XB_TOP], 1u);
            const unsigned tg = og / nx;
            if (og + 1u == (tg + 1u) * nx) xb_add(&bar[XB_TOPGEN], 1u);
            else XB_SPIN(xb_ld(&bar[XB_TOPGEN]) == tg, bar);
            __builtin_amdgcn_fence(__ATOMIC_ACQUIRE, "agent");
            xb_add(&bar[XB_XGEN(b.x)], 1u);
            asm volatile("s_waitcnt vmcnt(0)" ::: "memory");
        } else {
            XB_SPIN(xb_ld(&bar[XB_XGEN(b.x)]) == gen, bar);
            __builtin_amdgcn_fence(__ATOMIC_ACQUIRE, "agent");
            asm volatile("s_waitcnt vmcnt(0)" ::: "memory");
        }
    }
    __syncthreads();
}

__device__ __forceinline__ void gmlp_item(int item, const bf16_t* __restrict__ UV, const float* __restrict__ w_s_l, const float* __restrict__ b_s_l, bf16_t* __restrict__ COUT, LAS unsigned char* lds, int tid) {
    const int g = item & 3, n = (item >> 2) & 15, b = item >> 6, lane = tid & 63, wave = tid >> 6, fr = lane & 15, fq = lane >> 4;
    const size_t t0 = (size_t)b * SEQ + n * 128;
    LAS bf16_t* vgT = (LAS bf16_t*)lds;
    LAS bf16_t* wsb = (LAS bf16_t*)(lds + 34816);
    __syncthreads();
    { const int q = tid >> 2, qt = tid & 3;
      const u32x4* src = (const u32x4*)(UV + (t0 + q) * 1024 + 512 + g * 128 + qt * 32);
      float v[32]; float ss = 0.f;
#pragma unroll
      for (int i = 0; i < 4; ++i) { const u32x4 w = src[i]; f32x4 a, c; pg8::unpack8(w, a, c);
#pragma unroll
          for (int j = 0; j < 4; ++j) { v[i * 8 + j] = a[j]; v[i * 8 + 4 + j] = c[j]; ss += a[j] * a[j] + c[j] * c[j]; } }
      ss += __shfl_xor(ss, 1); ss += __shfl_xor(ss, 2);
      const float r = 1.0f / sqrtf(ss * (1.0f / 128.0f) + EPS);
#pragma unroll
      for (int cc = 0; cc < 32; ++cc) vgT[(qt * 32 + cc) * 136 + q] = (bf16_t)f2bf(v[cc] * r);
      const f32x4* wsrc = (const f32x4*)(w_s_l + ((size_t)g * 128 + q) * 128 + qt * 32);
#pragma unroll
      for (int i = 0; i < 4; ++i) { const f32x4 a = wsrc[2 * i], c = wsrc[2 * i + 1]; *(LAS u32x4*)(wsb + q * 136 + qt * 32 + i * 8) = pg8::pack8(a, c); } }
    __syncthreads();
    f32x4 acc[8];
#pragma unroll
    for (int j = 0; j < 8; ++j) acc[j] = (f32x4){0.f, 0.f, 0.f, 0.f};
#pragma unroll
    for (int ks = 0; ks < 4; ++ks) { const bf16x8 wfrag = *(const LAS bf16x8*)(wsb + (16 * wave + fr) * 136 + ks * 32 + fq * 8);
#pragma unroll
        for (int j = 0; j < 8; ++j) { const bf16x8 vfrag = *(const LAS bf16x8*)(vgT + (16 * j + fr) * 136 + ks * 32 + fq * 8); acc[j] = __builtin_amdgcn_mfma_f32_16x16x32_bf16(vfrag, wfrag, acc[j], 0, 0, 0); } }
    { const int p = 16 * wave + fr; const float bias = b_s_l[g * 128 + p];
      const bf16_t* urow = UV + (t0 + p) * 1024 + g * 128 + 4 * fq; bf16_t* orow = COUT + (t0 + p) * 512 + g * 128 + 4 * fq;
      unsigned long long uu[8];
#pragma unroll
      for (int j = 0; j < 8; ++j) uu[j] = *(const unsigned long long*)(urow + 16 * j);
#pragma unroll
      for (int j = 0; j < 8; ++j) { const unsigned lo = (unsigned)uu[j], hi = (unsigned)(uu[j] >> 32);
          const float u0 = __builtin_bit_cast(float, lo << 16), u1 = __builtin_bit_cast(float, lo & 0xffff0000u), u2 = __builtin_bit_cast(float, hi << 16), u3 = __builtin_bit_cast(float, hi & 0xffff0000u);
          *(unsigned long long*)(orow + 16 * j) = (unsigned long long)pk2(u0 * (acc[j][0] + bias), u1 * (acc[j][1] + bias)) | ((unsigned long long)pk2(u2 * (acc[j][2] + bias), u3 * (acc[j][3] + bias)) << 32); } }
}
__device__ __forceinline__ void topk_gather_item(int pair, int half, const float* __restrict__ AFF, int* __restrict__ SEL, unsigned* __restrict__ GIDX, LAS unsigned char* lds, int tid) {
    const int lane = tid & 63, wave = tid >> 6, b = pair >> 4, e = pair & 15;
    LAS int* cntA = (LAS int*)lds; LAS int* scanw = (LAS int*)(lds + 64); LAS int* idxs = (LAS int*)(lds + 128);
    const f32x4 xv = *(const f32x4*)(AFF + (size_t)pair * SEQ + tid * 4);
    unsigned u[4];
#pragma unroll
    for (int k = 0; k < 4; ++k) { const float f = xv[k]; u[k] = __float_as_uint(f); }
    unsigned T = 0u;
    __syncthreads();
    for (int bit = 30; bit >= 0; --bit) {
        const unsigned cand = T | (1u << bit); int c = 0;
#pragma unroll
        for (int k = 0; k < 4; ++k) c += __popcll(__ballot(u[k] >= cand));
        LAS int* buf = cntA + (bit & 1) * 8;
        if (lane == 0) buf[wave] = c;
        __syncthreads();
        int tot = 0;
#pragma unroll
        for (int w = 0; w < 8; ++w) tot += buf[w];
        if (tot >= CAP) T = cand;
    }
    int gt[4], eq[4], loc = 0;
#pragma unroll
    for (int k = 0; k < 4; ++k) { gt[k] = u[k] > T ? 1 : 0; eq[k] = u[k] == T ? 1 : 0; loc += gt[k] + (eq[k] << 16); }
    int inc = loc;
#pragma unroll
    for (int o = 1; o < 64; o <<= 1) { const int t = __shfl_up(inc, o); if (lane >= o) inc += t; }
    if (lane == 63) scanw[wave] = inc;
    __syncthreads();
    int base = 0, total = 0;
#pragma unroll
    for (int w = 0; w < 8; ++w) { const int s = scanw[w]; base += (w < wave) ? s : 0; total += s; }
    const int excl = base + inc - loc, need_eq = CAP - (total & 0xffff);
    int pg = excl & 0xffff, pe = excl >> 16, sl[4];
#pragma unroll
    for (int k = 0; k < 4; ++k) { const bool sel = gt[k] || (eq[k] && pe < need_eq); const int slot = pg + (pe < need_eq ? pe : need_eq);
        sl[k] = sel ? slot : -1; if (sel) idxs[slot] = tid * 4 + k; pg += gt[k]; pe += eq[k]; }
    if (half == 0) *(int __attribute__((ext_vector_type(4)))*)(SEL + (size_t)pair * SEQ + tid * 4) = (int __attribute__((ext_vector_type(4)))){sl[0], sl[1], sl[2], sl[3]};
    __syncthreads();
    if (tid < 128) { const int slot = half * 128 + tid; GIDX[(size_t)e * 2048 + b * CAP + slot] = (unsigned)(b * SEQ + idxs[slot]) * (unsigned)(DM * 2); }
}
__device__ __forceinline__ void stage_router(const float* __restrict__ w_router, LAS unsigned char* lds, int tid) {
    __syncthreads();
    for (int i = tid; i < DM * 4; i += 512) { const int k = i >> 2, e4 = i & 3; *(LAS f32x4*)(lds + (k >> 2) * 272 + (k & 3) * 64 + e4 * 16) = ((const f32x4*)w_router)[i]; }
    __syncthreads();
}
__device__ __forceinline__ void mod_load(f32x4 (&am)[4], f32x4 (&bm)[4], const float* __restrict__ gain, const float* __restrict__ ada_b, int sh_off, int sc_off, int lane) {
#pragma unroll
    for (int j = 0; j < 4; ++j) { const int col = 4 * lane + 256 * j; const f32x4 g4 = *(const f32x4*)(gain + col), sc = *(const f32x4*)(ada_b + sc_off + col); bm[j] = *(const f32x4*)(ada_b + sh_off + col); am[j] = g4 * (sc + 1.0f); }
}
template <bool ROUTER>
__device__ __forceinline__ void hprep_regs(const f32x4 (&v)[4], int t, int lane, const f32x4 (&am)[4], const f32x4 (&bm)[4], bf16_t* __restrict__ H, const LAS unsigned char* wl, float* __restrict__ AFF) {
    float ss = 0.f;
#pragma unroll
    for (int j = 0; j < 4; ++j) ss += (v[j].x * v[j].x + v[j].y * v[j].y) + (v[j].z * v[j].z + v[j].w * v[j].w);
    const float r = 1.0f / sqrtf(wave_sum(ss) * (1.0f / DM) + EPS);
    float lg[NE];
    if (ROUTER) {
#pragma unroll
        for (int e = 0; e < NE; ++e) lg[e] = 0.f; }
#pragma unroll
    for (int j = 0; j < 4; ++j) { const int col = 4 * lane + 256 * j;
        const f32x4 h = (v[j] * r) * am[j] + bm[j];
        *(unsigned long long*)(H + (size_t)t * DM + col) = (unsigned long long)pk2(h.x, h.y) | ((unsigned long long)pk2(h.z, h.w) << 32);
        if (ROUTER) {
#pragma unroll
            for (int q = 0; q < 4; ++q) { const float hv = h[q]; const LAS f32x4* wr = (const LAS f32x4*)(wl + (lane + 64 * j) * 272 + q * 64);
#pragma unroll
                for (int e4 = 0; e4 < 4; ++e4) { const f32x4 w = wr[e4]; lg[e4 * 4 + 0] += hv * w.x; lg[e4 * 4 + 1] += hv * w.y; lg[e4 * 4 + 2] += hv * w.z; lg[e4 * 4 + 3] += hv * w.w; } }
            __builtin_amdgcn_sched_barrier(0);
        }
    }
    if (ROUTER) {
        float a8[8], a4[4], a2[2], a1;
#pragma unroll
        for (int i = 0; i < 8; ++i) { const bool up = lane & 1; const float send = up ? lg[i] : lg[8 + i], keep = up ? lg[8 + i] : lg[i]; a8[i] = keep + __shfl_xor(send, 1); }
#pragma unroll
        for (int i = 0; i < 4; ++i) { const bool up = lane & 2; const float send = up ? a8[i] : a8[4 + i], keep = up ? a8[4 + i] : a8[i]; a4[i] = keep + __shfl_xor(send, 2); }
#pragma unroll
        for (int i = 0; i < 2; ++i) { const bool up = lane & 4; const float send = up ? a4[i] : a4[2 + i], keep = up ? a4[2 + i] : a4[i]; a2[i] = keep + __shfl_xor(send, 4); }
        { const bool up = lane & 8; const float send = up ? a2[0] : a2[1], keep = up ? a2[1] : a2[0]; a1 = keep + __shfl_xor(send, 8); }
        a1 += __shfl_xor(a1, 16); a1 += __shfl_xor(a1, 32);
        const int e_mine = ((lane & 1) << 3) | ((lane & 2) << 1) | ((lane & 4) >> 1) | ((lane & 8) >> 3);
        float mx = a1;
#pragma unroll
        for (int o = 1; o < 16; o <<= 1) mx = fmaxf(mx, __shfl_xor(mx, o));
        const float ex = expf(a1 - mx); float den = ex;
#pragma unroll
        for (int o = 1; o < 16; o <<= 1) den += __shfl_xor(den, o);
        const int b = t >> 11, s = t & 2047;
        if (lane < 16) AFF[((size_t)b * NE + e_mine) * SEQ + s] = ex / den;
    }
}

#define PHASE_IDS int tid_p_ = threadIdx.x; asm volatile("" : "+v"(tid_p_)); const int tid = tid_p_, lane = tid & 63, wave = __builtin_amdgcn_readfirstlane(tid >> 6), gw = vcu * NWAVES + wave; (void)tid; (void)lane; (void)wave; (void)gw
struct MArgs { const float* in[24]; float* out; unsigned char* ws; InvF invf; float lam_init[2]; int ph_lo, ph_hi, li, pad; };

__global__ void __launch_bounds__(NWAVES * 64, 2) mega(MArgs a) {
    extern __shared__ __attribute__((aligned(16))) unsigned char lds[];
    LAS unsigned char* L = (LAS unsigned char*)lds;
    volatile LAS unsigned* MISC = (volatile LAS unsigned*)(L + MISC_OFF);
    const int tid = threadIdx.x, lane = tid & 63, wave = __builtin_amdgcn_readfirstlane(tid >> 6);
    const int G = gridDim.x, bx = blockIdx.x, vcu = (G % 8 == 0) ? (bx % 8) * (G / 8) + bx / 8 : bx;
    unsigned char* ws = a.ws;
    if (tid < 64) MISC[tid] = 0u;
    __syncthreads();
    XcdBarrier bar = xcd_barrier_post((unsigned*)(ws + WS_CTL) + CW_BAR + a.li * XCD_BAR_WORDS, MISC + 8);
    const int lo = a.ph_lo, hi = a.ph_hi;
#define IN(k) (lo <= (k) && (k) < hi)
#ifndef REPEAT_MASK
#define REPEAT_MASK 0u
#endif
#define REPS(k) (int)(1u + ((REPEAT_MASK >> (k)) & 1u))
#ifndef REPEAT_L
#define REPEAT_L 0u
#endif
#define REPS_L(k) (int)(1u + ((REPEAT_L >> (k)) & 1u))
#define SEAM(k) do { if (IN(k) && IN((k) + 1)) xcd_barrier(bar); } while (0)
    const float* x_in = a.in[0]; const float* g_mix = a.in[5]; const float* g_ffn = a.in[6];
    float* X = (float*)(ws + WS_X); bf16_t* H = (bf16_t*)(ws + WS_H); const float* ADA = (const float*)(ws + WS_CTL + CTL_ADA);
    bf16_t *Q = (bf16_t*)(ws + WS_Q), *Kb = (bf16_t*)(ws + WS_K), *V = (bf16_t*)(ws + WS_V), *YT = (bf16_t*)(ws + WS_YT), *UV = (bf16_t*)(ws + WS_UV), *GATES = (bf16_t*)(ws + WS_GATES);
    bf16_t *AOUT = (bf16_t*)(ws + WS_AOUT), *BOUT = (bf16_t*)(ws + WS_BOUT), *COUT = (bf16_t*)(ws + WS_COUT), *T1 = (bf16_t*)(ws + WS_T1), *T2 = (bf16_t*)(ws + WS_T2), *MERGED = (bf16_t*)(ws + WS_MERGED);
    bf16_t *XIN = (bf16_t*)(ws + WS_XIN), *HID = (bf16_t*)(ws + WS_HID); float* Y = (float*)(ws + WS_Y);
    int* SEL = (int*)(ws + WS_SEL); float* AFF = (float*)(ws + WS_AFF);
    const int gw = vcu * NWAVES + wave, NGW = G * NWAVES;

    if (IN(0)) for (int rep_ = 0; rep_ < REPS(0); ++rep_) {

#ifndef SKIP_PRO
        const size_t gt = (size_t)bx * 512 + tid, GT = (size_t)G * 512;
        for (size_t i = gt; i < (size_t)MT * 8; i += GT) rope_entry((int)i, (const int*)a.in[2], (float*)(ws + WS_ROPE), a.invf);
        { LAS float* tc = (LAS float*)L; LAS float* tsn = tc + 2048;
          for (int j = tid; j < 2048; j += 512) { double sn, cs; sincos_d((double)j * (6.283185307179586476925 / 2048.0), sn, cs); tc[j] = (float)(cs * (1.0 / 512.0)); tsn[j] = (float)(-sn * (1.0 / 512.0)); }
          __syncthreads();
          for (size_t i = gt; i < (size_t)2048 * 256; i += GT) { const int m = (int)(i >> 8), k0 = (int)(i & 255) * 8; unsigned cw[4], sw[4];
#pragma unroll
              for (int j = 0; j < 4; ++j) { const int r0 = (m * (k0 + 2 * j)) & 2047, r1 = (m * (k0 + 2 * j + 1)) & 2047; cw[j] = cvtpk_c(tc[r0], tc[r1]); sw[j] = cvtpk_c(tsn[r0], tsn[r1]); }
              *(u32x4*)((bf16_t*)(ws + WS_DFTC) + (size_t)m * 2048 + k0) = (u32x4){cw[0], cw[1], cw[2], cw[3]};
              *(u32x4*)((bf16_t*)(ws + WS_DFTS) + (size_t)m * 2048 + k0) = (u32x4){sw[0], sw[1], sw[2], sw[3]}; }
          __syncthreads(); }
        for (size_t i = gt; i < (size_t)NL * NE * PAD_CH; i += GT) pad_chunk(i, ws);
        for (int it = bx; it < NL * 96; it += G) ada_item(it, a.in[1], a.in[3], a.in[4], (float*)(ws + WS_CTL + CTL_ADA), (LAS float*)L, tid);
        for (int it = G - 1 - bx; it < NL * 4 * 16; it += G) fold_item(it, a.in[7], (bf16_t*)(ws + WS_WIN), (LAS float*)L, tid);
        __syncthreads();
        ConvPtrs P{a.in[7], a.in[15], a.in[16], a.in[17], a.in[18], a.in[20], a.in[21], a.in[22], ws};
        LAS float* scr = (LAS float*)L + wave * (64 * 65);
#ifndef CONV_REPS
#define CONV_REPS 1
#endif
        for (int crep = 0; crep < CONV_REPS; ++crep) { __syncthreads();
        unsigned* qctr = (unsigned*)(ws + WS_CTL) + CW_CONVQ + 64 * crep;
        f32x4 va[16], vb[16]; TileDesc da, db;
        int base = 0, sub = 4, cur = CV_TOTAL;
#define CLAIM_NEXT(dst) do { if (sub == 4) { unsigned t_ = 0u; if (lane == 0) t_ = __hip_atomic_fetch_add(qctr, 4u, __ATOMIC_RELAXED, __HIP_MEMORY_SCOPE_AGENT); base = (int)__builtin_amdgcn_readfirstlane(t_); sub = 0; } \
            dst = base + sub; ++sub; } while (0)
        CLAIM_NEXT(cur);
        if (cur < CV_TOTAL) { da = conv_decode(cur, P); tile_load(da, va, lane);
            for (;;) { int nxt; CLAIM_NEXT(nxt); const bool hn = nxt < CV_TOTAL;
                if (hn) { db = conv_decode(nxt, P); tile_load(db, vb, lane); }
                tile_store(da, va, scr, lane);
                if (!hn) break;
                da = db;
#pragma unroll
                for (int i = 0; i < 16; ++i) va[i] = vb[i]; } }
        }
#undef CLAIM_NEXT
#endif

    }
    SEAM(0);
    if (IN(1)) for (int rep_ = 0; rep_ < REPS(1); ++rep_) {

#ifndef SKIP_HP1
        for (int t0 = 8 * gw; t0 < MT; t0 += 8 * NGW) {
            f32x4 am[4], bm[4]; mod_load(am, bm, g_mix, ADA + (size_t)(t0 >> 11) * 6144, 0, 1024, lane);
#pragma unroll 1
            for (int p = 0; p < 4; ++p) { const int t = t0 + 2 * p; const f32x4* xr = (const f32x4*)(x_in + (size_t)t * DM) + lane; f32x4 v[4], w[4];
#pragma unroll
                for (int j = 0; j < 4; ++j) { v[j] = xr[64 * j]; w[j] = xr[256 + 64 * j]; }
                hprep_regs<false>(v, t, lane, am, bm, H, (const LAS unsigned char*)nullptr, nullptr);
                hprep_regs<false>(w, t + 1, lane, am, bm, H, (const LAS unsigned char*)nullptr, nullptr); } }
#endif

    }
    SEAM(1);
    for (int l = 0; l < NL; ++l) {
        const int pb = 2 + 9 * l;
        const float* ada_l = ADA + (size_t)l * NB * 6144;
        asm volatile(".rept 2\n s_nop 0\n .endr");
        if (IN(pb + 0)) for (int rep_ = 0; rep_ < REPS_L(0); ++rep_) { PHASE_IDS;

#ifndef SKIP_WIN
            pg8::Gemm g{H, (const bf16_t*)(ws + WS_WIN) + (size_t)l * NIN * DM, MT, NIN, DM, 0}; pg8::StaticOrder S; S.init(MT, NIN, G, bx); S.rev = 1;
            pg8::EpiWin E{Q, YT, UV, GATES, (const float*)(ws + WS_ROPE)};
            pg8::gemm_phase<pg8::EpiWin, pg8::StaticOrder, true, true>(L, g, S, E);
#endif

        }
        SEAM(pb + 0);
        asm volatile(".rept 15\n s_nop 0\n .endr");
        if (IN(pb + 1)) for (int rep_ = 0; rep_ < REPS_L(1); ++rep_) { PHASE_IDS;
            float lam;
            { const float* q1 = a.in[8] + l * 64; const float* k1 = a.in[9] + l * 64; const float* q2 = a.in[10] + l * 64; const float* k2 = a.in[11] + l * 64;
              float d1 = q1[lane] * k1[lane], d2 = q2[lane] * k2[lane]; d1 = wave_sum(d1); d2 = wave_sum(d2); lam = expf(d1) - expf(d2) + a.lam_init[l]; }
            const float oscale = 1.0f - a.lam_init[l];

#ifndef SKIP_ATT
#if ATT_DUAL
            for (int rep2_ = 0; rep2_ < REPS_L(9); ++rep2_) att2::attn2_items(vcu, G, Q, Kb, V, AOUT, lam, oscale, a.in[12] + l * 128, (char*)lds);
#else
            for (int rep2_ = 0; rep2_ < REPS_L(9); ++rep2_)
            for (int it = vcu; it < NB * 8 * 16; it += G) { const int qb = it & 15, h = (it >> 4) & 7, b = it >> 7;
                const size_t qo = ((size_t)b * SEQ + qb * 128) * DM + h * 128, ko = (size_t)b * SEQ * DM + h * 128;
                att::attn_item(Q + qo, Kb + ko, V + ko, AOUT + qo, lam, oscale, a.in[12] + l * 128, (char*)lds); }
#endif
#endif


#ifndef SKIP_DFT
            for (int rep3_ = 0; rep3_ < REPS_L(10); ++rep3_)
            { pg8::Gemm g{(const bf16_t*)(ws + WS_DFTC), YT, 4096, 8192, SEQ, 0}; pg8::GroupOrder S; S.init(16, 8, 2, G, bx, 1); pg8::EpiDft E{BOUT};
              pg8::gemm_phase<pg8::EpiDft, pg8::GroupOrder, true, true>(L, g, S, E); }
#endif


#ifndef SKIP_GMLP
            for (int rep4_ = 0; rep4_ < REPS_L(11); ++rep4_)
            for (int it = vcu; it < NB * 16 * 4; it += G) gmlp_item(it, UV, a.in[13] + (size_t)l * 4 * 128 * 128, a.in[14] + (size_t)l * 4 * 128, COUT, L, tid);
#endif

        }
        SEAM(pb + 1);
        if (IN(pb + 2)) for (int rep_ = 0; rep_ < REPS_L(2); ++rep_) { PHASE_IDS;
            pg8::StaticOrder S; S.init(MT, DM, G, bx);

#ifndef SKIP_PROJ
            { pg8::Gemm g{AOUT, (const bf16_t*)(ws + WS_PA) + (size_t)l * 1024 * 1024, MT, DM, 1024, 0}; pg8::EpiProj<0> E{GATES, T1, T2, MERGED}; pg8::gemm_phase<pg8::EpiProj<0>, pg8::StaticOrder, false, true>(L, g, S, E); }
            { pg8::Gemm g{BOUT, (const bf16_t*)(ws + WS_PB) + (size_t)l * 1024 * 1024, MT, DM, 1024, 0}; pg8::EpiProj<1> E{GATES, T1, T2, MERGED}; pg8::gemm_phase<pg8::EpiProj<1>, pg8::StaticOrder, false, true>(L, g, S, E); }
            { pg8::Gemm g{COUT, (const bf16_t*)(ws + WS_PC) + (size_t)l * 1024 * 512, MT, DM, 512, 0}; pg8::EpiProj<2> E{GATES, T1, T2, MERGED}; pg8::gemm_phase<pg8::EpiProj<2>, pg8::StaticOrder, false, true>(L, g, S, E); }
#endif

        }
        SEAM(pb + 2);
        if (IN(pb + 3)) for (int rep_ = 0; rep_ < REPS_L(3); ++rep_) { PHASE_IDS;
            pg8::Gemm g{MERGED, (const bf16_t*)(ws + WS_WOUT) + (size_t)l * 1024 * 1024, MT, DM, 1024, 0}; pg8::StaticOrder S; S.init(MT, DM, G, bx);

#ifndef SKIP_WOUT
            pg8::EpiWout E{l == 0 ? x_in : (const float*)X, X, ada_l + 2048};
            pg8::gemm_phase<pg8::EpiWout, pg8::StaticOrder, false, true>(L, g, S, E);
#endif

        }
        SEAM(pb + 3);
        if (IN(pb + 4)) for (int rep_ = 0; rep_ < REPS_L(4); ++rep_) { PHASE_IDS;

#ifndef SKIP_HP2
            stage_router(a.in[19] + (size_t)l * DM * NE, L, tid);
            for (int t0 = 8 * gw; t0 < MT; t0 += 8 * NGW) {
                f32x4 am[4], bm[4]; mod_load(am, bm, g_ffn + l * DM, ada_l + (size_t)(t0 >> 11) * 6144, 3072, 4096, lane);
#pragma unroll 1
                for (int p = 0; p < 4; ++p) { const int t = t0 + 2 * p; const f32x4* xr = (const f32x4*)(X + (size_t)t * DM) + lane; f32x4 v[4], w[4];
#pragma unroll
                    for (int j = 0; j < 4; ++j) { v[j] = xr[64 * j]; w[j] = xr[256 + 64 * j]; }
                    hprep_regs<true>(v, t, lane, am, bm, H, L, AFF);
                    hprep_regs<true>(w, t + 1, lane, am, bm, H, L, AFF); } }
#endif

        }
        SEAM(pb + 4);

#ifndef SKIP_TOPK
        if (IN(pb + 5)) for (int rep_ = 0; rep_ < REPS_L(5); ++rep_) { PHASE_IDS; for (int it = bx; it < 2 * NB * NE; it += G) topk_gather_item(it >> 1, it & 1, AFF, SEL, (unsigned*)(ws + WS_IDX), L, tid); }
#endif

        SEAM(pb + 5);
        asm volatile(".rept 12\n s_nop 0\n .endr");
        if (IN(pb + 6)) for (int rep_ = 0; rep_ < REPS_L(6); ++rep_) { PHASE_IDS;

#ifndef SKIP_G1
            pg8::Gemm g{H, (const bf16_t*)(ws + WS_W13) + (size_t)l * NE * NFT * 256 * DM, NE * 2048, NE * NFT * 256, DM, 0}; pg8::GroupOrder S; S.init(NE, 8, NFT, G, bx, 0); pg8::EpiG1 E{HID};
            { const unsigned* GIDX = (const unsigned*)(ws + WS_IDX); LAS unsigned* gt = (LAS unsigned*)(L + pg8::STAGE_BYTES);
              pg8::Unit uu; for (int ui = 0; ui < 15 && S.next(ui, uu); ++ui) if (tid < 256) gt[ui * 256 + tid] = GIDX[(size_t)uu.pm * 256 + tid];
              __syncthreads(); }
            pg8::gemm_phase<pg8::EpiG1, pg8::GroupOrder, true, true, true>(L, g, S, E);
#endif

        }
        SEAM(pb + 6);
        asm volatile(".rept 2\n s_nop 0\n .endr");
        if (IN(pb + 7)) for (int rep_ = 0; rep_ < REPS_L(7); ++rep_) { PHASE_IDS;

#ifndef SKIP_G2
            pg8::Gemm g{HID, (const bf16_t*)(ws + WS_W2) + (size_t)l * NE * DM * FFL, NE * 2048, NE * DM, FFP, FFL}; pg8::GroupOrder S; S.init(NE, 8, 4, G, bx, 0); pg8::EpiG2 E{(bf16_t*)Y};
            pg8::gemm_phase<pg8::EpiG2, pg8::GroupOrder, true, true>(L, g, S, E);
#endif

        }
        SEAM(pb + 7);
        if (IN(pb + 8)) for (int rep_ = 0; rep_ < REPS_L(8); ++rep_) { PHASE_IDS;

#ifndef SKIP_COMB
            const bool last = (l + 1 == NL);
            for (int t0 = 8 * gw; t0 < MT; t0 += 8 * NGW) {
                const int b = t0 >> 11;
                f32x4 gr[4], am[4], bm[4];
#pragma unroll
                for (int q = 0; q < 4; ++q) gr[q] = *((const f32x4*)(ada_l + (size_t)b * 6144 + 5120) + lane + 64 * q);
                if (!last) mod_load(am, bm, g_mix + (l + 1) * DM, ADA + ((size_t)(l + 1) * NB + b) * 6144, 0, 1024, lane);
                else {
#pragma unroll
                    for (int q = 0; q < 4; ++q) { am[q] = *((const f32x4*)a.in[23] + lane + 64 * q); bm[q] = (f32x4){0.f, 0.f, 0.f, 0.f}; } }
                int jn = -1; float gn = 0.f; f32x4 xn[4];
                { const int s0 = t0 & 2047; if (lane < NE) { jn = SEL[((size_t)b * NE + lane) * SEQ + s0]; gn = AFF[((size_t)b * NE + lane) * SEQ + s0]; }
#pragma unroll
                  for (int q = 0; q < 4; ++q) xn[q] = *((const f32x4*)(X + (size_t)t0 * DM) + lane + 64 * q); }
#pragma unroll 1
                for (int i = 0; i < 8; ++i) { const int t = t0 + i;
                    const int jv = jn; const float gvv = gn; f32x4 xc[4];
#pragma unroll
                    for (int q = 0; q < 4; ++q) xc[q] = xn[q];
                    if (i + 1 < 8) { const int s1 = (t + 1) & 2047; if (lane < NE) { jn = SEL[((size_t)b * NE + lane) * SEQ + s1]; gn = AFF[((size_t)b * NE + lane) * SEQ + s1]; }
#pragma unroll
                        for (int q = 0; q < 4; ++q) xn[q] = *((const f32x4*)(X + (size_t)(t + 1) * DM) + lane + 64 * q); }
                    f32x4 acc[4];
#pragma unroll
                    for (int q = 0; q < 4; ++q) acc[q] = (f32x4){0.f, 0.f, 0.f, 0.f};
                    unsigned long long msk = __ballot(jv >= 0);
                    while (msk) {
                        const int e0 = __builtin_ctzll(msk); msk &= msk - 1; const bool two = msk != 0ull; const int e1 = two ? __builtin_ctzll(msk) : e0; if (two) msk &= msk - 1;
                        const int j0 = __builtin_amdgcn_readlane(jv, e0), j1 = __builtin_amdgcn_readlane(jv, e1);
                        const float g0 = __builtin_bit_cast(float, __builtin_amdgcn_readlane(__builtin_bit_cast(int, gvv), e0)), g1 = two ? __builtin_bit_cast(float, __builtin_amdgcn_readlane(__builtin_bit_cast(int, gvv), e1)) : 0.f;
                        const unsigned long long* y0 = (const unsigned long long*)((const bf16_t*)Y + ((size_t)e0 * 2048 + b * CAP + j0) * DM) + lane; const unsigned long long* y1 = (const unsigned long long*)((const bf16_t*)Y + ((size_t)e1 * 2048 + b * CAP + j1) * DM) + lane;
                        unsigned long long r0[4], r1[4];
#pragma unroll
                        for (int q = 0; q < 4; ++q) { r0[q] = y0[64 * q]; r1[q] = y1[64 * q]; }
#pragma unroll
                        for (int q = 0; q < 4; ++q) { const unsigned a0 = (unsigned)r0[q], a1 = (unsigned)(r0[q] >> 32), b0 = (unsigned)r1[q], b1 = (unsigned)(r1[q] >> 32);
                            const f32x4 ya = {__builtin_bit_cast(float, a0 << 16), __builtin_bit_cast(float, a0 & 0xffff0000u), __builtin_bit_cast(float, a1 << 16), __builtin_bit_cast(float, a1 & 0xffff0000u)};
                            const f32x4 yb = {__builtin_bit_cast(float, b0 << 16), __builtin_bit_cast(float, b0 & 0xffff0000u), __builtin_bit_cast(float, b1 << 16), __builtin_bit_cast(float, b1 & 0xffff0000u)};
                            acc[q] += ya * g0; acc[q] += yb * g1; }
                    }
                    f32x4 v[4];
#pragma unroll
                    for (int q = 0; q < 4; ++q) v[q] = xc[q] + gr[q] * acc[q];
                    if (!last) {
#pragma unroll
                        for (int q = 0; q < 4; ++q) *((f32x4*)(X + (size_t)t * DM) + lane + 64 * q) = v[q];
                        hprep_regs<false>(v, t, lane, am, bm, H, (const LAS unsigned char*)nullptr, nullptr);
                    } else {
                        float ss = 0.f;
#pragma unroll
                        for (int q = 0; q < 4; ++q) ss += (v[q].x * v[q].x + v[q].y * v[q].y) + (v[q].z * v[q].z + v[q].w * v[q].w);
                        const float r = 1.0f / sqrtf(wave_sum(ss) * (1.0f / DM) + EPS);
#pragma unroll
                        for (int q = 0; q < 4; ++q) ((f32x4*)(a.out + (size_t)t * DM))[lane + 64 * q] = v[q] * r * am[q];
                    }
                }
            }
#endif

        }
        if (l + 1 < NL) SEAM(pb + 8);
    }
#undef IN
#undef SEAM
}

__global__ __launch_bounds__(512) void k_prologue(const float* x, const float* c, const int* positions, const float* w_ada, const float* b_ada, ConvPtrs P, InvF IF) {
    extern __shared__ __attribute__((aligned(16))) unsigned char lds[];
    const int tid = threadIdx.x, lane = tid & 63, wave = tid >> 6;
    unsigned char* ws = P.ws;
    const size_t gt = (size_t)blockIdx.x * 512 + tid, GT = (size_t)gridDim.x * 512;
    for (size_t i = gt; i < (size_t)MT * DM / 4; i += GT) ((f32x4*)(ws + WS_X))[i] = ((const f32x4*)x)[i];
    for (size_t i = gt; i < (size_t)MT * 8; i += GT) rope_entry((int)i, positions, (float*)(ws + WS_ROPE), IF);
    for (size_t i = gt; i < (size_t)2048 * 256; i += GT) dft_entry8((int)i, (bf16_t*)(ws + WS_DFTC), (bf16_t*)(ws + WS_DFTS));
    for (size_t i = gt; i < (size_t)NL * NE * PAD_CH; i += GT) pad_chunk(i, ws);
    for (int it = blockIdx.x; it < NL * 96; it += gridDim.x) ada_item(it, c, w_ada, b_ada, (float*)(ws + WS_CTL + CTL_ADA), (LAS float*)lds, tid);
    for (int it = blockIdx.x; it < NL * 4 * 16; it += gridDim.x) fold_item(it, P.w_in, (bf16_t*)(ws + WS_WIN), (LAS float*)lds, tid);
    __syncthreads();
    LAS float* scr = (LAS float*)(lds) + wave * (64 * 65);
    for (int it = blockIdx.x * 8 + wave; it < CV_TOTAL; it += gridDim.x * 8) conv_item(it, P, scr, lane);
}

template <bool ROUTER>
__global__ __launch_bounds__(256) void k_hprep(const float* X, const float* gain, const float* ADA, int sh_off, int sc_off, bf16_t* H, const float* w_router, float* AFF) {
    const int lane = threadIdx.x & 63; const int gw = blockIdx.x * 4 + (threadIdx.x >> 6), NGW = gridDim.x * 4;
    for (int t = gw; t < MT; t += NGW) {
        const int b = t >> 11;
        const f32x4* xr = (const f32x4*)(X + (size_t)t * DM) + lane;
        f32x4 v[4]; float ss = 0.f;
#pragma unroll
        for (int j = 0; j < 4; ++j) { v[j] = xr[64 * j]; ss += (v[j].x * v[j].x + v[j].y * v[j].y) + (v[j].z * v[j].z + v[j].w * v[j].w); }
        const float r = 1.0f / sqrtf(wave_sum(ss) * (1.0f / DM) + EPS);
        float lg[NE];
        if (ROUTER) {
#pragma unroll
            for (int e = 0; e < NE; ++e) lg[e] = 0.f; }
#pragma unroll
        for (int j = 0; j < 4; ++j) { const int col = 4 * lane + 256 * j;
            const f32x4 g4 = *(const f32x4*)(gain + col), sh = *(const f32x4*)(ADA + b * 6144 + sh_off + col), sc = *(const f32x4*)(ADA + b * 6144 + sc_off + col);
            f32x4 h; h.x = v[j].x * r * g4.x * (1.f + sc.x) + sh.x; h.y = v[j].y * r * g4.y * (1.f + sc.y) + sh.y; h.z = v[j].z * r * g4.z * (1.f + sc.z) + sh.z; h.w = v[j].w * r * g4.w * (1.f + sc.w) + sh.w;
            *(unsigned long long*)(H + (size_t)t * DM + col) = (unsigned long long)pk2(h.x, h.y) | ((unsigned long long)pk2(h.z, h.w) << 32);
            if (ROUTER) {
#pragma unroll
                for (int q = 0; q < 4; ++q) { const float hv = h[q]; const f32x4* wr = (const f32x4*)(w_router + (size_t)(col + q) * NE);
#pragma unroll
                    for (int e4 = 0; e4 < 4; ++e4) { const f32x4 w = wr[e4]; lg[e4 * 4 + 0] += hv * w.x; lg[e4 * 4 + 1] += hv * w.y; lg[e4 * 4 + 2] += hv * w.z; lg[e4 * 4 + 3] += hv * w.w; } } }
        }
        if (ROUTER) {
            float mx = -1e30f;
#pragma unroll
            for (int e = 0; e < NE; ++e) { lg[e] = wave_sum(lg[e]); mx = fmaxf(mx, lg[e]); }
            float den = 0.f;
#pragma unroll
            for (int e = 0; e < NE; ++e) { lg[e] = expf(lg[e] - mx); den += lg[e]; }
            const float inv = 1.0f / den; const int s = t & 2047;
#pragma unroll
            for (int e = 0; e < NE; ++e) if (lane == e) AFF[((size_t)b * NE + e) * SEQ + s] = lg[e] * inv;
        }
    }
}

struct GemmP { const bf16_t* A; const bf16_t* Bt; size_t strideA, strideB; int K, lda, ldb, pad; };
template <class Epi, bool PAIR>
__global__ __launch_bounds__(256) void k_gemm(GemmP g, Epi epi) {
    const int tid = threadIdx.x, wid = tid >> 6, lane = tid & 63, wr = wid >> 1, wc = wid & 1, fr = lane & 15, fq = lane >> 4;
    const int z = blockIdx.z, bx = blockIdx.x;
    const bf16_t* A = g.A + (size_t)z * g.strideA; const bf16_t* Bt = g.Bt + (size_t)z * g.strideB;
    const int row0 = blockIdx.y * 128 + wr * 64;
    int bcol[4];
#pragma unroll
    for (int j = 0; j < 4; ++j) bcol[j] = PAIR ? ((bx >> 1) * 256 + (bx & 1) * 64 + wc * 32 + (j & 1) * 16 + (j >> 1) * 128) : (bx * 128 + wc * 64 + j * 16);
    f32x4 acc[4][4];
#pragma unroll
    for (int i = 0; i < 4; ++i)
#pragma unroll
        for (int j = 0; j < 4; ++j) acc[i][j] = (f32x4){0.f, 0.f, 0.f, 0.f};
    for (int k0 = 0; k0 < g.K; k0 += 32) {
        bf16x8 a[4], b[4];
#pragma unroll
        for (int i = 0; i < 4; ++i) a[i] = *(const bf16x8*)(A + (size_t)(row0 + i * 16 + fr) * g.lda + k0 + fq * 8);
#pragma unroll
        for (int j = 0; j < 4; ++j) b[j] = *(const bf16x8*)(Bt + (size_t)(bcol[j] + fr) * g.ldb + k0 + fq * 8);
#pragma unroll
        for (int i = 0; i < 4; ++i)
#pragma unroll
            for (int j = 0; j < 4; ++j) acc[i][j] = __builtin_amdgcn_mfma_f32_16x16x32_bf16(a[i], b[j], acc[i][j], 0, 0, 0);
    }
#pragma unroll
    for (int i = 0; i < 4; ++i)
#pragma unroll
        for (int r = 0; r < 4; ++r) { const int row = row0 + i * 16 + fq * 4 + r;
            if constexpr (PAIR) {
#pragma unroll
                for (int j = 0; j < 2; ++j) epi.pair(z, row, (bx >> 1) * 128 + (bx & 1) * 64 + wc * 32 + j * 16 + fr, acc[i][j][r], acc[i][j + 2][r]);
            } else {
#pragma unroll
                for (int j = 0; j < 4; ++j) epi(z, row, bcol[j] + fr, acc[i][j][r]);
            } }
}
struct EWin { bf16_t *Q, *K, *V, *YT, *UV, *GATES;
    __device__ __forceinline__ void operator()(int, int t, int n, float v) const {
        if (n < 1024) Q[(size_t)t * DM + n] = (bf16_t)f2bf(v);
        else if (n < 2048) K[(size_t)t * DM + n - 1024] = (bf16_t)f2bf(v);
        else if (n < 3072) V[(size_t)t * DM + n - 2048] = (bf16_t)f2bf(v);
        else if (n < 4096) { const int g = (n - 3072) >> 8, nl = n & 255, part = nl >> 7, cp = nl & 127, b = t >> 11, pos = t & 2047;
            YT[((size_t)(b * 2 + part) * 512 + g * 128 + cp) * SEQ + pos] = (bf16_t)f2bf(v); }
        else if (n < 5120) UV[(size_t)t * 1024 + n - 4096] = (bf16_t)f2bf(gelu_tanh_f(v));
        else GATES[(size_t)t * 3072 + n - 5120] = (bf16_t)f2bf(sigmoid_f(v)); } };
struct EDftP { bf16_t* BOUT; int part, pad;
    __device__ __forceinline__ void operator()(int b, int m, int n, float v) const { BOUT[((size_t)b * SEQ + m) * 1024 + part * 512 + n] = (bf16_t)f2bf(v); } };
template <int WHICH> struct EProj { const bf16_t* GATES; bf16_t* T1; bf16_t* OUT;
    __device__ __forceinline__ void operator()(int, int t, int n, float v) const {
        const float g = bf2f(GATES[(size_t)t * 3072 + WHICH * 1024 + n]); const size_t o = (size_t)t * DM + n;
        if (WHICH == 0) T1[o] = (bf16_t)f2bf(g * v); else if (WHICH == 1) T1[o] = (bf16_t)f2bf(bf2f(T1[o]) + g * v); else OUT[o] = (bf16_t)f2bf(bf2f(T1[o]) + g * v); } };
struct EWout { float* X; const float* gt;
    __device__ __forceinline__ void operator()(int, int t, int n, float v) const { X[(size_t)t * DM + n] += gt[(t >> 11) * 6144 + n] * v; } };
struct EG1 { bf16_t* HID;
    __device__ __forceinline__ void operator()(int, int, int, float) const {}
    __device__ __forceinline__ void pair(int e, int row, int f, float a, float b) const { HID[((size_t)e * 2048 + row) * FFL + f] = (bf16_t)f2bf(silu_f(a) * b); } };
struct EG2 { float* Y;
    __device__ __forceinline__ void operator()(int e, int row, int n, float v) const { Y[((size_t)e * 2048 + row) * DM + n] = v; } };

__global__ __launch_bounds__(256) void k_rope(bf16_t* Q, bf16_t* K, const float* ROPE) {
    const size_t idx = (size_t)blockIdx.x * 256 + threadIdx.x; if (idx >= (size_t)MT * 256) return;
    const int i = idx & 7, c = (idx >> 3) & 1, h = (idx >> 4) & 7, which = (idx >> 7) & 1; const size_t t = idx >> 8;
    bf16_t* p = (which ? K : Q) + t * DM + h * 128 + c * 64 + i;
    const float a = bf2f(p[0]), b = bf2f(p[8]), cs = ROPE[t * 16 + i], sn = ROPE[t * 16 + 8 + i];
    p[0] = (bf16_t)f2bf(a * cs - b * sn); p[8] = (bf16_t)f2bf(a * sn + b * cs);
}
__global__ __launch_bounds__(128) void k_attn_naive(const bf16_t* Q, const bf16_t* K, const bf16_t* V, bf16_t* AOUT, const float* lq1, const float* lk1, const float* lq2, const float* lk2, const float* a_norm_g, float lam_init) {
    __shared__ float smem[16384];
    float (*Ks)[32][64] = (float (*)[32][64])smem;
    float (*Vs)[128] = (float (*)[128])(smem + 4096);
    float (*Ox)[129] = (float (*)[129])smem;
    const int bx = blockIdx.x, qblk = bx & 31, h = (bx >> 5) & 7, b = bx >> 8, tid = threadIdx.x, c = tid >> 6, qi = tid & 63;
    const size_t t = (size_t)b * SEQ + qblk * 64 + qi;
    float q[64], o[128];
#pragma unroll
    for (int d = 0; d < 64; ++d) q[d] = bf2f(Q[t * DM + h * 128 + c * 64 + d]) * (0.125f * 1.4426950408889634f);
#pragma unroll
    for (int d = 0; d < 128; ++d) o[d] = 0.f;
    float m = -1e30f, lsum = 0.f;
    for (int kt = 0; kt < SEQ / 32; ++kt) {
        __syncthreads();
        for (int idx = tid; idx < 32 * 128; idx += 128) { const int key = idx >> 7, d = idx & 127; const size_t src = ((size_t)b * SEQ + kt * 32 + key) * DM + h * 128 + d;
            Ks[d >> 6][key][d & 63] = bf2f(K[src]); Vs[key][d] = bf2f(V[src]); }
        __syncthreads();
        for (int j = 0; j < 32; ++j) {
            float s = 0.f;
#pragma unroll
            for (int d = 0; d < 64; ++d) s += q[d] * Ks[c][j][d];
            if (s > m) { const float al = exp2f(m - s);
#pragma unroll
                for (int d = 0; d < 128; ++d) o[d] *= al;
                lsum *= al; m = s; }
            const float p = exp2f(s - m); lsum += p;
#pragma unroll
            for (int d = 0; d < 128; ++d) o[d] += p * Vs[j][d];
        }
    }
    const float inv = 1.0f / lsum;
    __syncthreads();
    if (c == 1) {
#pragma unroll
        for (int d = 0; d < 128; ++d) Ox[qi][d] = o[d] * inv; }
    __syncthreads();
    if (c == 0) {
        float d1 = 0.f, d2 = 0.f;
        for (int d = 0; d < 64; ++d) { d1 += lq1[d] * lk1[d]; d2 += lq2[d] * lk2[d]; }
        const float lam = expf(d1) - expf(d2) + lam_init;
        float ss = 0.f;
#pragma unroll
        for (int d = 0; d < 128; ++d) { o[d] = o[d] * inv - lam * Ox[qi][d]; ss += o[d] * o[d]; }
        const float r = (1.0f - lam_init) / sqrtf(ss * (1.0f / 128.0f) + EPS);
#pragma unroll
        for (int d = 0; d < 128; ++d) AOUT[t * DM + h * 128 + d] = (bf16_t)f2bf(o[d] * r * a_norm_g[d]);
    }
}
__global__ __launch_bounds__(256) void k_gmlp_naive(const bf16_t* UV, const float* w_s, const float* b_s, bf16_t* COUT) {
    __shared__ float vg[128][128];
    const int bx = blockIdx.x, g = bx & 3, n = (bx >> 2) & 15, b = bx >> 6, tid = threadIdx.x;
    const size_t t0 = (size_t)b * SEQ + n * 128;
    { const int qr = tid >> 1, hf = tid & 1; float v[64]; float ss = 0.f;
#pragma unroll
      for (int cc = 0; cc < 64; ++cc) { v[cc] = bf2f(UV[(t0 + qr) * 1024 + 512 + g * 128 + hf * 64 + cc]); ss += v[cc] * v[cc]; }
      ss += __shfl_xor(ss, 1);
      const float r = 1.0f / sqrtf(ss * (1.0f / 128.0f) + EPS);
#pragma unroll
      for (int cc = 0; cc < 64; ++cc) vg[qr][hf * 64 + cc] = v[cc] * r; }
    __syncthreads();
    const int p = tid >> 1, ch0 = (tid & 1) * 64;
    float acc[64];
#pragma unroll
    for (int cc = 0; cc < 64; ++cc) acc[cc] = 0.f;
    const float* wrow = w_s + ((size_t)g * 128 + p) * 128;
    for (int qq = 0; qq < 128; ++qq) { const float w = wrow[qq];
#pragma unroll
        for (int cc = 0; cc < 64; ++cc) acc[cc] += w * vg[qq][ch0 + cc]; }
    const float bias = b_s[g * 128 + p];
#pragma unroll
    for (int cc = 0; cc < 64; ++cc) { const float u = bf2f(UV[(t0 + p) * 1024 + g * 128 + ch0 + cc]); COUT[(t0 + p) * 512 + g * 128 + ch0 + cc] = (bf16_t)f2bf(u * (acc[cc] + bias)); }
}
__global__ __launch_bounds__(512) void k_topk(const float* AFF, int* SEL, int* IDX) {
    __shared__ float v[SEQ];
    const int pair = blockIdx.x >> 1, half = blockIdx.x & 1, tid = threadIdx.x;
    for (int i = tid; i < SEQ; i += 512) v[i] = AFF[(size_t)pair * SEQ + i];
    __syncthreads();
    for (int ii = 0; ii < 2; ++ii) { const int i = half * 1024 + ii * 512 + tid; const float x = v[i]; int rank = 0;
        for (int j = 0; j < SEQ; ++j) { const float y = v[j]; rank += ((y > x) || (y == x && j < i)) ? 1 : 0; }
        SEL[(size_t)pair * SEQ + i] = rank < CAP ? rank : -1;
        if (rank < CAP) IDX[pair * CAP + rank] = i; }
}
__global__ __launch_bounds__(256) void k_gather(const bf16_t* H, const int* IDX, bf16_t* XIN) {
    const int lane = threadIdx.x & 63; const int gw = blockIdx.x * 4 + (threadIdx.x >> 6), NGW = gridDim.x * 4;
    for (int r = gw; r < NE * 2048; r += NGW) { const int e = r >> 11, b = (r >> 8) & 7, j = r & 255; const int s = IDX[(b * NE + e) * CAP + j];
        const u32x4* src = (const u32x4*)(H + ((size_t)b * SEQ + s) * DM); u32x4* dst = (u32x4*)(XIN + (size_t)r * DM);
        dst[lane] = src[lane]; dst[lane + 64] = src[lane + 64]; }
}
__global__ __launch_bounds__(256) void k_combine(float* X, const float* Y, const int* SEL, const float* AFF, const float* gt2) {
    const int lane = threadIdx.x & 63; const int gw = blockIdx.x * 4 + (threadIdx.x >> 6), NGW = gridDim.x * 4;
    for (int t = gw; t < MT; t += NGW) { const int b = t >> 11, s = t & 2047;
        f32x4 acc[4];
#pragma unroll
        for (int j = 0; j < 4; ++j) acc[j] = (f32x4){0.f, 0.f, 0.f, 0.f};
        for (int e = 0; e < NE; ++e) { const int j = SEL[((size_t)b * NE + e) * SEQ + s];
            if (j >= 0) { const float g = AFF[((size_t)b * NE + e) * SEQ + s]; const f32x4* yr = (const f32x4*)(Y + ((size_t)e * 2048 + b * 256 + j) * DM) + lane;
#pragma unroll
                for (int q = 0; q < 4; ++q) acc[q] += yr[64 * q] * g; } }
        f32x4* xr = (f32x4*)(X + (size_t)t * DM) + lane; const f32x4* gr = (const f32x4*)(gt2 + b * 6144) + lane;
#pragma unroll
        for (int q = 0; q < 4; ++q) xr[64 * q] = xr[64 * q] + gr[64 * q] * acc[q];
    }
}
__global__ __launch_bounds__(256) void k_final(const float* X, const float* gain, float* out) {
    const int lane = threadIdx.x & 63; const int gw = blockIdx.x * 4 + (threadIdx.x >> 6), NGW = gridDim.x * 4;
    for (int t = gw; t < MT; t += NGW) {
        const f32x4* xr = (const f32x4*)(X + (size_t)t * DM) + lane; f32x4 v[4]; float ss = 0.f;
#pragma unroll
        for (int j = 0; j < 4; ++j) { v[j] = xr[64 * j]; ss += (v[j].x * v[j].x + v[j].y * v[j].y) + (v[j].z * v[j].z + v[j].w * v[j].w); }
        const float r = 1.0f / sqrtf(wave_sum(ss) * (1.0f / DM) + EPS);
#pragma unroll
        for (int j = 0; j < 4; ++j) { const f32x4 g4 = *((const f32x4*)gain + lane + 64 * j); ((f32x4*)(out + (size_t)t * DM))[lane + 64 * j] = v[j] * r * g4; }
    }
}

#ifndef MEGA_MASK
#define MEGA_MASK 0x7fbff
#endif
#ifndef MEGA_MERGE
#define MEGA_MERGE 0
#endif
static void v1_launch(void* const* d_in, void* d_out, unsigned char* ws, InvF IF, hipStream_t stream, unsigned mask, int merge, MArgs a, int grid) {
    const float* x = (const float*)d_in[0]; const float* c = (const float*)d_in[1]; const int* positions = (const int*)d_in[2];
    const float* w_ada = (const float*)d_in[3]; const float* b_ada = (const float*)d_in[4]; const float* g_mix = (const float*)d_in[5]; const float* g_ffn = (const float*)d_in[6];
    const float* w_in = (const float*)d_in[7]; const float* lq1 = (const float*)d_in[8]; const float* lk1 = (const float*)d_in[9]; const float* lq2 = (const float*)d_in[10]; const float* lk2 = (const float*)d_in[11];
    const float* a_norm_g = (const float*)d_in[12]; const float* w_s = (const float*)d_in[13]; const float* b_s = (const float*)d_in[14];
    const float* p_a = (const float*)d_in[15]; const float* p_b = (const float*)d_in[16]; const float* p_c = (const float*)d_in[17]; const float* w_out = (const float*)d_in[18];
    const float* w_router = (const float*)d_in[19]; const float* w1 = (const float*)d_in[20]; const float* w3 = (const float*)d_in[21]; const float* w2 = (const float*)d_in[22]; const float* g_final = (const float*)d_in[23];
    ConvPtrs P{w_in, p_a, p_b, p_c, w_out, w1, w3, w2, ws};
    float* X = (float*)(ws + WS_X); bf16_t* H = (bf16_t*)(ws + WS_H); float* ADA = (float*)(ws + WS_CTL + CTL_ADA); float* ROPE = (float*)(ws + WS_ROPE);
    bf16_t *Q = (bf16_t*)(ws + WS_Q), *K = (bf16_t*)(ws + WS_K), *V = (bf16_t*)(ws + WS_V), *YT = (bf16_t*)(ws + WS_YT), *UV = (bf16_t*)(ws + WS_UV), *GATES = (bf16_t*)(ws + WS_GATES);
    bf16_t *AOUT = (bf16_t*)(ws + WS_AOUT), *BOUT = (bf16_t*)(ws + WS_BOUT), *COUT = (bf16_t*)(ws + WS_COUT), *T1 = (bf16_t*)(ws + WS_T1), *MERGED = (bf16_t*)(ws + WS_MERGED);
    bf16_t *XIN = (bf16_t*)(ws + WS_XIN), *HID = (bf16_t*)(ws + WS_HID); float* Y = (float*)(ws + WS_Y);
    int* SEL = (int*)(ws + WS_SEL); int* IDX = (int*)(ws + WS_IDX); float* AFF = (float*)(ws + WS_AFF);
    int n_mega = 0;
    for (int ph = 0; ph < N_PHASES; ++ph) {
        if ((mask >> ph) & 1u) {
#if (WIN_DBG & 0x6F) != 0x6F
            if (ph >= 2 && (ph - 2) % 9 == 0) { const int l = (ph - 2) / 9; GemmP g{H, (const bf16_t*)(ws + WS_WIN) + (size_t)l * NIN * DM, 0, 0, DM, DM, DM, 0}; EWin e{Q, K, V, YT, UV, GATES};
                hipLaunchKernelGGL((k_gemm<EWin, false>), dim3(NIN / 128, MT / 128, 1), dim3(256), 0, stream, g, e);
                hipLaunchKernelGGL(k_rope, dim3(MT), dim3(256), 0, stream, Q, K, (const float*)ROPE); }
#endif
            int hi = ph + 1; if (merge) while (hi < N_PHASES && ((mask >> hi) & 1u)) ++hi;
            a.ph_lo = ph; a.ph_hi = hi; a.li = n_mega++; a.pad = 0;
            hipLaunchKernelGGL(mega, dim3(grid), dim3(NWAVES * 64), LDS_TOTAL, stream, a);
#if (WIN_DBG >> 4) & 1
            if (ph >= 2 && (ph - 2) % 9 == 0) hipLaunchKernelGGL(k_rope, dim3(MT), dim3(256), 0, stream, Q, K, (const float*)ROPE);
#endif
            ph = hi - 1; continue;
        }
        if (ph == 0) { hipLaunchKernelGGL(k_prologue, dim3(1024), dim3(512), 8 * 64 * 65 * 4, stream, x, c, positions, w_ada, b_ada, P, IF); continue; }
        if (ph == 1) { hipLaunchKernelGGL(k_hprep<false>, dim3(1024), dim3(256), 0, stream, x, g_mix, (const float*)ADA, 0, 1024, H, (const float*)nullptr, (float*)nullptr); continue; }
        const int l = (ph - 2) / 9, k = (ph - 2) % 9;
        const float* ada_l = ADA + (size_t)l * NB * 6144;
        const float lam_init = (float)(0.8 - 0.6 * exp(-0.3 * (double)l));
        if (k == 0) { GemmP g{H, (const bf16_t*)(ws + WS_WIN) + (size_t)l * NIN * DM, 0, 0, DM, DM, DM, 0}; EWin e{Q, K, V, YT, UV, GATES};
            hipLaunchKernelGGL((k_gemm<EWin, false>), dim3(NIN / 128, MT / 128, 1), dim3(256), 0, stream, g, e);
            hipLaunchKernelGGL(k_rope, dim3(MT), dim3(256), 0, stream, Q, K, (const float*)ROPE); }
        else if (k == 1) {
            hipLaunchKernelGGL(k_attn_naive, dim3(NB * 8 * 32), dim3(128), 0, stream, (const bf16_t*)Q, (const bf16_t*)K, (const bf16_t*)V, AOUT, lq1 + l * 64, lk1 + l * 64, lq2 + l * 64, lk2 + l * 64, a_norm_g + l * 128, lam_init);
            for (int part = 0; part < 2; ++part) { GemmP gp{(const bf16_t*)(ws + (part ? WS_DFTS : WS_DFTC)), YT + (size_t)part * 512 * SEQ, 0, (size_t)2 * 512 * SEQ, SEQ, SEQ, SEQ, 0}; EDftP ep{BOUT, part, 0};
                hipLaunchKernelGGL((k_gemm<EDftP, false>), dim3(512 / 128, SEQ / 128, NB), dim3(256), 0, stream, gp, ep); }
            hipLaunchKernelGGL(k_gmlp_naive, dim3(NB * 16 * 4), dim3(256), 0, stream, (const bf16_t*)UV, w_s + (size_t)l * 4 * 128 * 128, b_s + (size_t)l * 4 * 128, COUT); }
        else if (k == 2) {
            { GemmP g{AOUT, (const bf16_t*)(ws + WS_PA) + (size_t)l * 1024 * 1024, 0, 0, 1024, 1024, 1024, 0}; EProj<0> e{GATES, T1, MERGED}; hipLaunchKernelGGL((k_gemm<EProj<0>, false>), dim3(8, MT / 128, 1), dim3(256), 0, stream, g, e); }
            { GemmP g{BOUT, (const bf16_t*)(ws + WS_PB) + (size_t)l * 1024 * 1024, 0, 0, 1024, 1024, 1024, 0}; EProj<1> e{GATES, T1, MERGED}; hipLaunchKernelGGL((k_gemm<EProj<1>, false>), dim3(8, MT / 128, 1), dim3(256), 0, stream, g, e); }
            { GemmP g{COUT, (const bf16_t*)(ws + WS_PC) + (size_t)l * 1024 * 512, 0, 0, 512, 512, 512, 0}; EProj<2> e{GATES, T1, MERGED}; hipLaunchKernelGGL((k_gemm<EProj<2>, false>), dim3(8, MT / 128, 1), dim3(256), 0, stream, g, e); } }
        else if (k == 3) { if (l == 0) (void)hipMemcpyAsync(X, x, (size_t)MT * DM * 4, hipMemcpyDeviceToDevice, stream);
            GemmP g{MERGED, (const bf16_t*)(ws + WS_WOUT) + (size_t)l * 1024 * 1024, 0, 0, 1024, 1024, 1024, 0}; EWout e{X, ada_l + 2048};
            hipLaunchKernelGGL((k_gemm<EWout, false>), dim3(8, MT / 128, 1), dim3(256), 0, stream, g, e); }
        else if (k == 4) hipLaunchKernelGGL(k_hprep<true>, dim3(1024), dim3(256), 0, stream, (const float*)X, g_ffn + l * DM, ada_l, 3072, 4096, H, w_router + (size_t)l * DM * NE, AFF);
        else if (k == 5) { hipLaunchKernelGGL(k_topk, dim3(NB * NE * 2), dim3(512), 0, stream, (const float*)AFF, SEL, IDX);
            hipLaunchKernelGGL(k_gather, dim3(1024), dim3(256), 0, stream, (const bf16_t*)H, (const int*)IDX, XIN); }
        else if (k == 6) { GemmP g{XIN, (const bf16_t*)(ws + WS_W13) + (size_t)l * NE * NFT * 256 * DM, (size_t)2048 * DM, (size_t)NFT * 256 * DM, DM, DM, DM, 0}; EG1 e{HID};
            hipLaunchKernelGGL((k_gemm<EG1, true>), dim3(NFT * 2, 2048 / 128, NE), dim3(256), 0, stream, g, e); }
        else if (k == 7) { GemmP g{HID, (const bf16_t*)(ws + WS_W2) + (size_t)l * NE * DM * FFL, (size_t)2048 * FFL, (size_t)DM * FFL, FFP, FFL, FFL, 0}; EG2 e{Y};
            hipLaunchKernelGGL((k_gemm<EG2, false>), dim3(8, 2048 / 128, NE), dim3(256), 0, stream, g, e); }
        else { hipLaunchKernelGGL(k_combine, dim3(1024), dim3(256), 0, stream, X, (const float*)Y, (const int*)SEL, (const float*)AFF, ada_l + 5120);
            if (l + 1 < NL) hipLaunchKernelGGL(k_hprep<false>, dim3(1024), dim3(256), 0, stream, (const float*)X, g_mix + (l + 1) * DM, (const float*)(ADA + (size_t)(l + 1) * NB * 6144), 0, 1024, H, (const float*)nullptr, (float*)nullptr);
            else hipLaunchKernelGGL(k_final, dim3(1024), dim3(256), 0, stream, (const float*)X, g_final, (float*)d_out); }
    }
}

#ifndef KMODE
#define KMODE 0
#endif
extern "C" void kernel_launch(void* const* d_in, const int* in_sizes, int n_in, void* d_out, int out_size, void* d_ws, size_t ws_size, hipStream_t stream) {
    static int grid = 0;
    if (grid == 0) {
        if (n_in != 24 || in_sizes[0] != MT * DM || out_size != MT * DM || ws_size < WS_END) { fprintf(stderr, "kernel_launch: unexpected shapes (n_in %d, in0 %d, out %d, ws %zu)\n", n_in, n_in > 0 ? in_sizes[0] : -1, out_size, ws_size); grid = -1; return; }
        int dev = 0, cus = 0, per_cu = 0;
        if (hipGetDevice(&dev) != hipSuccess || hipDeviceGetAttribute(&cus, hipDeviceAttributeMultiprocessorCount, dev) != hipSuccess) { grid = -1; return; }
        if (hipFuncSetAttribute((const void*)k_prologue, hipFuncAttributeMaxDynamicSharedMemorySize, 8 * 64 * 65 * 4) != hipSuccess) { fprintf(stderr, "kernel_launch: hipFuncSetAttribute failed\n"); grid = -1; return; }
        if (hipFuncSetAttribute((const void*)mega, hipFuncAttributeMaxDynamicSharedMemorySize, LDS_TOTAL) != hipSuccess) { fprintf(stderr, "kernel_launch: hipFuncSetAttribute(mega) failed\n"); grid = -1; return; }
        if (hipOccupancyMaxActiveBlocksPerMultiprocessor(&per_cu, (const void*)mega, NWAVES * 64, LDS_TOTAL) != hipSuccess || per_cu < 1) fprintf(stderr, "kernel_launch: note: occupancy query reports %d workgroups per CU\n", per_cu);
        (void)hipGetLastError();
        grid = cus;
    }
    if (grid < 0) return;
    unsigned char* ws = (unsigned char*)d_ws;
    (void)hipMemsetAsync(ws + WS_CTL, 0, CTL_ZERO_BYTES, stream);
    InvF IF{}; for (int i = 0; i < 8; ++i) IF.v[i] = (float)pow(500000.0, -(double)i / 8.0);
    MArgs a{};
    for (int i = 0; i < 24; ++i) a.in[i] = (const float*)d_in[i];
    a.out = (float*)d_out; a.ws = ws; a.invf = IF;
    for (int l = 0; l < NL; ++l) a.lam_init[l] = (float)(0.8 - 0.6 * exp(-0.3 * (double)l));
#if KMODE == 0
    a.ph_lo = 0; a.ph_hi = N_PHASES; a.li = 0;
    hipLaunchKernelGGL(mega, dim3(grid), dim3(NWAVES * 64), LDS_TOTAL, stream, a);
    { const hipError_t le = hipPeekAtLastError(); if (le != hipSuccess) fprintf(stderr, "kernel_launch: launch failed: %s\n", hipGetErrorName(le)); }
#elif KMODE == 1
    v1_launch(d_in, d_out, ws, IF, stream, 0u, 0, a, grid);
#else
    v1_launch(d_in, d_out, ws, IF, stream, (unsigned)(MEGA_MASK), MEGA_MERGE, a, grid);
#endif
}
```

```cpp
#include <hip/hip_runtime.h>
#include <cstdio>
#include <cstdint>
#include <cmath>

#ifndef ATT_DUAL
#define ATT_DUAL 1
#endif
#ifndef WIN_DBG
#define WIN_DBG 0x6F
#endif
#define LAS __attribute__((address_space(3)))
typedef unsigned short bf16_t;
typedef short bf16x8 __attribute__((ext_vector_type(8)));
typedef float f32x4 __attribute__((ext_vector_type(4)));
typedef unsigned u32x4 __attribute__((ext_vector_type(4)));

constexpr int NB = 8, SEQ = 2048, DM = 1024, NL = 2, MT = NB * SEQ;
constexpr int NIN = 8192, NIN_SRC = 7680;
constexpr int NE = 16, FF = 2752, FFP = 2816, FFL = 2880, CAP = 256, NFT = 22;
constexpr float EPS = 1e-6f;

constexpr size_t MiB = 1u << 20;
constexpr size_t WS_CTL = 0, CTL_ZERO_BYTES = 1 * MiB;
constexpr size_t CTL_ADA = 256 * 1024;
constexpr size_t WS_ROPE = 2 * MiB;
constexpr size_t WS_SEL = 3 * MiB;
constexpr size_t WS_AFF = 4 * MiB;
constexpr size_t WS_IDX = 5 * MiB;
constexpr size_t WS_WIN = 8 * MiB;
constexpr size_t WS_PA = 40 * MiB, WS_PB = 44 * MiB, WS_PC = 48 * MiB, WS_WOUT = 50 * MiB;
constexpr size_t WS_DFTC = 56 * MiB, WS_DFTS = 64 * MiB;
constexpr size_t WS_W13 = 72 * MiB;
constexpr size_t WS_W2 = 424 * MiB;
constexpr size_t WS_X = 608 * MiB;
constexpr size_t WS_H = 672 * MiB;
constexpr size_t WS_Q = 704 * MiB, WS_K = 736 * MiB, WS_V = 768 * MiB;
constexpr size_t WS_YT = 800 * MiB;
constexpr size_t WS_UV = 832 * MiB;
constexpr size_t WS_GATES = 864 * MiB;
constexpr size_t WS_AOUT = 960 * MiB, WS_BOUT = 992 * MiB, WS_COUT = 1024 * MiB;
constexpr size_t WS_T1 = 1040 * MiB, WS_MERGED = 1072 * MiB;
static_assert(WS_K - WS_Q == (32u << 20) && WS_V - WS_K == (32u << 20), "EpiWin: Q|K|V 32 MiB apart");
constexpr size_t WS_XIN = 704 * MiB;
constexpr size_t WS_HID = 768 * MiB;
constexpr size_t WS_Y = 952 * MiB;
constexpr size_t WS_T2 = 1104 * MiB;
constexpr size_t WS_END = 1136 * MiB;

__device__ __forceinline__ unsigned f2bf(float f) { unsigned u = __builtin_bit_cast(unsigned, f); return (u + 0x7fffu + ((u >> 16) & 1u)) >> 16; }
__device__ __forceinline__ unsigned pk2(float lo, float hi) { return f2bf(lo) | (f2bf(hi) << 16); }
__device__ __forceinline__ float bf2f(unsigned short b) { return __builtin_bit_cast(float, ((unsigned)b) << 16); }
__device__ __forceinline__ float wave_sum(float v) {
#pragma unroll
    for (int o = 1; o < 64; o <<= 1) v += __shfl_xor(v, o);
    return v;
}
__device__ __forceinline__ float sigmoid_f(float v) { return 1.0f / (1.0f + __expf(-v)); }
__device__ __forceinline__ float silu_f(float v) { return v / (1.0f + __expf(-v)); }
__device__ __forceinline__ float gelu_tanh_f(float v) {
    const float u = 0.7978845608028654f * (v + 0.044715f * v * v * v);
    const float e = __expf(2.0f * u);
    const float th = 1.0f - 2.0f / (e + 1.0f);
    return 0.5f * v * (1.0f + th);
}
__device__ inline void sincos_d(double x, double& s, double& c) {
    const double n = __builtin_rint(x * 0.63661977236758134308);
    double r = (x - n * 1.57079632673412561417e+00) - n * 6.07710050650619224932e-11;
    const double z = r * r;
    const double sp = r + r * z * (-1.66666666666666324348e-01 + z * (8.33333333332248946124e-03 + z * (-1.98412698298579493134e-04 + z * (2.75573137070700676789e-06 + z * (-2.50507602534068634195e-08 + z * 1.58969099521155010221e-10)))));
    const double cp = 1.0 - 0.5 * z + z * z * (4.16666666666666019037e-02 + z * (-1.38888888888741095749e-03 + z * (2.48015872894767294178e-05 + z * (-2.75573143513906633035e-07 + z * (2.08757232129817482790e-09 + z * -1.13596475577881948265e-11)))));
    const int q = ((int)n) & 3;
    s = (q == 0) ? sp : (q == 1) ? cp : (q == 2) ? -sp : -cp;
    c = (q == 0) ? cp : (q == 1) ? -sp : (q == 2) ? -cp : sp;
}

__device__ __forceinline__ void ada_item(int item, const float* c, const float* w_ada, const float* b_ada, float* ADA, LAS float* scr, int tid) {
    const int nc = item % 96, l = item / 96;
    LAS float* cact = scr; LAS float* part = scr + NB * DM;
    __syncthreads();
    for (int i = tid; i < NB * DM; i += 512) cact[i] = silu_f(c[i]);
    __syncthreads();
    { const int col = tid & 63, kp = tid >> 6; const int n = nc * 64 + col;
      float acc[NB];
#pragma unroll
      for (int b = 0; b < NB; ++b) acc[b] = 0.f;
      const float* wp = w_ada + ((size_t)l * DM + kp * 128) * 6144 + n;
      for (int k0 = 0; k0 < 128; k0 += 16) { float w[16];
#pragma unroll
          for (int i = 0; i < 16; ++i) w[i] = wp[(size_t)(k0 + i) * 6144];
#pragma unroll
          for (int i = 0; i < 16; ++i) {
#pragma unroll
              for (int b = 0; b < NB; ++b) acc[b] += cact[b * DM + kp * 128 + k0 + i] * w[i]; } }
#pragma unroll
      for (int b = 0; b < NB; ++b) part[(kp * NB + b) * 64 + col] = acc[b]; }
    __syncthreads();
    { const int col = tid & 63, b = tid >> 6; const int n = nc * 64 + col; float sum = b_ada[l * 6144 + n];
#pragma unroll
      for (int kp = 0; kp < 8; ++kp) sum += part[(kp * NB + b) * 64 + col];
      ADA[((size_t)l * NB + b) * 6144 + n] = sum; }
}
struct InvF { float v[8]; };
__device__ __forceinline__ void rope_entry(int idx, const int* positions, float* ROPE, const InvF& F) {
    const int t = idx >> 3, i = idx & 7;
    float invf = F.v[0];
#pragma unroll
    for (int q = 1; q < 8; ++q) invf = (i == q) ? F.v[q] : invf;
    const float ang = (float)positions[t] * invf;
    double s, c; sincos_d((double)ang, s, c);
    ROPE[t * 16 + i] = (float)c; ROPE[t * 16 + 8 + i] = (float)s;
}
__device__ __forceinline__ void dft_entry8(int idx, bf16_t* DFTC, bf16_t* DFTS) {
    const int m = idx >> 8, k0 = (idx & 255) * 8;
    unsigned cw[4], sw[4];
#pragma unroll
    for (int j = 0; j < 4; ++j) {
        float cv[2], sv[2];
#pragma unroll
        for (int e = 0; e < 2; ++e) { const int k = k0 + 2 * j + e; const int r = (m * k) & 2047; double s, c; sincos_d((double)r * (6.283185307179586476925 / 2048.0), s, c);
            cv[e] = (float)(c * (1.0 / 512.0)); sv[e] = (float)(-s * (1.0 / 512.0)); }
        cw[j] = pk2(cv[0], cv[1]); sw[j] = pk2(sv[0], sv[1]);
    }
    *(u32x4*)(DFTC + (size_t)m * 2048 + k0) = (u32x4){cw[0], cw[1], cw[2], cw[3]};
    *(u32x4*)(DFTS + (size_t)m * 2048 + k0) = (u32x4){sw[0], sw[1], sw[2], sw[3]};
}
__device__ __forceinline__ void transpose_tile(const float* __restrict__ src, size_t ldsrc, int k0, int n0, bf16_t* __restrict__ dst, size_t ldd, bf16_t* __restrict__ dst2, LAS float* scr, int lane) {
    f32x4 v[16];
#pragma unroll
    for (int i = 0; i < 16; ++i) v[i] = *(const f32x4*)(src + (size_t)(k0 + i * 4 + (lane >> 4)) * ldsrc + n0 + (lane & 15) * 4);
#pragma unroll
    for (int i = 0; i < 16; ++i) { LAS float* p = scr + (i * 4 + (lane >> 4)) * 65 + (lane & 15) * 4; p[0] = v[i][0]; p[1] = v[i][1]; p[2] = v[i][2]; p[3] = v[i][3]; }
    asm volatile("s_waitcnt lgkmcnt(0)" ::: "memory");
    const int c = lane & 7;
#pragma unroll
    for (int j = 0; j < 8; ++j) { const int n = (lane >> 3) + 8 * j; const LAS float* s = scr + (8 * c) * 65 + n;
        u32x4 o; o.x = pk2(s[0 * 65], s[1 * 65]); o.y = pk2(s[2 * 65], s[3 * 65]); o.z = pk2(s[4 * 65], s[5 * 65]); o.w = pk2(s[6 * 65], s[7 * 65]);
        *(u32x4*)(dst + (size_t)n * ldd + 8 * c) = o;
        if (dst2) *(u32x4*)(dst2 + (size_t)n * ldd + 8 * c) = o; }
    asm volatile("s_waitcnt lgkmcnt(0)" ::: "memory");
}
struct ConvPtrs { const float *w_in, *p_a, *p_b, *p_c, *w_out, *w1, *w3, *w2; unsigned char* ws; };
constexpr int CV_WIN = 16 * 112, CV_PA = 256, CV_PB = 128, CV_PC = 128, CV_WO = 256, CV_SMALL = CV_WIN + CV_PA + CV_PB + CV_PC + CV_WO;
constexpr int CV_EXP = 688 * 3, CV_LAYER = CV_SMALL + NE * CV_EXP, CV_TOTAL = NL * CV_LAYER;
__device__ __forceinline__ void conv_item(int it, const ConvPtrs& P, LAS float* scr, int lane) {
    const int l = it / CV_LAYER; int r = it % CV_LAYER;
    if (r < CV_WIN) { const int kt = r & 15; int nt = r >> 4; if (nt >= 48) nt += 8;
        const int n0 = nt * 64, drow = (n0 < 3072) ? n0 : n0 + 512;
        transpose_tile(P.w_in + (size_t)l * DM * NIN_SRC, NIN_SRC, kt * 64, n0, (bf16_t*)(P.ws + WS_WIN) + ((size_t)l * NIN + drow) * DM + kt * 64, DM, nullptr, scr, lane); return; }
    r -= CV_WIN;
    if (r < CV_PA) { const int kt = r & 15, nt = r >> 4;
        transpose_tile(P.p_a + (size_t)l * 1024 * 1024, 1024, kt * 64, nt * 64, (bf16_t*)(P.ws + WS_PA) + ((size_t)l * 1024 + nt * 64) * 1024 + kt * 64, 1024, nullptr, scr, lane); return; }
    r -= CV_PA;
    if (r < CV_PB) { const int kt = r & 7, nt = r >> 3;
        bf16_t* d = (bf16_t*)(P.ws + WS_PB) + ((size_t)l * 1024 + nt * 64) * 1024 + kt * 64;
        transpose_tile(P.p_b + (size_t)l * 512 * 1024, 1024, kt * 64, nt * 64, d, 1024, d + 512, scr, lane); return; }
    r -= CV_PB;
    if (r < CV_PC) { const int kt = r & 7, nt = r >> 3;
        transpose_tile(P.p_c + (size_t)l * 512 * 1024, 1024, kt * 64, nt * 64, (bf16_t*)(P.ws + WS_PC) + ((size_t)l * 1024 + nt * 64) * 512 + kt * 64, 512, nullptr, scr, lane); return; }
    r -= CV_PC;
    if (r < CV_WO) { const int kt = r & 15, nt = r >> 4;
        transpose_tile(P.w_out + (size_t)l * 1024 * 1024, 1024, kt * 64, nt * 64, (bf16_t*)(P.ws + WS_WOUT) + ((size_t)l * 1024 + nt * 64) * 1024 + kt * 64, 1024, nullptr, scr, lane); return; }
    r -= CV_WO;
    const int e = r / CV_EXP; r %= CV_EXP;
    const size_t le = (size_t)l * NE + e;
    if (r < 1376) { const int which = r / 688; r %= 688; const int kt = r & 15, nt = r >> 4;
        const int f0 = nt * 64, drow = (f0 >> 7) * 256 + which * 128 + (f0 & 127);
        transpose_tile((which ? P.w3 : P.w1) + le * DM * FF, FF, kt * 64, f0, (bf16_t*)(P.ws + WS_W13) + (le * (NFT * 256) + drow) * DM + kt * 64, DM, nullptr, scr, lane); return; }
    r -= 1376;
    { const int kt = r % 43, nt = r / 43;
        transpose_tile(P.w2 + le * FF * DM, DM, kt * 64, nt * 64, (bf16_t*)(P.ws + WS_W2) + (le * DM + nt * 64) * FFL + kt * 64, FFL, nullptr, scr, lane); }
}
typedef float f32x2_c __attribute__((ext_vector_type(2))); typedef __bf16 bf16x2_c __attribute__((ext_vector_type(2)));
__device__ __forceinline__ unsigned cvtpk_c(float lo, float hi) { f32x2_c v = {lo, hi}; bf16x2_c b = __builtin_convertvector(v, bf16x2_c); return __builtin_bit_cast(unsigned, b); }
struct TileDesc { const float* src; bf16_t* dst; bf16_t* dst2; unsigned ldsrc, ldd; };
__device__ __forceinline__ TileDesc conv_decode(int it, const ConvPtrs& P) {
    TileDesc d; d.dst2 = nullptr;
    const int l = it / CV_LAYER; int r = it % CV_LAYER;
    if (r < CV_WIN) { const int kt = r / 112; int nt = r % 112; if (nt >= 48) nt += 8;
        const int n0 = nt * 64, drow = (n0 < 3072) ? n0 : n0 + 512;
        d.src = P.w_in + ((size_t)l * DM + kt * 64) * NIN_SRC + n0; d.ldsrc = NIN_SRC; d.dst = (bf16_t*)(P.ws + WS_WIN) + ((size_t)l * NIN + drow) * DM + kt * 64; d.ldd = DM; return d; }
    r -= CV_WIN;
    if (r < CV_PA) { const int kt = r >> 4, nt = r & 15;
        d.src = P.p_a + ((size_t)l * 1024 + kt * 64) * 1024 + nt * 64; d.ldsrc = 1024; d.dst = (bf16_t*)(P.ws + WS_PA) + ((size_t)l * 1024 + nt * 64) * 1024 + kt * 64; d.ldd = 1024; return d; }
    r -= CV_PA;
    if (r < CV_PB) { const int kt = r >> 4, nt = r & 15;
        d.src = P.p_b + ((size_t)l * 512 + kt * 64) * 1024 + nt * 64; d.ldsrc = 1024; d.dst = (bf16_t*)(P.ws + WS_PB) + ((size_t)l * 1024 + nt * 64) * 1024 + kt * 64; d.dst2 = d.dst + 512; d.ldd = 1024; return d; }
    r -= CV_PB;
    if (r < CV_PC) { const int kt = r >> 4, nt = r & 15;
        d.src = P.p_c + ((size_t)l * 512 + kt * 64) * 1024 + nt * 64; d.ldsrc = 1024; d.dst = (bf16_t*)(P.ws + WS_PC) + ((size_t)l * 1024 + nt * 64) * 512 + kt * 64; d.ldd = 512; return d; }
    r -= CV_PC;
    if (r < CV_WO) { const int kt = r >> 4, nt = r & 15;
        d.src = P.w_out + ((size_t)l * 1024 + kt * 64) * 1024 + nt * 64; d.ldsrc = 1024; d.dst = (bf16_t*)(P.ws + WS_WOUT) + ((size_t)l * 1024 + nt * 64) * 1024 + kt * 64; d.ldd = 1024; return d; }
    r -= CV_WO;
    const int e = r / CV_EXP; r %= CV_EXP;
    const size_t le = (size_t)l * NE + e;
    if (r < 1376) { const int which = r / 688; r %= 688; const int kt = r / 43, nt = r % 43;
        const int f0 = nt * 64, drow = (f0 >> 7) * 256 + which * 128 + (f0 & 127);
        d.src = (which ? P.w3 : P.w1) + (le * DM + kt * 64) * FF + f0; d.ldsrc = FF; d.dst = (bf16_t*)(P.ws + WS_W13) + (le * (NFT * 256) + drow) * DM + kt * 64; d.ldd = DM; return d; }
    r -= 1376;
    { const int kt = r >> 4, nt = r & 15;
        d.src = P.w2 + (le * FF + kt * 64) * DM + nt * 64; d.ldsrc = DM; d.dst = (bf16_t*)(P.ws + WS_W2) + (le * DM + nt * 64) * FFL + kt * 64; d.ldd = FFL; return d; }
}
__device__ __forceinline__ void tile_load(const TileDesc& d, f32x4 (&v)[16], int lane) {
    const float* p = d.src + (size_t)(lane >> 4) * d.ldsrc + (lane & 15) * 4;
#pragma unroll
    for (int i = 0; i < 16; ++i) v[i] = *(const f32x4*)(p + (size_t)(i * 4) * d.ldsrc);
}
__device__ __forceinline__ void tile_store(const TileDesc& d, const f32x4 (&v)[16], LAS float* scr, int lane) {
#pragma unroll
    for (int i = 0; i < 16; ++i) { LAS float* p = scr + (i * 4 + (lane >> 4)) * 65 + (lane & 15) * 4; p[0] = v[i][0]; p[1] = v[i][1]; p[2] = v[i][2]; p[3] = v[i][3]; }
    asm volatile("s_waitcnt lgkmcnt(0)" ::: "memory");
    const int c = lane & 7;
#pragma unroll
    for (int j = 0; j < 8; ++j) { const int n = (lane >> 3) + 8 * j; const LAS float* s = scr + (8 * c) * 65 + n;
        u32x4 o; o.x = cvtpk_c(s[0 * 65], s[1 * 65]); o.y = cvtpk_c(s[2 * 65], s[3 * 65]); o.z = cvtpk_c(s[4 * 65], s[5 * 65]); o.w = cvtpk_c(s[6 * 65], s[7 * 65]);
        *(u32x4*)(d.dst + (size_t)n * d.ldd + 8 * c) = o;
        if (d.dst2) *(u32x4*)(d.dst2 + (size_t)n * d.ldd + 8 * c) = o; }
    asm volatile("s_waitcnt lgkmcnt(0)" ::: "memory");
}
constexpr int PAD_CH_W13 = 128 * 128, PAD_CH_W2 = 1024 * 8, PAD_CH = PAD_CH_W13 + PAD_CH_W2;
__device__ __forceinline__ void pad_chunk(size_t idx, unsigned char* ws) {
    const size_t le = idx / PAD_CH; const int r = (int)(idx % PAD_CH);
    const u32x4 z = {0u, 0u, 0u, 0u};
    if (r < PAD_CH_W13) { const int row = r >> 7, ch = r & 127; const int drow = 21 * 256 + ((row < 64) ? 64 + row : 192 + (row - 64));
        *(u32x4*)((bf16_t*)(ws + WS_W13) + (le * (NFT * 256) + drow) * DM + ch * 8) = z; }
    else { const int q = r - PAD_CH_W13; const int row = q >> 3, ch = q & 7;
        *(u32x4*)((bf16_t*)(ws + WS_W2) + (le * DM + row) * FFL + FF + ch * 8) = z; }
}
__device__ __forceinline__ void fold_item(int item, const float* w_in, bf16_t* WIN, LAS float* scr, int tid) {
    const int kc = item & 15, g = (item >> 4) & 3, l = item >> 6;
    LAS float* wt = scr; LAS float* tc = scr + 64 * 129; LAS float* ts = tc + 128;
    __syncthreads();
    for (int i = tid; i < 64 * 128; i += 512) { const int kk = i >> 7, c = i & 127; wt[kk * 129 + c] = w_in[((size_t)l * DM + kc * 64 + kk) * NIN_SRC + 3072 + g * 128 + c]; }
    if (tid < 128) { double s, c; sincos_d((double)tid * (6.283185307179586476925 / 128.0), s, c); tc[tid] = (float)c; ts[tid] = (float)s; }
    __syncthreads();
    const int kk = tid & 63, og = tid >> 6;
    for (int oo = 0; oo < 32; ++oo) { const int o = og * 32 + oo, part = o >> 7, cp = o & 127;
        float acc = 0.f;
        for (int c = 0; c < 128; ++c) { const int j = (c * cp) & 127; acc += wt[kk * 129 + c] * (part ? ts[j] : tc[j]); }
        WIN[((size_t)l * NIN + 3072 + g * 256 + o) * DM + kc * 64 + kk] = (bf16_t)f2bf(acc); }
}

namespace pg8 {
#define PG8_LAS __attribute__((address_space(3)))
typedef unsigned short bf16_t;
typedef short bf16x8 __attribute__((ext_vector_type(8)));
typedef float f32x4 __attribute__((ext_vector_type(4)));
typedef unsigned u32x4 __attribute__((ext_vector_type(4)));
constexpr int BM = 256, BK = 64, HALF = 128, HTB = HALF * BK * 2  , STAGE_BYTES = 8 * HTB, NXCD = 8, WGM = 8;

__host__ __device__ __forceinline__ int lds_byte(int r, int c) { const int st = (r >> 4) * 2 + (c >> 5), rr = r & 15, cc = c & 31, ob = rr * 64 + cc * 2; return st * 1024 + (ob ^ (((ob >> 9) & 1) << 5)); }
__host__ __device__ __forceinline__ void stage_rc(int b, int& R, int& C) { const int st = b / 1024, sb = b % 1024, swz = sb ^ (((sb >> 9) & 1) << 5); R = (st >> 1) * 16 + swz / 64; C = (st & 1) * 32 + (swz % 64) / 2; }
__host__ __device__ __forceinline__ int perm32(int rho) { const int n = rho >> 4, i = rho & 15; return 8 * (i >> 2) + 4 * n + (i & 3); }

struct Unit { int pm, pn; };
struct Gemm { const bf16_t* A; const bf16_t* Bt; int M, N, K, ld; };

struct StaticOrder {
    int nM, nN, nwg, G, c, rev;
    __host__ __device__ void init(int M, int N, int G_, int c_) { nM = M / BM; nN = N / BM; nwg = nM * nN; G = G_; c = c_; rev = 0; }
    __host__ __device__ bool next(int i, Unit& u) const {
        const long L = (long)i * G + c; if (L >= nwg) return false;
        int wgid = (int)L; { const int q = nwg / NXCD, r = nwg % NXCD, xcd = wgid % NXCD, off = wgid / NXCD; wgid = (xcd < r ? xcd * (q + 1) : r * (q + 1) + (xcd - r) * q) + off; }
        const int nig = WGM * nN, gid = wgid / nig, fm = gid * WGM, gsz = (nM - fm) < WGM ? (nM - fm) : WGM;
        u.pm = fm + ((wgid % nig) % gsz); u.pn = (wgid % nig) / gsz;
        if (rev) u.pn = nN - 1 - u.pn;
        return true;
    }
    __device__ __forceinline__ void a_ready(const Unit&) const {}
    __device__ __forceinline__ void done(const Unit&) const {}
};

typedef float f32x2_t __attribute__((ext_vector_type(2))); typedef __bf16 bf16x2_t __attribute__((ext_vector_type(2)));
__device__ __forceinline__ unsigned cvt_pk_bf16(float lo, float hi) { f32x2_t v = {lo, hi}; bf16x2_t b = __builtin_convertvector(v, bf16x2_t); return __builtin_bit_cast(unsigned, b); }
__device__ __forceinline__ float fast_sigmoid(float v) { return __builtin_amdgcn_rcpf(1.0f + __builtin_amdgcn_exp2f(-1.4426950408889634f * v)); }
__device__ __forceinline__ float fast_gelu_tanh(float v) { return v * __builtin_amdgcn_rcpf(1.0f + __builtin_amdgcn_exp2f(-2.3022082f * (v + 0.044715f * v * v * v))); }
__device__ __forceinline__ u32x4 pack8(const f32x4& v0, const f32x4& v1) { u32x4 w; w.x = cvt_pk_bf16(v0[0], v0[1]); w.y = cvt_pk_bf16(v0[2], v0[3]); w.z = cvt_pk_bf16(v1[0], v1[1]); w.w = cvt_pk_bf16(v1[2], v1[3]); return w; }
__device__ __forceinline__ void unpack8(const u32x4& w, f32x4& v0, f32x4& v1) {
    v0[0] = __builtin_bit_cast(float, w.x << 16); v0[1] = __builtin_bit_cast(float, w.x & 0xffff0000u); v0[2] = __builtin_bit_cast(float, w.y << 16); v0[3] = __builtin_bit_cast(float, w.y & 0xffff0000u);
    v1[0] = __builtin_bit_cast(float, w.z << 16); v1[1] = __builtin_bit_cast(float, w.z & 0xffff0000u); v1[2] = __builtin_bit_cast(float, w.w << 16); v1[3] = __builtin_bit_cast(float, w.w & 0xffff0000u); }

struct GroupOrder {
    int nM, nN, per, nwg, G, c, amode;
    __host__ __device__ void init(int Z, int nM_, int nN_, int G_, int c_, int amode_) { nM = nM_; nN = nN_; per = nM * nN; nwg = Z * per; G = G_; c = c_; amode = amode_; }
    __host__ __device__ bool next(int i, Unit& u) const {
        const long L = (long)i * G + c; if (L >= nwg) return false;
        int wgid = (int)L; { const int q = nwg / NXCD, r = nwg % NXCD, xcd = wgid % NXCD, off = wgid / NXCD; wgid = (xcd < r ? xcd * (q + 1) : r * (q + 1) + (xcd - r) * q) + off; }
        const int z = wgid / per, rr = wgid % per;
        const int nig = WGM * nN, gid = rr / nig, fm = gid * WGM, gsz = (nM - fm) < WGM ? (nM - fm) : WGM;
        const int pml = fm + ((rr % nig) % gsz), pnl = (rr % nig) / gsz;
        u.pm = (amode ? (z & 1) : z) * nM + pml; u.pn = z * nN + pnl; return true;
    }
    __device__ __forceinline__ void a_ready(const Unit&) const {}
    __device__ __forceinline__ void done(const Unit&) const {}
};

struct EpiWin {
    static constexpr bool PERM = true, AFTER_DRAIN = false;
    bf16_t *Q, *YT, *UV, *GATES; const float* ROPE;
    __device__ __forceinline__ void operator()(const f32x4 (&acc)[2][2][4][2], const Unit& u, int wr, int wc, int fr, int fq) const {
        const int row0 = u.pm * BM + wr * 64 + fr, pn = u.pn;
#if (WIN_DBG & 0x6F) != 0x6F
        { const int br = pn < 4 ? 0 : (pn < 8 ? 5 : (pn < 12 ? 6 : (pn < 16 ? 1 : (pn < 20 ? 2 : 3)))); if (!((WIN_DBG >> br) & 1)) return; }
#endif
        if (pn < 12) {
            bf16_t* base = Q + (size_t)(pn >> 2) * (size_t)(16u << 20) + (pn & 3) * 256 + wc * 32 + 8 * fq;
            const bool rope = (pn < 8) && ((wc & 1) == 0) && !((WIN_DBG >> 4) & 1);
            const float sgn = (fq == 0) ? -1.f : 1.f;
            const bool ld = rope && fq < 2;
            f32x4 nc0 = {1.f, 1.f, 1.f, 1.f}, nc1 = nc0, ns0 = {0.f, 0.f, 0.f, 0.f}, ns1 = ns0;
            if (ld) { const f32x4* rp = (const f32x4*)(ROPE + (size_t)row0 * 16); nc0 = rp[0]; nc1 = rp[1]; ns0 = rp[2]; ns1 = rp[3]; }
#pragma unroll
            for (int c = 0; c < 8; ++c) { const int ai = c >> 2, m = c & 3; const int row = row0 + ai * HALF + m * 16;
                f32x4 cs0 = nc0, cs1 = nc1, sn0 = ns0 * sgn, sn1 = ns1 * sgn;
                if (ld && c + 1 < 8) { const int c2 = c + 1; const f32x4* rp = (const f32x4*)(ROPE + (size_t)(row0 + (c2 >> 2) * HALF + (c2 & 3) * 16) * 16); nc0 = rp[0]; nc1 = rp[1]; ns0 = rp[2]; ns1 = rp[3]; }
#pragma unroll
                for (int bj = 0; bj < 2; ++bj) { f32x4 v0 = acc[ai][bj][m][0], v1 = acc[ai][bj][m][1];
                    if (rope) { f32x4 p0, p1;
#pragma unroll
                        for (int j = 0; j < 4; ++j) { p0[j] = __shfl_xor(v0[j], 16); p1[j] = __shfl_xor(v1[j], 16); }
                        v0 = v0 * cs0 + p0 * sn0; v1 = v1 * cs1 + p1 * sn1; }
                    *(u32x4*)(base + (size_t)row * 1024 + bj * HALF) = pack8(v0, v1); } }
        } else if (pn < 16) {
            const int g = pn - 12, b = u.pm >> 3, pos0 = (u.pm & 7) * BM + wr * 64 + fr;
#pragma unroll
            for (int bj = 0; bj < 2; ++bj) { bf16_t* yb = YT + ((size_t)(b * 2 + bj) * 512 + g * 128 + wc * 32 + 8 * fq) * 2048 + pos0;
#pragma unroll
                for (int ai = 0; ai < 2; ++ai)
#pragma unroll
                    for (int m = 0; m < 4; ++m)
#pragma unroll
                        for (int n = 0; n < 2; ++n) { const u32x4 dummy = {0u, 0u, 0u, 0u}; (void)dummy; const unsigned w0 = cvt_pk_bf16(acc[ai][bj][m][n][0], acc[ai][bj][m][n][1]), w1 = cvt_pk_bf16(acc[ai][bj][m][n][2], acc[ai][bj][m][n][3]);
                            bf16_t* p = yb + (size_t)(4 * n) * 2048 + ai * HALF + m * 16;
                            p[0] = (bf16_t)(w0 & 0xffffu); p[2048] = (bf16_t)(w0 >> 16); p[2 * 2048] = (bf16_t)(w1 & 0xffffu); p[3 * 2048] = (bf16_t)(w1 >> 16); } }
        } else if (pn < 20) {
            bf16_t* base = UV + (pn - 16) * 256 + wc * 32 + 8 * fq;
#pragma unroll
            for (int ai = 0; ai < 2; ++ai)
#pragma unroll
                for (int m = 0; m < 4; ++m) { const int row = row0 + ai * HALF + m * 16;
#pragma unroll
                    for (int bj = 0; bj < 2; ++bj) { f32x4 v0 = acc[ai][bj][m][0], v1 = acc[ai][bj][m][1];
#pragma unroll
                        for (int j = 0; j < 4; ++j) { v0[j] = fast_gelu_tanh(v0[j]); v1[j] = fast_gelu_tanh(v1[j]); }
                        *(u32x4*)(base + (size_t)row * 1024 + bj * HALF) = pack8(v0, v1); } }
        } else {
            bf16_t* base = GATES + (pn - 20) * 256 + wc * 32 + 8 * fq;
#pragma unroll
            for (int ai = 0; ai < 2; ++ai)
#pragma unroll
                for (int m = 0; m < 4; ++m) { const int row = row0 + ai * HALF + m * 16;
#pragma unroll
                    for (int bj = 0; bj < 2; ++bj) { f32x4 v0 = acc[ai][bj][m][0], v1 = acc[ai][bj][m][1];
#pragma unroll
                        for (int j = 0; j < 4; ++j) { v0[j] = fast_sigmoid(v0[j]); v1[j] = fast_sigmoid(v1[j]); }
                        __builtin_nontemporal_store(pack8(v0, v1), (u32x4*)(base + (size_t)row * 3072 + bj * HALF)); } }
        }
    }
};
struct EpiDft {
    static constexpr bool PERM = true, AFTER_DRAIN = false;
    bf16_t* BOUT;
    __device__ __forceinline__ void operator()(const f32x4 (&acc)[2][2][4][2], const Unit& u, int wr, int wc, int fr, int fq) const {
        const int part = u.pm >> 3, mt = u.pm & 7, b = u.pn >> 2, nt = u.pn & 1;
        bf16_t* base = BOUT + ((size_t)b * 2048 + mt * BM + wr * 64 + fr) * 1024 + part * 512 + nt * 256 + wc * 32 + 8 * fq;
#pragma unroll
        for (int ai = 0; ai < 2; ++ai)
#pragma unroll
            for (int m = 0; m < 4; ++m)
#pragma unroll
                for (int bj = 0; bj < 2; ++bj) *(u32x4*)(base + (size_t)(ai * HALF + m * 16) * 1024 + bj * HALF) = pack8(acc[ai][bj][m][0], acc[ai][bj][m][1]);
    }
};
template <int WHICH> struct EpiProj {
    static constexpr bool PERM = true, AFTER_DRAIN = false;
    const bf16_t* GATES; bf16_t* T1; bf16_t* T2; bf16_t* OUT;
    struct Ld { u32x4 ga, gb, gc, t1, t2; };
    __device__ __forceinline__ Ld load(size_t row, int col) const { Ld r; const bf16_t* g = GATES + row * 3072 + col; r.ga = *(const u32x4*)g; r.gb = *(const u32x4*)(g + 1024); r.gc = *(const u32x4*)(g + 2048);
        r.t1 = *(const u32x4*)(T1 + row * 1024 + col); r.t2 = *(const u32x4*)(T2 + row * 1024 + col); return r; }
    __device__ __forceinline__ void operator()(const f32x4 (&acc)[2][2][4][2], const Unit& u, int wr, int wc, int fr, int fq) const {
        const int row0 = u.pm * BM + wr * 64 + fr, col0 = u.pn * BM + wc * 32 + 8 * fq;
        if (WHICH < 2) {
            bf16_t* dst = (WHICH == 0 ? T1 : T2);
#pragma unroll
            for (int ai = 0; ai < 2; ++ai)
#pragma unroll
                for (int m = 0; m < 4; ++m)
#pragma unroll
                    for (int bj = 0; bj < 2; ++bj) *(u32x4*)(dst + (size_t)(row0 + ai * HALF + m * 16) * 1024 + col0 + bj * HALF) = pack8(acc[ai][bj][m][0], acc[ai][bj][m][1]);
        } else {
            Ld cur = load((size_t)row0, col0), nx1 = load((size_t)row0, col0 + HALF);
#pragma unroll
            for (int c = 0; c < 16; ++c) { const int ai = c >> 3, m = (c >> 1) & 3, bj = c & 1;
                const size_t row = (size_t)(row0 + ai * HALF + m * 16); const int col = col0 + bj * HALF;
                Ld nx2 = nx1;
                if (c + 2 < 16) { const int c2 = c + 2, ai2 = c2 >> 3, m2 = (c2 >> 1) & 3, bj2 = c2 & 1; nx2 = load((size_t)(row0 + ai2 * HALF + m2 * 16), col0 + bj2 * HALF); }
                f32x4 a0, a1, b0, b1, c0, c1, p0, p1, q0, q1;
                unpack8(cur.ga, a0, a1); unpack8(cur.gb, b0, b1); unpack8(cur.gc, c0, c1); unpack8(cur.t1, p0, p1); unpack8(cur.t2, q0, q1);
                const f32x4 v0 = a0 * p0 + b0 * q0 + c0 * acc[ai][bj][m][0], v1 = a1 * p1 + b1 * q1 + c1 * acc[ai][bj][m][1];
                *(u32x4*)(OUT + row * 1024 + col) = pack8(v0, v1);
                cur = nx1; nx1 = nx2; }
        }
    }
};
struct EpiWout {
    static constexpr bool PERM = false, AFTER_DRAIN = false;
    const float* Xin; float* Xout; const float* gt;
    __device__ __forceinline__ void operator()(const f32x4 (&acc)[2][2][4][2], const Unit& u, int wr, int wc, int fr, int fq) const {
        const int row0 = u.pm * BM + wr * 64 + fr, col0 = u.pn * BM + wc * 32 + 4 * fq, b = u.pm >> 3;
        f32x4 gv[2][2];
#pragma unroll
        for (int bj = 0; bj < 2; ++bj)
#pragma unroll
            for (int n = 0; n < 2; ++n) gv[bj][n] = *(const f32x4*)(gt + b * 6144 + col0 + bj * HALF + n * 16);
#pragma unroll
        for (int ai = 0; ai < 2; ++ai)
#pragma unroll
            for (int mh = 0; mh < 2; ++mh) { f32x4 xv[2][2][2];
#pragma unroll
                for (int mm = 0; mm < 2; ++mm)
#pragma unroll
                    for (int bj = 0; bj < 2; ++bj)
#pragma unroll
                        for (int n = 0; n < 2; ++n) xv[mm][bj][n] = *(const f32x4*)(Xin + (size_t)(row0 + ai * HALF + (mh * 2 + mm) * 16) * 1024 + col0 + bj * HALF + n * 16);
#pragma unroll
                for (int mm = 0; mm < 2; ++mm)
#pragma unroll
                    for (int bj = 0; bj < 2; ++bj)
#pragma unroll
                        for (int n = 0; n < 2; ++n) *(f32x4*)(Xout + (size_t)(row0 + ai * HALF + (mh * 2 + mm) * 16) * 1024 + col0 + bj * HALF + n * 16) = xv[mm][bj][n] + gv[bj][n] * acc[ai][bj][mh * 2 + mm][n]; }
    }
};
struct EpiG1 {
    static constexpr bool PERM = true, AFTER_DRAIN = false;
    bf16_t* HID;
    __device__ __forceinline__ void operator()(const f32x4 (&acc)[2][2][4][2], const Unit& u, int wr, int wc, int fr, int fq) const {
        const int ft = u.pn % 22;
        bf16_t* base = HID + ((size_t)u.pm * BM + wr * 64 + fr) * FFL + ft * 128 + wc * 32 + 8 * fq;
#pragma unroll
        for (int ai = 0; ai < 2; ++ai)
#pragma unroll
            for (int m = 0; m < 4; ++m) { f32x4 h0, h1;
#pragma unroll
                for (int j = 0; j < 4; ++j) { const float a0 = acc[ai][0][m][0][j], a1 = acc[ai][0][m][1][j]; h0[j] = a0 * fast_sigmoid(a0) * acc[ai][1][m][0][j]; h1[j] = a1 * fast_sigmoid(a1) * acc[ai][1][m][1][j]; }
                *(u32x4*)(base + (size_t)(ai * HALF + m * 16) * FFL) = pack8(h0, h1); }
    }
};
struct EpiG2 {
    static constexpr bool PERM = true, AFTER_DRAIN = false;
    bf16_t* YB;
    __device__ __forceinline__ void operator()(const f32x4 (&acc)[2][2][4][2], const Unit& u, int wr, int wc, int fr, int fq) const {
        bf16_t* base = YB + ((size_t)u.pm * BM + wr * 64 + fr) * 1024 + (u.pn & 3) * 256 + wc * 32 + 8 * fq;
#pragma unroll
        for (int ai = 0; ai < 2; ++ai)
#pragma unroll
            for (int m = 0; m < 4; ++m)
#pragma unroll
                for (int bj = 0; bj < 2; ++bj) *(u32x4*)(base + (size_t)(ai * HALF + m * 16) * 1024 + bj * HALF) = pack8(acc[ai][bj][m][0], acc[ai][bj][m][1]);
    }
};
template <class Epi, class Sched, bool ALIGN_EPI = false, bool SP2 = false, bool GATHER = false>
__device__ __forceinline__ void gemm_phase(PG8_LAS unsigned char* lds, const Gemm g, const Sched& S, const Epi& E) {
    int tid_l = threadIdx.x; asm volatile("" : "+v"(tid_l));
    const int tid = tid_l, wid = __builtin_amdgcn_readfirstlane(tid >> 6), lane = tid & 63, wr = wid >> 2, wc = wid & 3, fr = lane & 15, fq = lane >> 4;
    const int K = g.K, nt = K / BK, LD = g.ld ? g.ld : K;
    unsigned voffA[2], voffA1[2], voffB[2]; int gR[2], gC[2];
#pragma unroll
    for (int i = 0; i < 2; ++i) { int R, C; stage_rc(tid * 16 + i * 8192, R, C); const int Rb = Epi::PERM ? ((R & ~31) + perm32(R & 31)) : R;
        voffA[i] = (unsigned)(R * LD + C) * 2u; voffA1[i] = voffA[i]; voffB[i] = (unsigned)(Rb * LD + C) * 2u; gR[i] = R; gC[i] = C * 2; }
    const PG8_LAS unsigned* gtab = (const PG8_LAS unsigned*)(lds + STAGE_BYTES);
#define PG8_GLOAD(u_) do { if constexpr (GATHER) { _Pragma("unroll") for (int _i = 0; _i < 2; ++_i) { voffA[_i] = gtab[(u_) * 256 + gR[_i]] + (unsigned)gC[_i]; voffA1[_i] = gtab[(u_) * 256 + HALF + gR[_i]] + (unsigned)gC[_i]; } } } while (0)
    const size_t kstep = (size_t)(BK * 2);
    const size_t hstep = (size_t)HALF * LD * 2;
    const size_t tstep = 2 * hstep;
    const size_t hstepA = GATHER ? 0 : hstep, tstepA = GATHER ? 0 : tstep;
    const unsigned ldsw = (unsigned)wid * 1024u;
    const int aoff = lds_byte(wr * 64 + fr, fq * 8), boff = lds_byte(wc * 32 + fr, fq * 8);
#define PG8_SA(b, h) (((b) * 2 + (h)) * HTB)
#define PG8_SB(b, h) ((4 + (b) * 2 + (h)) * HTB)
#define PG8_STAGE(bufoff, gbase, voff) do { _Pragma("unroll") for (int _i = 0; _i < 2; ++_i) \
        __builtin_amdgcn_global_load_lds((const unsigned*)((const char*)(gbase) + (voff)[_i]), (PG8_LAS unsigned*)(lds + (bufoff) + ldsw + _i * 8192), 16, 0, 0); } while (0)
#define PG8_LDA(dst, b, h) do { _Pragma("unroll") for (int m = 0; m < 4; ++m) _Pragma("unroll") for (int k = 0; k < 2; ++k) dst[m][k] = *(const PG8_LAS bf16x8*)(lds + PG8_SA(b, h) + aoff + m * 2048 + k * 1024); } while (0)
#define PG8_LDB(dst, b, h) do { _Pragma("unroll") for (int n = 0; n < 2; ++n) _Pragma("unroll") for (int k = 0; k < 2; ++k) dst[n][k] = *(const PG8_LAS bf16x8*)(lds + PG8_SB(b, h) + boff + n * 2048 + k * 1024); } while (0)
#define PG8_MMA(ai, bj, At, Bt) do { __builtin_amdgcn_s_setprio(1); _Pragma("unroll") for (int m = 0; m < 4; ++m) _Pragma("unroll") for (int n = 0; n < 2; ++n) _Pragma("unroll") for (int k = 0; k < 2; ++k) \
        acc[ai][bj][m][n] = __builtin_amdgcn_mfma_f32_16x16x32_bf16(Bt[n][k], At[m][k], acc[ai][bj][m][n], 0, 0, 0); __builtin_amdgcn_s_setprio(0); } while (0)
#define PG8_WAIT_V(n) asm volatile("s_waitcnt vmcnt(" #n ")" ::: "memory")
#define PG8_WAIT_L(n) asm volatile("s_waitcnt lgkmcnt(" #n ")" ::: "memory")
#define PG8_BAR __builtin_amdgcn_s_barrier()
#define PG8_SCHED __builtin_amdgcn_sched_barrier(0)
    Unit cur, nxt; int ui = 0;
    if (!S.next(0, cur)) return;
    f32x4 acc[2][2][4][2];
#pragma unroll
    for (int a = 0; a < 2; ++a)
#pragma unroll
        for (int b = 0; b < 2; ++b)
#pragma unroll
            for (int m = 0; m < 4; ++m)
#pragma unroll
                for (int n = 0; n < 2; ++n) acc[a][b][m][n] = (f32x4){0.f, 0.f, 0.f, 0.f};
    bf16x8 At[4][2], B0[2][2], B1[2][2];
    static_assert(!GATHER || SP2, "gathered A: SP2 schedule only");
    const char* cA = (const char*)g.A + (size_t)cur.pm * tstepA; const char* cB = (const char*)g.Bt + (size_t)cur.pn * tstep;
    S.a_ready(cur);
    PG8_GLOAD(0);
    if constexpr (SP2) {
        PG8_STAGE(PG8_SB(0, 0), cB, voffB); PG8_STAGE(PG8_SB(0, 1), cB + hstep, voffB); PG8_STAGE(PG8_SA(0, 0), cA, voffA); PG8_STAGE(PG8_SA(0, 1), cA + hstepA, voffA1);
        if (wr == 1) PG8_BAR;
        PG8_WAIT_V(2); PG8_BAR;
        PG8_STAGE(PG8_SB(1, 0), cB + kstep, voffB); PG8_STAGE(PG8_SA(1, 0), cA + kstep, voffA); PG8_STAGE(PG8_SB(1, 1), cB + hstep + kstep, voffB);
        PG8_WAIT_V(6); PG8_BAR;
    } else {
        PG8_STAGE(PG8_SB(0, 0), cB, voffB); PG8_STAGE(PG8_SA(0, 0), cA, voffA); PG8_STAGE(PG8_SB(0, 1), cB + hstep, voffB); PG8_STAGE(PG8_SA(0, 1), cA + hstep, voffA);
        if (wr == 1) PG8_BAR;
        PG8_WAIT_V(4); PG8_BAR;
        PG8_STAGE(PG8_SB(1, 0), cB + kstep, voffB); PG8_STAGE(PG8_SA(1, 0), cA + kstep, voffA); PG8_STAGE(PG8_SB(1, 1), cB + hstep + kstep, voffB);
        PG8_WAIT_V(6); PG8_BAR;
    }
    for (;;) {
        const bool has_next = S.next(ui + 1, nxt);
        const char* nA = has_next ? (const char*)g.A + (size_t)nxt.pm * tstepA : cA; const char* nB = has_next ? (const char*)g.Bt + (size_t)nxt.pn * tstep : cB;
        for (int t = 0; t < nt; t += 2) {
            const bool last = (t == nt - 2);
            const char* a1 = cA + (size_t)(t + 1) * kstep;
            const char* a2 = last ? nA : cA + (size_t)(t + 2) * kstep; const char* b2 = last ? nB : cB + (size_t)(t + 2) * kstep;
            const char* a3 = a2 + kstep; const char* b3 = b2 + kstep;
            if (last && has_next) S.a_ready(nxt);
            if constexpr (SP2) {
            PG8_LDB(B0, 0, 0); PG8_LDB(B1, 0, 1); PG8_SCHED; PG8_LDA(At, 0, 0); PG8_STAGE(PG8_SA(1, 1), a1 + hstepA, voffA1);
            if constexpr (GATHER) { const int un_ = ui + (int)(last & has_next); PG8_GLOAD(un_); }
            PG8_WAIT_V(8); PG8_WAIT_L(0); PG8_BAR; PG8_MMA(0, 0, At, B0); PG8_MMA(0, 1, At, B1); PG8_BAR; PG8_SCHED;
            PG8_LDA(At, 0, 1); PG8_STAGE(PG8_SB(0, 0), b2, voffB); PG8_STAGE(PG8_SB(0, 1), b2 + hstep, voffB); PG8_STAGE(PG8_SA(0, 0), a2, voffA);
            PG8_WAIT_V(8); PG8_WAIT_L(0); PG8_BAR; PG8_MMA(1, 0, At, B0); PG8_MMA(1, 1, At, B1); PG8_BAR; PG8_SCHED;
            PG8_LDB(B0, 1, 0); PG8_LDB(B1, 1, 1); PG8_SCHED; PG8_LDA(At, 1, 0); PG8_STAGE(PG8_SA(0, 1), a2 + hstepA, voffA1);
            PG8_WAIT_V(8); PG8_WAIT_L(0); PG8_BAR; PG8_MMA(0, 0, At, B0); PG8_MMA(0, 1, At, B1); PG8_BAR; PG8_SCHED;
            PG8_LDA(At, 1, 1); PG8_STAGE(PG8_SB(1, 0), b3, voffB); PG8_STAGE(PG8_SB(1, 1), b3 + hstep, voffB); PG8_STAGE(PG8_SA(1, 0), a3, voffA);
            PG8_WAIT_V(8); PG8_WAIT_L(0); PG8_BAR; PG8_MMA(1, 0, At, B0); PG8_MMA(1, 1, At, B1); PG8_BAR; PG8_SCHED;
            } else {
            PG8_LDB(B0, 0, 0); PG8_SCHED; PG8_LDA(At, 0, 0); PG8_STAGE(PG8_SA(1, 1), a1 + hstep, voffA);
            PG8_WAIT_L(8); PG8_BAR; PG8_WAIT_L(0); PG8_MMA(0, 0, At, B0); PG8_BAR; PG8_SCHED;
            PG8_LDB(B1, 0, 1); PG8_STAGE(PG8_SB(0, 0), b2, voffB);
            PG8_BAR; PG8_WAIT_L(0); PG8_MMA(0, 1, At, B1); PG8_BAR;
            PG8_LDA(At, 0, 1); PG8_STAGE(PG8_SA(0, 0), a2, voffA);
            PG8_BAR; PG8_WAIT_L(0); PG8_MMA(1, 0, At, B0); PG8_BAR; PG8_SCHED;
            PG8_STAGE(PG8_SB(0, 1), b2 + hstep, voffB);
            PG8_WAIT_V(6); PG8_BAR; PG8_MMA(1, 1, At, B1); PG8_BAR;
            PG8_LDB(B0, 1, 0); PG8_SCHED; PG8_LDA(At, 1, 0); PG8_STAGE(PG8_SA(0, 1), a2 + hstep, voffA);
            PG8_WAIT_L(8); PG8_BAR; PG8_WAIT_L(0); PG8_MMA(0, 0, At, B0); PG8_BAR; PG8_SCHED;
            PG8_LDB(B1, 1, 1); PG8_STAGE(PG8_SB(1, 0), b3, voffB);
            PG8_BAR; PG8_WAIT_L(0); PG8_MMA(0, 1, At, B1); PG8_BAR;
            PG8_LDA(At, 1, 1); PG8_STAGE(PG8_SA(1, 0), a3, voffA);
            PG8_BAR; PG8_WAIT_L(0); PG8_MMA(1, 0, At, B0); PG8_BAR; PG8_SCHED;
            PG8_STAGE(PG8_SB(1, 1), b3 + hstep, voffB);
            PG8_WAIT_V(6); PG8_BAR; PG8_MMA(1, 1, At, B1); PG8_BAR;
            }
        }
        if constexpr (ALIGN_EPI) { if (wr == 0) PG8_BAR; }
        if constexpr (!Epi::AFTER_DRAIN) { int tz = threadIdx.x; asm volatile("" : "+v"(tz));
            const int lz = tz & 63; E(acc, cur, wr, wc, lz & 15, lz >> 4); S.done(cur); }
        if (!has_next) break;
#pragma unroll
        for (int a = 0; a < 2; ++a)
#pragma unroll
            for (int b = 0; b < 2; ++b)
#pragma unroll
                for (int m = 0; m < 4; ++m)
#pragma unroll
                    for (int n = 0; n < 2; ++n) acc[a][b][m][n] = (f32x4){0.f, 0.f, 0.f, 0.f};
        cur = nxt; cA = nA; cB = nB; ++ui;
        if constexpr (ALIGN_EPI) { if (wr == 1) PG8_BAR; }
    }
    PG8_WAIT_V(0);
    if constexpr (!ALIGN_EPI) { if (wr == 0) PG8_BAR; }
    PG8_BAR;
    if constexpr (Epi::AFTER_DRAIN) { E.fused(acc, cur, wr, wc, fr, fq, lds, wid, lane); S.done(cur); }
#undef PG8_GLOAD
#undef PG8_SA
#undef PG8_SB
#undef PG8_STAGE
#undef PG8_LDA
#undef PG8_LDB
#undef PG8_MMA
#undef PG8_WAIT_V
#undef PG8_WAIT_L
#undef PG8_BAR
#undef PG8_SCHED
}
}
namespace att {
using bf16 = unsigned short;
constexpr int QBLK = 32, KVBLK = 64, LDR = 1024, NKT = 2048 / KVBLK;
constexpr float SCALE = 0.125f, THR = 8.f;
constexpr int SHM_V = KVBLK * 128 * 2, SHM_K = KVBLK * 128 * 2, LDS_BYTES = 2 * SHM_V + 2 * SHM_K + 8 * 64 * 4;
using bf16x8 = __attribute__((ext_vector_type(8))) short;
using s16x4  = __attribute__((ext_vector_type(4))) short;
using f32x16 = __attribute__((ext_vector_type(16))) float;
using u32x4  = __attribute__((ext_vector_type(4))) unsigned;
#define KSWZ(row, colB) ((row) * 256 + ((colB) ^ (((row) & 7) << 4)))
#define SBAR() __builtin_amdgcn_sched_barrier(0)
__device__ __forceinline__ int crow(int r, int hi) { return (r & 3) + 8 * (r >> 2) + 4 * hi; }
__device__ __forceinline__ unsigned cvtpk(float lo, float hi) { unsigned r; asm volatile("v_cvt_pk_bf16_f32 %0, %1, %2" : "=v"(r) : "v"(lo), "v"(hi)); return r; }
__device__ __forceinline__ void partialSM(f32x16& p0, f32x16& p1, float& m_reg, float& mn, float& alpha) {
  constexpr float C = SCALE * 1.4426950408889634f;
  float pmax = p0[0]; for (int r = 1; r < 16; ++r) pmax = fmaxf(pmax, p0[r]); for (int r = 0; r < 16; ++r) pmax = fmaxf(pmax, p1[r]);
  { auto rr = __builtin_amdgcn_permlane32_swap(__float_as_uint(pmax), __float_as_uint(pmax), false, false);
    pmax = fmaxf(__uint_as_float(rr[0]), __uint_as_float(rr[1])); }
  if (__builtin_expect(__all(pmax - m_reg <= THR / SCALE), 1)) { mn = m_reg; alpha = 1.f; }
  else { mn = fmaxf(m_reg, pmax); alpha = __builtin_amdgcn_exp2f((m_reg - mn) * C); m_reg = mn; }
  float mnC = -mn * C;
  for (int r = 0; r < 16; ++r) p0[r] = fmaf(p0[r], C, mnC); for (int r = 0; r < 16; ++r) p1[r] = fmaf(p1[r], C, mnC);
  for (int r = 0; r < 16; ++r) p0[r] = __builtin_amdgcn_exp2f(p0[r]);
}
__device__ __forceinline__ void finishSM(f32x16& p0, f32x16& p1, float alpha, float& l_reg, bf16x8& pa0, bf16x8& pa1, bf16x8& pa2, bf16x8& pa3) {
  for (int r = 0; r < 16; ++r) p1[r] = __builtin_amdgcn_exp2f(p1[r]);
  float ps = 0; for (int r = 0; r < 16; ++r) ps += p0[r]; for (int r = 0; r < 16; ++r) ps += p1[r];
  { auto rr = __builtin_amdgcn_permlane32_swap(__float_as_uint(ps), __float_as_uint(ps), false, false);
    ps = __uint_as_float(rr[0]) + __uint_as_float(rr[1]); }
  l_reg = l_reg * alpha + ps;
#define PK4(P, BASE, OUT) do { unsigned a0 = cvtpk(P[BASE + 0], P[BASE + 1]), a1 = cvtpk(P[BASE + 2], P[BASE + 3]);   \
    unsigned b0 = cvtpk(P[BASE + 4], P[BASE + 5]), b1 = cvtpk(P[BASE + 6], P[BASE + 7]);                              \
    auto r0 = __builtin_amdgcn_permlane32_swap(a0, b0, false, false); auto r1 = __builtin_amdgcn_permlane32_swap(a1, b1, false, false); \
    u32x4 w = {r0[0], r1[0], r0[1], r1[1]}; OUT = *reinterpret_cast<bf16x8*>(&w); } while (0)
  PK4(p0, 0, pa0); PK4(p0, 8, pa1); PK4(p1, 0, pa2); PK4(p1, 8, pa3);
#undef PK4
}
__device__ __forceinline__ void qkt(f32x16& p0, f32x16& p1, const bf16* Ks, const bf16x8* qr, int r32, int hi, int cofsB) {
  p0 = f32x16{}; p1 = f32x16{};
  for (int d0 = 0; d0 < 4; ++d0) { int cb = cofsB + (d0 * 16 + hi * 8) * 2;
    bf16x8 b0 = *reinterpret_cast<const bf16x8*>((const char*)Ks + KSWZ(r32, cb));
    bf16x8 b1 = *reinterpret_cast<const bf16x8*>((const char*)Ks + KSWZ(32 + r32, cb));
    p0 = __builtin_amdgcn_mfma_f32_32x32x16_bf16(b0, qr[d0], p0, 0, 0, 0);
    p1 = __builtin_amdgcn_mfma_f32_32x32x16_bf16(b1, qr[d0], p1, 0, 0, 0); }
}
__device__ __forceinline__ int v_st(int k, int c) { const int kk = (k & ~0xC) | ((k & 4) << 1) | ((k & 8) >> 1); return ((kk >> 3) * 4 + (c >> 5)) * 512 + ((kk & 7) * 32 + (c & 31)) * 2; }
__device__ __forceinline__ int v_rd_base(int lane) { return ((lane & 3) << 3) | (((lane >> 2) & 3) << 6) | (((lane >> 4) & 1) << 5) | (((lane >> 5) & 1) << 8); }
constexpr int v_rd_off(int d0, int ks, int half) { return d0 * 512 + ks * 4096 + half * 2048; }
template <int OFF> __device__ __forceinline__ s16x4 tr_read(int vb) {
  s16x4 r; asm volatile("ds_read_b64_tr_b16 %0, %1 offset:%2" : "=&v"(r) : "v"(vb), "i"(OFF) : "memory"); return r;
}
template <int D0> __device__ __forceinline__ void pv_one(f32x16& od, int vb, bf16x8 pa0, bf16x8 pa1, bf16x8 pa2, bf16x8 pa3) {
  const s16x4 l0 = tr_read<v_rd_off(D0, 0, 0)>(vb), h0 = tr_read<v_rd_off(D0, 0, 1)>(vb), l1 = tr_read<v_rd_off(D0, 1, 0)>(vb), h1 = tr_read<v_rd_off(D0, 1, 1)>(vb);
  const s16x4 l2 = tr_read<v_rd_off(D0, 2, 0)>(vb), h2 = tr_read<v_rd_off(D0, 2, 1)>(vb), l3 = tr_read<v_rd_off(D0, 3, 0)>(vb), h3 = tr_read<v_rd_off(D0, 3, 1)>(vb);
  asm volatile("s_waitcnt lgkmcnt(0)" ::: "memory"); SBAR();
#define PK(L, H) (bf16x8){L[0], L[1], L[2], L[3], H[0], H[1], H[2], H[3]}
  od = __builtin_amdgcn_mfma_f32_32x32x16_bf16(pa0, PK(l0, h0), od, 0, 0, 0);
  od = __builtin_amdgcn_mfma_f32_32x32x16_bf16(pa1, PK(l1, h1), od, 0, 0, 0);
  od = __builtin_amdgcn_mfma_f32_32x32x16_bf16(pa2, PK(l2, h2), od, 0, 0, 0);
  od = __builtin_amdgcn_mfma_f32_32x32x16_bf16(pa3, PK(l3, h3), od, 0, 0, 0);
#undef PK
}
__device__ __forceinline__ void pv_d0(f32x16* o, int vb, bf16x8 pa0, bf16x8 pa1, bf16x8 pa2, bf16x8 pa3) {
  pv_one<0>(o[0], vb, pa0, pa1, pa2, pa3); pv_one<1>(o[1], vb, pa0, pa1, pa2, pa3); pv_one<2>(o[2], vb, pa0, pa1, pa2, pa3); pv_one<3>(o[3], vb, pa0, pa1, pa2, pa3);
}
__device__ __forceinline__ void attn_item(const bf16* __restrict__ Qb, const bf16* __restrict__ Kh, const bf16* __restrict__ Vh, bf16* __restrict__ Ob,
                                          float lam, float oscale, const float* __restrict__ gain, char* lds) {
  int tid_l = threadIdx.x; asm volatile("" : "+v"(tid_l));
  const int tid = tid_l, wid = tid >> 6, lane = tid & 63, r32 = lane & 31, hi = lane >> 5, rg = wid >> 1, cm = wid & 1;
  bf16* V_lds = (bf16*)lds; bf16* K_lds = (bf16*)(lds + 2 * SHM_V);
  float* ws = (float*)(lds + 2 * SHM_V + 2 * SHM_K) + wid * 64; float* li_l = ws; float* al_l = ws + 32;
  float m_reg = -1e30f, l_reg = 0; f32x16 o[4] = {}; bf16x8 qr[4];
  const bf16* Qw = Qb + (long)(rg * QBLK + r32) * LDR + cm * 64 + hi * 8;
#pragma unroll
  for (int d0 = 0; d0 < 4; ++d0) qr[d0] = *reinterpret_cast<const bf16x8*>(Qw + d0 * 16);
  const int cofsB = cm * 128;
  const int sr = tid >> 4, sc = (tid & 15) * 8, vst0 = v_st(sr, sc), vst1 = v_st(32 + sr, sc);
  const int vb0 = (int)(uintptr_t)V_lds + v_rd_base(lane);
  struct { bf16x8 vs0, vs1, ks0, ks1; } sr_[2];
#define SLOAD(i, k0) do { sr_[i].vs0 = *reinterpret_cast<const bf16x8*>(&Vh[(long)((k0) + sr) * LDR + sc]); sr_[i].vs1 = *reinterpret_cast<const bf16x8*>(&Vh[(long)((k0) + 32 + sr) * LDR + sc]); \
    sr_[i].ks0 = *reinterpret_cast<const bf16x8*>(&Kh[(long)((k0) + sr) * LDR + sc]); sr_[i].ks1 = *reinterpret_cast<const bf16x8*>(&Kh[(long)((k0) + 32 + sr) * LDR + sc]); } while (0)
#define SWRITE(b, i) do { *(bf16x8*)((char*)V_lds + (b) * SHM_V + vst0) = sr_[i].vs0;          \
    *(bf16x8*)((char*)V_lds + (b) * SHM_V + vst1) = sr_[i].vs1; int kc = sc * 2;               \
    *(bf16x8*)((char*)K_lds + (b) * SHM_K + KSWZ(sr, kc)) = sr_[i].ks0;                       \
    *(bf16x8*)((char*)K_lds + (b) * SHM_K + KSWZ(32 + sr, kc)) = sr_[i].ks1; } while (0)
#define SWAIT() asm volatile("s_waitcnt vmcnt(4)" ::: "memory")
#define RESC(a) do { if (__any((a) < 1.f)) { if (hi == 0) al_l[r32] = (a); asm volatile("s_waitcnt lgkmcnt(0)" ::: "memory"); \
    for (int d = 0; d < 4; ++d) for (int r = 0; r < 16; ++r) o[d][r] *= al_l[crow(r, hi)]; } } while (0)
  f32x16 pA0, pA1, pB0, pB1; float mnA, mnB, alA, alB; bf16x8 pa0, pa1, pa2, pa3; const int NT = NKT;
  constexpr int SE = 0, SO = 1;
  SLOAD(SE, 0); asm volatile("s_waitcnt vmcnt(0)" ::: "memory"); SWRITE(0, SE); __syncthreads();
  qkt(pA0, pA1, K_lds, qr, r32, hi, cofsB); partialSM(pA0, pA1, m_reg, mnA, alA);
  SLOAD(SO, KVBLK); if (2 < NT) SLOAD(SE, 2 * KVBLK);
  SWAIT(); SWRITE(1, SO); __syncthreads();
  for (int j = 1; j + 1 < NT; j += 2) {
    SBAR(); qkt(pB0, pB1, (bf16*)((char*)K_lds + SHM_K), qr, r32, hi, cofsB);
    finishSM(pA0, pA1, alA, l_reg, pa0, pa1, pa2, pa3); SBAR();
    SLOAD(SO, (j + 2) * KVBLK); SBAR();
    pv_d0(o, vb0, pa0, pa1, pa2, pa3); partialSM(pB0, pB1, m_reg, mnB, alB);
    __syncthreads(); SWAIT(); SWRITE(0, SE);
    RESC(alB); __syncthreads();
    SBAR(); qkt(pA0, pA1, K_lds, qr, r32, hi, cofsB);
    finishSM(pB0, pB1, alB, l_reg, pa0, pa1, pa2, pa3); SBAR();
    if (j + 3 < NT) SLOAD(SE, (j + 3) * KVBLK); SBAR();
    pv_d0(o, vb0 + (int)SHM_V, pa0, pa1, pa2, pa3); partialSM(pA0, pA1, m_reg, mnA, alA);
    __syncthreads(); SWAIT(); SWRITE(1, SO);
    RESC(alA); __syncthreads();
  }
  SBAR(); qkt(pB0, pB1, (bf16*)((char*)K_lds + SHM_K), qr, r32, hi, cofsB);
  finishSM(pA0, pA1, alA, l_reg, pa0, pa1, pa2, pa3); SBAR();
  pv_d0(o, vb0, pa0, pa1, pa2, pa3); partialSM(pB0, pB1, m_reg, mnB, alB);
  __syncthreads(); RESC(alB);
  finishSM(pB0, pB1, alB, l_reg, pa0, pa1, pa2, pa3); SBAR();
  pv_d0(o, vb0 + (int)SHM_V, pa0, pa1, pa2, pa3);
  if (hi == 0) li_l[r32] = l_reg; asm volatile("s_waitcnt lgkmcnt(0)" ::: "memory");
  float rli[16];
#pragma unroll
  for (int r = 0; r < 16; ++r) rli[r] = __builtin_amdgcn_rcpf(li_l[crow(r, hi)]);
  __syncthreads();
  float* ex = (float*)lds + rg * 4096 + lane;
  if (cm == 1) {
#pragma unroll
    for (int d0 = 0; d0 < 4; ++d0)
#pragma unroll
      for (int r = 0; r < 16; ++r) ex[(d0 * 16 + r) * 64] = o[d0][r] * rli[r] * lam;
  }
  __syncthreads();
  if (cm == 0) {
    float ss[16];
#pragma unroll
    for (int r = 0; r < 16; ++r) { float s = 0.f;
#pragma unroll
      for (int d0 = 0; d0 < 4; ++d0) { const float v = o[d0][r] * rli[r] - ex[(d0 * 16 + r) * 64]; o[d0][r] = v; s += v * v; }
      ss[r] = s; }
#pragma unroll
    for (int r = 0; r < 16; ++r) { float s = ss[r]; s += __shfl_xor(s, 1); s += __shfl_xor(s, 2); s += __shfl_xor(s, 4); s += __shfl_xor(s, 8); s += __shfl_xor(s, 16);
      ss[r] = oscale / sqrtf(s * (1.0f / 128.0f) + 1e-6f); }
    float gn[4];
#pragma unroll
    for (int d0 = 0; d0 < 4; ++d0) gn[d0] = gain[d0 * 32 + r32];
#pragma unroll
    for (int r = 0; r < 16; ++r) { bf16* orow = Ob + (long)(rg * QBLK + crow(r, hi)) * LDR + r32;
#pragma unroll
      for (int d0 = 0; d0 < 4; ++d0) { const float v = o[d0][r] * ss[r] * gn[d0]; unsigned u = __builtin_bit_cast(unsigned, v); u = (u + 0x7fffu + ((u >> 16) & 1u)) >> 16; orow[d0 * 32] = (bf16)u; } }
  }
  __syncthreads();
#undef SLOAD
#undef SWRITE
#undef SWAIT
#undef RESC
}
#undef KSWZ
#undef SBAR
}
namespace att2 {
using namespace att;
constexpr int SHM_Q = 256 * 128 * 2;
constexpr int LDS_BYTES2 = 2 * SHM_V + 2 * SHM_K + SHM_Q + 8 * 64 * 4;
#define KSWZ(row, colB) ((row) * 256 + ((colB) ^ (((row) & 15) << 4)))
#define SBAR() __builtin_amdgcn_sched_barrier(0)
__device__ __forceinline__ void qkt2(f32x16& p0, f32x16& p1, const char* Ks, const char* Qs, int qrow, int r32, int hi, int cofsB) {
  p0 = f32x16{}; p1 = f32x16{};
#pragma unroll
  for (int d0 = 0; d0 < 4; ++d0) { const int cb = cofsB + (d0 * 16 + hi * 8) * 2;
    const bf16x8 q = *reinterpret_cast<const bf16x8*>(Qs + KSWZ(qrow, cb));
    const bf16x8 b0 = *reinterpret_cast<const bf16x8*>(Ks + KSWZ(r32, cb));
    const bf16x8 b1 = *reinterpret_cast<const bf16x8*>(Ks + KSWZ(32 + r32, cb));
    p0 = __builtin_amdgcn_mfma_f32_32x32x16_bf16(b0, q, p0, 0, 0, 0);
    p1 = __builtin_amdgcn_mfma_f32_32x32x16_bf16(b1, q, p1, 0, 0, 0); }
}
__device__ __forceinline__ void attn2_items(int first, int stride, const bf16* __restrict__ Q, const bf16* __restrict__ Kg, const bf16* __restrict__ Vg, bf16* __restrict__ O,
                                            float lam, float oscale, const float* __restrict__ gain, char* lds) {
  int tid_l = threadIdx.x; asm volatile("" : "+v"(tid_l));
  const int tid = tid_l, wid = tid >> 6, lane = tid & 63, r32 = lane & 31, hi = lane >> 5;
  char* V_lds = lds; char* K_lds = lds + 2 * SHM_V; char* Q_lds = lds + 2 * SHM_V + 2 * SHM_K;
  float* ws = (float*)(lds + 2 * SHM_V + 2 * SHM_K + SHM_Q) + wid * 64; float* li_l = ws; float* al_l = ws + 32;
  const int sr = tid >> 4, sc = (tid & 15) * 8, vst0 = v_st(sr, sc), vst1 = v_st(32 + sr, sc);
  const int vb0 = (int)(uintptr_t)V_lds + v_rd_base(lane);
  const int qrow = wid * 32 + r32;
  const unsigned kvoff0 = (unsigned)(sr * LDR + sc) * 2u;
  for (int it = first; it < 8 * 8 * 8; it += stride) {
    unsigned kvoff = kvoff0; asm volatile("" : "+v"(kvoff));
    const int qb = it & 7, h = (it >> 3) & 7, b = it >> 6;
    const bf16* Qb = Q + ((long)b * 2048 + qb * 256) * LDR + h * 128; const bf16* Kh = Kg + (long)b * 2048 * LDR + h * 128; const bf16* Vh = Vg + (long)b * 2048 * LDR + h * 128;
    bf16* Ob = O + ((long)b * 2048 + qb * 256) * LDR + h * 128;
    bf16x8 vs0, vs1, ks0, ks1;
#define SLOAD2(k0) do { const char* vb_ = (const char*)Vh + (size_t)(k0) * (LDR * 2); const char* kb_ = (const char*)Kh + (size_t)(k0) * (LDR * 2);     \
    vs0 = *reinterpret_cast<const bf16x8*>(vb_ + kvoff); vs1 = *reinterpret_cast<const bf16x8*>(vb_ + kvoff + (unsigned)(32 * LDR * 2)); \
    ks0 = *reinterpret_cast<const bf16x8*>(kb_ + kvoff); ks1 = *reinterpret_cast<const bf16x8*>(kb_ + kvoff + (unsigned)(32 * LDR * 2)); } while (0)
#define SWRITE2(bf) do { *(bf16x8*)(V_lds + (bf) * SHM_V + vst0) = vs0; *(bf16x8*)(V_lds + (bf) * SHM_V + vst1) = vs1; const int kc = sc * 2; \
    *(bf16x8*)(K_lds + (bf) * SHM_K + KSWZ(sr, kc)) = ks0; *(bf16x8*)(K_lds + (bf) * SHM_K + KSWZ(32 + sr, kc)) = ks1; } while (0)
#define RESC2(o, a) do { if (__any((a) < 1.f)) { if (hi == 0) al_l[r32] = (a); asm volatile("s_waitcnt lgkmcnt(0)" ::: "memory"); \
    for (int d = 0; d < 4; ++d) for (int r = 0; r < 16; ++r) o[d][r] *= al_l[crow(r, hi)]; } } while (0)
    SLOAD2(0);
    {
      bf16x8 qv[8]; int srz = sr; asm volatile("" : "+v"(srz));
      const unsigned qoff = (unsigned)(srz * LDR + sc) * 2u;
#pragma unroll
      for (int i = 0; i < 8; ++i) qv[i] = *reinterpret_cast<const bf16x8*>((const char*)Qb + qoff + (unsigned)(32 * i * LDR * 2));
#pragma unroll
      for (int i = 0; i < 8; ++i) *(bf16x8*)(Q_lds + KSWZ(srz + 32 * i, sc * 2)) = qv[i]; }
    SWRITE2(0);
    __syncthreads();
    f32x16 o0[4] = {}, o1[4] = {}; float m0 = -1e30f, l0 = 0.f, m1 = -1e30f, l1 = 0.f;
    for (int j = 0; j < NKT; ++j) {
      const int bf = j & 1;
      int qrow_l = qrow; asm volatile("" : "+v"(qrow_l));
      if (j + 1 < NKT) SLOAD2((j + 1) * KVBLK);
      const char* Ks = K_lds + bf * SHM_K; const int vb = vb0 + bf * SHM_V;
      { f32x16 p0, p1; float mn, al; bf16x8 pa0, pa1, pa2, pa3;
        qkt2(p0, p1, Ks, Q_lds, qrow_l, r32, hi, 0);
        partialSM(p0, p1, m0, mn, al); RESC2(o0, al);
        finishSM(p0, p1, al, l0, pa0, pa1, pa2, pa3); SBAR();
        pv_d0(o0, vb, pa0, pa1, pa2, pa3); }
      SBAR();
      { f32x16 p0, p1; float mn, al; bf16x8 pa0, pa1, pa2, pa3;
        qkt2(p0, p1, Ks, Q_lds, qrow_l, r32, hi, 128);
        partialSM(p0, p1, m1, mn, al); RESC2(o1, al);
        finishSM(p0, p1, al, l1, pa0, pa1, pa2, pa3); SBAR();
        pv_d0(o1, vb, pa0, pa1, pa2, pa3); }
      if (j + 1 < NKT) SWRITE2(bf ^ 1);
      __syncthreads();
    }
    {
    int lz = tid_l & 63; asm volatile("" : "+v"(lz));
    const int r32 = lz & 31, hi = lz >> 5;
    if (hi == 0) { li_l[r32] = l0; al_l[r32] = l1; } asm volatile("s_waitcnt lgkmcnt(0)" ::: "memory");
    float ss[16];
#pragma unroll
    for (int r = 0; r < 16; ++r) { const float ra = __builtin_amdgcn_rcpf(li_l[crow(r, hi)]), rb = lam * __builtin_amdgcn_rcpf(al_l[crow(r, hi)]); float s = 0.f;
#pragma unroll
      for (int d0 = 0; d0 < 4; ++d0) { const float v = o0[d0][r] * ra - o1[d0][r] * rb; o0[d0][r] = v; s += v * v; }
      ss[r] = s; }
#pragma unroll
    for (int r = 0; r < 16; ++r) { float s = ss[r]; s += __shfl_xor(s, 1); s += __shfl_xor(s, 2); s += __shfl_xor(s, 4); s += __shfl_xor(s, 8); s += __shfl_xor(s, 16);
      ss[r] = oscale / sqrtf(s * (1.0f / 128.0f) + 1e-6f); }
    float gn[4];
#pragma unroll
    for (int d0 = 0; d0 < 4; ++d0) gn[d0] = gain[d0 * 32 + r32];
#pragma unroll
    for (int r = 0; r < 16; ++r) { bf16* orow = Ob + (long)(wid * QBLK + crow(r, hi)) * LDR + r32;
#pragma unroll
      for (int d0 = 0; d0 < 4; ++d0) { const float v = o0[d0][r] * ss[r] * gn[d0]; unsigned u = __builtin_bit_cast(unsigned, v); u = (u + 0x7fffu + ((u >> 16) & 1u)) >> 16; orow[d0 * 32] = (bf16)u; } }
    }
    __syncthreads();
#undef SLOAD2
#undef SWRITE2
#undef RESC2
  }
}
#undef KSWZ
#undef SBAR
}
#define GAS __attribute__((address_space(1)))
typedef GAS unsigned gu32;
constexpr int NWAVES = 8;
constexpr int RING_BYTES = 131072, LDS_TOTAL = 147456, MISC_OFF = LDS_TOTAL - 256;
constexpr int CW_CONVQ = 1024;
constexpr int CW_BAR = 4096;
constexpr int N_PHASES = 2 + 9 * NL;

#define XB_TMO      128
#define XB_XCNT(j)  (256  + 64 * (j))
#define XB_XSUB(j)  (1280 + 64 * (j))
#define XB_XGEN(j)  (2304 + 64 * (j))
#define XB_TOP      3328
#define XB_TOPGEN   3392
#define XCD_BAR_WORDS 3456
#define XB_SPIN_CAP (1u << 18)
__device__ __forceinline__ unsigned xb_ld(unsigned* p)              { return __hip_atomic_load(p, __ATOMIC_RELAXED, __HIP_MEMORY_SCOPE_AGENT); }
__device__ __forceinline__ unsigned xb_add(unsigned* p, unsigned v) { return __hip_atomic_fetch_add(p, v, __ATOMIC_RELAXED, __HIP_MEMORY_SCOPE_AGENT); }
__device__ __forceinline__ unsigned xb_xcc_id() { return (unsigned)__builtin_amdgcn_s_getreg((3 << 11) | 20) & 0xFu; }
#define XB_SPIN(cond, bar) do { unsigned _sp = 0; while (cond) { __builtin_amdgcn_s_sleep(1); \
    if ((++_sp & 255u) == 0u) { if (xb_ld(&(bar)[XB_TMO])) break; if (_sp > XB_SPIN_CAP) { atomicAdd(&(bar)[XB_TMO], 1u); break; } } } } while (0)
struct XcdBarrier { unsigned* bar; unsigned x; volatile LAS unsigned* st; };
__device__ __forceinline__ XcdBarrier xcd_barrier_post(unsigned* bar, volatile LAS unsigned* st) {
    XcdBarrier b; b.bar = bar; b.x = xb_xcc_id(); b.st = st;
    if (threadIdx.x == 0) (void)xb_add(&bar[XB_XCNT(b.x)], 1u);
    return b;
}
__device__ __forceinline__ void xcd_barrier_complete(unsigned* bar, unsigned x, unsigned& nloc, unsigned& nx) {
    const unsigned G = gridDim.x * gridDim.y * gridDim.z;
    unsigned sum, cnt, mine, sp = 0u;
    for (;;) {
        sum = 0u; cnt = 0u; mine = 0u;
#pragma unroll
        for (unsigned j = 0; j < 16; ++j) { const unsigned c = xb_ld(&bar[XB_XCNT(j)]); sum += c; cnt += (c > 0u) ? 1u : 0u; mine = (j == x) ? c : mine; }
        if (sum == G) break;
        __builtin_amdgcn_s_sleep(1);
        if ((++sp & 255u) == 0u) { if (xb_ld(&bar[XB_TMO])) break; if (sp > XB_SPIN_CAP) { atomicAdd(&bar[XB_TMO], 1u); break; } }
    }
    nloc = mine > 0u ? mine : 1u; nx = cnt > 0u ? cnt : 1u;
}
__device__ __forceinline__ void xcd_barrier(const XcdBarrier& b) {
    asm volatile("s_waitcnt vmcnt(0)" ::: "memory");
    __syncthreads();
    if (threadIdx.x == 0) {
        unsigned* bar = b.bar;
        __builtin_amdgcn_s_waitcnt(0);
        unsigned nloc = b.st[0], nx = b.st[1];
        if (nloc == 0u) { xcd_barrier_complete(bar, b.x, nloc, nx); b.st[0] = nloc; b.st[1] = nx; }
        const unsigned old = xb_add(&bar[XB_XSUB(b.x)], 1u);
        const unsigned gen = old / nloc;
        if (old + 1u == (gen + 1u) * nloc) {
            __builtin_amdgcn_fence(__ATOMIC_RELEASE, "agent");
            asm volatile("s_waitcnt vmcnt(0)" ::: "memory");
            const unsigned og = xb_add(&bar[XB_TOP], 1u);
            const unsigned tg = og / nx;
            if (og + 1u == (tg + 1u) * nx) xb_add(&bar[XB_TOPGEN], 1u);
            else XB_SPIN(xb_ld(&bar[XB_TOPGEN]) == tg, bar);
            __builtin_amdgcn_fence(__ATOMIC_ACQUIRE, "agent");
            xb_add(&bar[XB_XGEN(b.x)], 1u);
            asm volatile("s_waitcnt vmcnt(0)" ::: "memory");
        } else {
            XB_SPIN(xb_ld(&bar[XB_XGEN(b.x)]) == gen, bar);
            __builtin_amdgcn_fence(__ATOMIC_ACQUIRE, "agent");
            asm volatile("s_waitcnt vmcnt(0)" ::: "memory");
        }
    }
    __syncthreads();
}

__device__ __forceinline__ void gmlp_item(int item, const bf16_t* __restrict__ UV, const float* __restrict__ w_s_l, const float* __restrict__ b_s_l, bf16_t* __restrict__ COUT, LAS unsigned char* lds, int tid) {
    const int g = item & 3, n = (item >> 2) & 15, b = item >> 6, lane = tid & 63, wave = tid >> 6, fr = lane & 15, fq = lane >> 4;
    const size_t t0 = (size_t)b * SEQ + n * 128;
    LAS bf16_t* vgT = (LAS bf16_t*)lds;
    LAS bf16_t* wsb = (LAS bf16_t*)(lds + 34816);
    __syncthreads();
    { const int q = tid >> 2, qt = tid & 3;
      const u32x4* src = (const u32x4*)(UV + (t0 + q) * 1024 + 512 + g * 128 + qt * 32);
      float v[32]; float ss = 0.f;
#pragma unroll
      for (int i = 0; i < 4; ++i) { const u32x4 w = src[i]; f32x4 a, c; pg8::unpack8(w, a, c);
#pragma unroll
          for (int j = 0; j < 4; ++j) { v[i * 8 + j] = a[j]; v[i * 8 + 4 + j] = c[j]; ss += a[j] * a[j] + c[j] * c[j]; } }
      ss += __shfl_xor(ss, 1); ss += __shfl_xor(ss, 2);
      const float r = 1.0f / sqrtf(ss * (1.0f / 128.0f) + EPS);
#pragma unroll
      for (int cc = 0; cc < 32; ++cc) vgT[(qt * 32 + cc) * 136 + q] = (bf16_t)f2bf(v[cc] * r);
      const f32x4* wsrc = (const f32x4*)(w_s_l + ((size_t)g * 128 + q) * 128 + qt * 32);
#pragma unroll
      for (int i = 0; i < 4; ++i) { const f32x4 a = wsrc[2 * i], c = wsrc[2 * i + 1]; *(LAS u32x4*)(wsb + q * 136 + qt * 32 + i * 8) = pg8::pack8(a, c); } }
    __syncthreads();
    f32x4 acc[8];
#pragma unroll
    for (int j = 0; j < 8; ++j) acc[j] = (f32x4){0.f, 0.f, 0.f, 0.f};
#pragma unroll
    for (int ks = 0; ks < 4; ++ks) { const bf16x8 wfrag = *(const LAS bf16x8*)(wsb + (16 * wave + fr) * 136 + ks * 32 + fq * 8);
#pragma unroll
        for (int j = 0; j < 8; ++j) { const bf16x8 vfrag = *(const LAS bf16x8*)(vgT + (16 * j + fr) * 136 + ks * 32 + fq * 8); acc[j] = __builtin_amdgcn_mfma_f32_16x16x32_bf16(vfrag, wfrag, acc[j], 0, 0, 0); } }
    { const int p = 16 * wave + fr; const float bias = b_s_l[g * 128 + p];
      const bf16_t* urow = UV + (t0 + p) * 1024 + g * 128 + 4 * fq; bf16_t* orow = COUT + (t0 + p) * 512 + g * 128 + 4 * fq;
      unsigned long long uu[8];
#pragma unroll
      for (int j = 0; j < 8; ++j) uu[j] = *(const unsigned long long*)(urow + 16 * j);
#pragma unroll
      for (int j = 0; j < 8; ++j) { const unsigned lo = (unsigned)uu[j], hi = (unsigned)(uu[j] >> 32);
          const float u0 = __builtin_bit_cast(float, lo << 16), u1 = __builtin_bit_cast(float, lo & 0xffff0000u), u2 = __builtin_bit_cast(float, hi << 16), u3 = __builtin_bit_cast(float, hi & 0xffff0000u);
          *(unsigned long long*)(orow + 16 * j) = (unsigned long long)pk2(u0 * (acc[j][0] + bias), u1 * (acc[j][1] + bias)) | ((unsigned long long)pk2(u2 * (acc[j][2] + bias), u3 * (acc[j][3] + bias)) << 32); } }
}
__device__ __forceinline__ void topk_gather_item(int pair, int half, const float* __restrict__ AFF, int* __restrict__ SEL, unsigned* __restrict__ GIDX, LAS unsigned char* lds, int tid) {
    const int lane = tid & 63, wave = tid >> 6, b = pair >> 4, e = pair & 15;
    LAS int* cntA = (LAS int*)lds; LAS int* scanw = (LAS int*)(lds + 64); LAS int* idxs = (LAS int*)(lds + 128);
    const f32x4 xv = *(const f32x4*)(AFF + (size_t)pair * SEQ + tid * 4);
    unsigned u[4];
#pragma unroll
    for (int k = 0; k < 4; ++k) { const float f = xv[k]; u[k] = __float_as_uint(f); }
    unsigned T = 0u;
    __syncthreads();
    for (int bit = 30; bit >= 0; --bit) {
        const unsigned cand = T | (1u << bit); int c = 0;
#pragma unroll
        for (int k = 0; k < 4; ++k) c += __popcll(__ballot(u[k] >= cand));
        LAS int* buf = cntA + (bit & 1) * 8;
        if (lane == 0) buf[wave] = c;
        __syncthreads();
        int tot = 0;
#pragma unroll
        for (int w = 0; w < 8; ++w) tot += buf[w];
        if (tot >= CAP) T = cand;
    }
    int gt[4], eq[4], loc = 0;
#pragma unroll
    for (int k = 0; k < 4; ++k) { gt[k] = u[k] > T ? 1 : 0; eq[k] = u[k] == T ? 1 : 0; loc += gt[k] + (eq[k] << 16); }
    int inc = loc;
#pragma unroll
    for (int o = 1; o < 64; o <<= 1) { const int t = __shfl_up(inc, o); if (lane >= o) inc += t; }
    if (lane == 63) scanw[wave] = inc;
    __syncthreads();
    int base = 0, total = 0;
#pragma unroll
    for (int w = 0; w < 8; ++w) { const int s = scanw[w]; base += (w < wave) ? s : 0; total += s; }
    const int excl = base + inc - loc, need_eq = CAP - (total & 0xffff);
    int pg = excl & 0xffff, pe = excl >> 16, sl[4];
#pragma unroll
    for (int k = 0; k < 4; ++k) { const bool sel = gt[k] || (eq[k] && pe < need_eq); const int slot = pg + (pe < need_eq ? pe : need_eq);
        sl[k] = sel ? slot : -1; if (sel) idxs[slot] = tid * 4 + k; pg += gt[k]; pe += eq[k]; }
    if (half == 0) *(int __attribute__((ext_vector_type(4)))*)(SEL + (size_t)pair * SEQ + tid * 4) = (int __attribute__((ext_vector_type(4)))){sl[0], sl[1], sl[2], sl[3]};
    __syncthreads();
    if (tid < 128) { const int slot = half * 128 + tid; GIDX[(size_t)e * 2048 + b * CAP + slot] = (unsigned)(b * SEQ + idxs[slot]) * (unsigned)(DM * 2); }
}
__device__ __forceinline__ void stage_router(const float* __restrict__ w_router, LAS unsigned char* lds, int tid) {
    __syncthreads();
    for (int i = tid; i < DM * 4; i += 512) { const int k = i >> 2, e4 = i & 3; *(LAS f32x4*)(lds + (k >> 2) * 272 + (k & 3) * 64 + e4 * 16) = ((const f32x4*)w_router)[i]; }
    __syncthreads();
}
__device__ __forceinline__ void mod_load(f32x4 (&am)[4], f32x4 (&bm)[4], const float* __restrict__ gain, const float* __restrict__ ada_b, int sh_off, int sc_off, int lane) {
#pragma unroll
    for (int j = 0; j < 4; ++j) { const int col = 4 * lane + 256 * j; const f32x4 g4 = *(const f32x4*)(gain + col), sc = *(const f32x4*)(ada_b + sc_off + col); bm[j] = *(const f32x4*)(ada_b + sh_off + col); am[j] = g4 * (sc + 1.0f); }
}
template <bool ROUTER>
__device__ __forceinline__ void hprep_regs(const f32x4 (&v)[4], int t, int lane, const f32x4 (&am)[4], const f32x4 (&bm)[4], bf16_t* __restrict__ H, const LAS unsigned char* wl, float* __restrict__ AFF) {
    float ss = 0.f;
#pragma unroll
    for (int j = 0; j < 4; ++j) ss += (v[j].x * v[j].x + v[j].y * v[j].y) + (v[j].z * v[j].z + v[j].w * v[j].w);
    const float r = 1.0f / sqrtf(wave_sum(ss) * (1.0f / DM) + EPS);
    float lg[NE];
    if (ROUTER) {
#pragma unroll
        for (int e = 0; e < NE; ++e) lg[e] = 0.f; }
#pragma unroll
    for (int j = 0; j < 4; ++j) { const int col = 4 * lane + 256 * j;
        const f32x4 h = (v[j] * r) * am[j] + bm[j];
        *(unsigned long long*)(H + (size_t)t * DM + col) = (unsigned long long)pk2(h.x, h.y) | ((unsigned long long)pk2(h.z, h.w) << 32);
        if (ROUTER) {
#pragma unroll
            for (int q = 0; q < 4; ++q) { const float hv = h[q]; const LAS f32x4* wr = (const LAS f32x4*)(wl + (lane + 64 * j) * 272 + q * 64);
#pragma unroll
                for (int e4 = 0; e4 < 4; ++e4) { const f32x4 w = wr[e4]; lg[e4 * 4 + 0] += hv * w.x; lg[e4 * 4 + 1] += hv * w.y; lg[e4 * 4 + 2] += hv * w.z; lg[e4 * 4 + 3] += hv * w.w; } }
            __builtin_amdgcn_sched_barrier(0);
        }
    }
    if (ROUTER) {
        float a8[8], a4[4], a2[2], a1;
#pragma unroll
        for (int i = 0; i < 8; ++i) { const bool up = lane & 1; const float send = up ? lg[i] : lg[8 + i], keep = up ? lg[8 + i] : lg[i]; a8[i] = keep + __shfl_xor(send, 1); }
#pragma unroll
        for (int i = 0; i < 4; ++i) { const bool up = lane & 2; const float send = up ? a8[i] : a8[4 + i], keep = up ? a8[4 + i] : a8[i]; a4[i] = keep + __shfl_xor(send, 2); }
#pragma unroll
        for (int i = 0; i < 2; ++i) { const bool up = lane & 4; const float send = up ? a4[i] : a4[2 + i], keep = up ? a4[2 + i] : a4[i]; a2[i] = keep + __shfl_xor(send, 4); }
        { const bool up = lane & 8; const float send = up ? a2[0] : a2[1], keep = up ? a2[1] : a2[0]; a1 = keep + __shfl_xor(send, 8); }
        a1 += __shfl_xor(a1, 16); a1 += __shfl_xor(a1, 32);
        const int e_mine = ((lane & 1) << 3) | ((lane & 2) << 1) | ((lane & 4) >> 1) | ((lane & 8) >> 3);
        float mx = a1;
#pragma unroll
        for (int o = 1; o < 16; o <<= 1) mx = fmaxf(mx, __shfl_xor(mx, o));
        const float ex = expf(a1 - mx); float den = ex;
#pragma unroll
        for (int o = 1; o < 16; o <<= 1) den += __shfl_xor(den, o);
        const int b = t >> 11, s = t & 2047;
        if (lane < 16) AFF[((size_t)b * NE + e_mine) * SEQ + s] = ex / den;
    }
}

#define PHASE_IDS int tid_p_ = threadIdx.x; asm volatile("" : "+v"(tid_p_)); const int tid = tid_p_, lane = tid & 63, wave = __builtin_amdgcn_readfirstlane(tid >> 6), gw = vcu * NWAVES + wave; (void)tid; (void)lane; (void)wave; (void)gw
struct MArgs { const float* in[24]; float* out; unsigned char* ws; InvF invf; float lam_init[2]; int ph_lo, ph_hi, li, pad; };

__global__ void __launch_bounds__(NWAVES * 64, 2) mega(MArgs a) {
    extern __shared__ __attribute__((aligned(16))) unsigned char lds[];
    LAS unsigned char* L = (LAS unsigned char*)lds;
    volatile LAS unsigned* MISC = (volatile LAS unsigned*)(L + MISC_OFF);
    const int tid = threadIdx.x, lane = tid & 63, wave = __builtin_amdgcn_readfirstlane(tid >> 6);
    const int G = gridDim.x, bx = blockIdx.x, vcu = (G % 8 == 0) ? (bx % 8) * (G / 8) + bx / 8 : bx;
    unsigned char* ws = a.ws;
    if (tid < 64) MISC[tid] = 0u;
    __syncthreads();
    XcdBarrier bar = xcd_barrier_post((unsigned*)(ws + WS_CTL) + CW_BAR + a.li * XCD_BAR_WORDS, MISC + 8);
    const int lo = a.ph_lo, hi = a.ph_hi;
#define IN(k) (lo <= (k) && (k) < hi)
#ifndef REPEAT_MASK
#define REPEAT_MASK 0u
#endif
#define REPS(k) (int)(1u + ((REPEAT_MASK >> (k)) & 1u))
#ifndef REPEAT_L
#define REPEAT_L 0u
#endif
#define REPS_L(k) (int)(1u + ((REPEAT_L >> (k)) & 1u))
#define SEAM(k) do { if (IN(k) && IN((k) + 1)) xcd_barrier(bar); } while (0)
    const float* x_in = a.in[0]; const float* g_mix = a.in[5]; const float* g_ffn = a.in[6];
    float* X = (float*)(ws + WS_X); bf16_t* H = (bf16_t*)(ws + WS_H); const float* ADA = (const float*)(ws + WS_CTL + CTL_ADA);
    bf16_t *Q = (bf16_t*)(ws + WS_Q), *Kb = (bf16_t*)(ws + WS_K), *V = (bf16_t*)(ws + WS_V), *YT = (bf16_t*)(ws + WS_YT), *UV = (bf16_t*)(ws + WS_UV), *GATES = (bf16_t*)(ws + WS_GATES);
    bf16_t *AOUT = (bf16_t*)(ws + WS_AOUT), *BOUT = (bf16_t*)(ws + WS_BOUT), *COUT = (bf16_t*)(ws + WS_COUT), *T1 = (bf16_t*)(ws + WS_T1), *T2 = (bf16_t*)(ws + WS_T2), *MERGED = (bf16_t*)(ws + WS_MERGED);
    bf16_t *XIN = (bf16_t*)(ws + WS_XIN), *HID = (bf16_t*)(ws + WS_HID); float* Y = (float*)(ws + WS_Y);
    int* SEL = (int*)(ws + WS_SEL); float* AFF = (float*)(ws + WS_AFF);
    const int gw = vcu * NWAVES + wave, NGW = G * NWAVES;

    if (IN(0)) for (int rep_ = 0; rep_ < REPS(0); ++rep_) {

#ifndef SKIP_PRO
        const size_t gt = (size_t)bx * 512 + tid, GT = (size_t)G * 512;
        for (size_t i = gt; i < (size_t)MT * 8; i += GT) rope_entry((int)i, (const int*)a.in[2], (float*)(ws + WS_ROPE), a.invf);
        { LAS float* tc = (LAS float*)L; LAS float* tsn = tc + 2048;
          for (int j = tid; j < 2048; j += 512) { double sn, cs; sincos_d((double)j * (6.283185307179586476925 / 2048.0), sn, cs); tc[j] = (float)(cs * (1.0 / 512.0)); tsn[j] = (float)(-sn * (1.0 / 512.0)); }
          __syncthreads();
          for (size_t i = gt; i < (size_t)2048 * 256; i += GT) { const int m = (int)(i >> 8), k0 = (int)(i & 255) * 8; unsigned cw[4], sw[4];
#pragma unroll
              for (int j = 0; j < 4; ++j) { const int r0 = (m * (k0 + 2 * j)) & 2047, r1 = (m * (k0 + 2 * j + 1)) & 2047; cw[j] = cvtpk_c(tc[r0], tc[r1]); sw[j] = cvtpk_c(tsn[r0], tsn[r1]); }
              *(u32x4*)((bf16_t*)(ws + WS_DFTC) + (size_t)m * 2048 + k0) = (u32x4){cw[0], cw[1], cw[2], cw[3]};
              *(u32x4*)((bf16_t*)(ws + WS_DFTS) + (size_t)m * 2048 + k0) = (u32x4){sw[0], sw[1], sw[2], sw[3]}; }
          __syncthreads(); }
        for (size_t i = gt; i < (size_t)NL * NE * PAD_CH; i += GT) pad_chunk(i, ws);
        for (int it = bx; it < NL * 96; it += G) ada_item(it, a.in[1], a.in[3], a.in[4], (float*)(ws + WS_CTL + CTL_ADA), (LAS float*)L, tid);
        for (int it = G - 1 - bx; it < NL * 4 * 16; it += G) fold_item(it, a.in[7], (bf16_t*)(ws + WS_WIN), (LAS float*)L, tid);
        __syncthreads();
        ConvPtrs P{a.in[7], a.in[15], a.in[16], a.in[17], a.in[18], a.in[20], a.in[21], a.in[22], ws};
        LAS float* scr = (LAS float*)L + wave * (64 * 65);
#ifndef CONV_REPS
#define CONV_REPS 1
#endif
        for (int crep = 0; crep < CONV_REPS; ++crep) { __syncthreads();
        unsigned* qctr = (unsigned*)(ws + WS_CTL) + CW_CONVQ + 64 * crep;
        f32x4 va[16], vb[16]; TileDesc da, db;
        int base = 0, sub = 4, cur = CV_TOTAL;
#define CLAIM_NEXT(dst) do { if (sub == 4) { unsigned t_ = 0u; if (lane == 0) t_ = __hip_atomic_fetch_add(qctr, 4u, __ATOMIC_RELAXED, __HIP_MEMORY_SCOPE_AGENT); base = (int)__builtin_amdgcn_readfirstlane(t_); sub = 0; } \
            dst = base + sub; ++sub; } while (0)
        CLAIM_NEXT(cur);
        if (cur < CV_TOTAL) { da = conv_decode(cur, P); tile_load(da, va, lane);
            for (;;) { int nxt; CLAIM_NEXT(nxt); const bool hn = nxt < CV_TOTAL;
                if (hn) { db = conv_decode(nxt, P); tile_load(db, vb, lane); }
                tile_store(da, va, scr, lane);
                if (!hn) break;
                da = db;
#pragma unroll
                for (int i = 0; i < 16; ++i) va[i] = vb[i]; } }
        }
#undef CLAIM_NEXT
#endif

    }
    SEAM(0);
    if (IN(1)) for (int rep_ = 0; rep_ < REPS(1); ++rep_) {

#ifndef SKIP_HP1
        for (int t0 = 8 * gw; t0 < MT; t0 += 8 * NGW) {
            f32x4 am[4], bm[4]; mod_load(am, bm, g_mix, ADA + (size_t)(t0 >> 11) * 6144, 0, 1024, lane);
#pragma unroll 1
            for (int p = 0; p < 4; ++p) { const int t = t0 + 2 * p; const f32x4* xr = (const f32x4*)(x_in + (size_t)t * DM) + lane; f32x4 v[4], w[4];
#pragma unroll
                for (int j = 0; j < 4; ++j) { v[j] = xr[64 * j]; w[j] = xr[256 + 64 * j]; }
                hprep_regs<false>(v, t, lane, am, bm, H, (const LAS unsigned char*)nullptr, nullptr);
                hprep_regs<false>(w, t + 1, lane, am, bm, H, (const LAS unsigned char*)nullptr, nullptr); } }
#endif

    }
    SEAM(1);
    for (int l = 0; l < NL; ++l) {
        const int pb = 2 + 9 * l;
        const float* ada_l = ADA + (size_t)l * NB * 6144;
        asm volatile(".rept 2\n s_nop 0\n .endr");
        if (IN(pb + 0)) for (int rep_ = 0; rep_ < REPS_L(0); ++rep_) { PHASE_IDS;

#ifndef SKIP_WIN
            pg8::Gemm g{H, (const bf16_t*)(ws + WS_WIN) + (size_t)l * NIN * DM, MT, NIN, DM, 0}; pg8::StaticOrder S; S.init(MT, NIN, G, bx); S.rev = 1;
            pg8::EpiWin E{Q, YT, UV, GATES, (const float*)(ws + WS_ROPE)};
            pg8::gemm_phase<pg8::EpiWin, pg8::StaticOrder, true, true>(L, g, S, E);
#endif

        }
        SEAM(pb + 0);
        asm volatile(".rept 15\n s_nop 0\n .endr");
        if (IN(pb + 1)) for (int rep_ = 0; rep_ < REPS_L(1); ++rep_) { PHASE_IDS;
            float lam;
            { const float* q1 = a.in[8] + l * 64; const float* k1 = a.in[9] + l * 64; const float* q2 = a.in[10] + l * 64; const float* k2 = a.in[11] + l * 64;
              float d1 = q1[lane] * k1[lane], d2 = q2[lane] * k2[lane]; d1 = wave_sum(d1); d2 = wave_sum(d2); lam = expf(d1) - expf(d2) + a.lam_init[l]; }
            const float oscale = 1.0f - a.lam_init[l];

#ifndef SKIP_ATT
#if ATT_DUAL
            for (int rep2_ = 0; rep2_ < REPS_L(9); ++rep2_) att2::attn2_items(vcu, G, Q, Kb, V, AOUT, lam, oscale, a.in[12] + l * 128, (char*)lds);
#else
            for (int rep2_ = 0; rep2_ < REPS_L(9); ++rep2_)
            for (int it = vcu; it < NB * 8 * 16; it += G) { const int qb = it & 15, h = (it >> 4) & 7, b = it >> 7;
                const size_t qo = ((size_t)b * SEQ + qb * 128) * DM + h * 128, ko = (size_t)b * SEQ * DM + h * 128;
                att::attn_item(Q + qo, Kb + ko, V + ko, AOUT + qo, lam, oscale, a.in[12] + l * 128, (char*)lds); }
#endif
#endif


#ifndef SKIP_DFT
            for (int rep3_ = 0; rep3_ < REPS_L(10); ++rep3_)
            { pg8::Gemm g{(const bf16_t*)(ws + WS_DFTC), YT, 4096, 8192, SEQ, 0}; pg8::GroupOrder S; S.init(16, 8, 2, G, bx, 1); pg8::EpiDft E{BOUT};
              pg8::gemm_phase<pg8::EpiDft, pg8::GroupOrder, true, true>(L, g, S, E); }
#endif


#ifndef SKIP_GMLP
            for (int rep4_ = 0; rep4_ < REPS_L(11); ++rep4_)
            for (int it = vcu; it < NB * 16 * 4; it += G) gmlp_item(it, UV, a.in[13] + (size_t)l * 4 * 128 * 128, a.in[14] + (size_t)l * 4 * 128, COUT, L, tid);
#endif

        }
        SEAM(pb + 1);
        if (IN(pb + 2)) for (int rep_ = 0; rep_ < REPS_L(2); ++rep_) { PHASE_IDS;
            pg8::StaticOrder S; S.init(MT, DM, G, bx);

#ifndef SKIP_PROJ
            { pg8::Gemm g{AOUT, (const bf16_t*)(ws + WS_PA) + (size_t)l * 1024 * 1024, MT, DM, 1024, 0}; pg8::EpiProj<0> E{GATES, T1, T2, MERGED}; pg8::gemm_phase<pg8::EpiProj<0>, pg8::StaticOrder, false, true>(L, g, S, E); }
            { pg8::Gemm g{BOUT, (const bf16_t*)(ws + WS_PB) + (size_t)l * 1024 * 1024, MT, DM, 1024, 0}; pg8::EpiProj<1> E{GATES, T1, T2, MERGED}; pg8::gemm_phase<pg8::EpiProj<1>, pg8::StaticOrder, false, true>(L, g, S, E); }
            { pg8::Gemm g{COUT, (const bf16_t*)(ws + WS_PC) + (size_t)l * 1024 * 512, MT, DM, 512, 0}; pg8::EpiProj<2> E{GATES, T1, T2, MERGED}; pg8::gemm_phase<pg8::EpiProj<2>, pg8::StaticOrder, false, true>(L, g, S, E); }
#endif

        }
        SEAM(pb + 2);
        if (IN(pb + 3)) for (int rep_ = 0; rep_ < REPS_L(3); ++rep_) { PHASE_IDS;
            pg8::Gemm g{MERGED, (const bf16_t*)(ws + WS_WOUT) + (size_t)l * 1024 * 1024, MT, DM, 1024, 0}; pg8::StaticOrder S; S.init(MT, DM, G, bx);

#ifndef SKIP_WOUT
            pg8::EpiWout E{l == 0 ? x_in : (const float*)X, X, ada_l + 2048};
            pg8::gemm_phase<pg8::EpiWout, pg8::StaticOrder, false, true>(L, g, S, E);
#endif

        }
        SEAM(pb + 3);
        if (IN(pb + 4)) for (int rep_ = 0; rep_ < REPS_L(4); ++rep_) { PHASE_IDS;

#ifndef SKIP_HP2
            stage_router(a.in[19] + (size_t)l * DM * NE, L, tid);
            for (int t0 = 8 * gw; t0 < MT; t0 += 8 * NGW) {
                f32x4 am[4], bm[4]; mod_load(am, bm, g_ffn + l * DM, ada_l + (size_t)(t0 >> 11) * 6144, 3072, 4096, lane);
#pragma unroll 1
                for (int p = 0; p < 4; ++p) { const int t = t0 + 2 * p; const f32x4* xr = (const f32x4*)(X + (size_t)t * DM) + lane; f32x4 v[4], w[4];
#pragma unroll
                    for (int j = 0; j < 4; ++j) { v[j] = xr[64 * j]; w[j] = xr[256 + 64 * j]; }
                    hprep_regs<true>(v, t, lane, am, bm, H, L, AFF);
                    hprep_regs<true>(w, t + 1, lane, am, bm, H, L, AFF); } }
#endif

        }
        SEAM(pb + 4);

#ifndef SKIP_TOPK
        if (IN(pb + 5)) for (int rep_ = 0; rep_ < REPS_L(5); ++rep_) { PHASE_IDS; for (int it = bx; it < 2 * NB * NE; it += G) topk_gather_item(it >> 1, it & 1, AFF, SEL, (unsigned*)(ws + WS_IDX), L, tid); }
#endif

        SEAM(pb + 5);
        asm volatile(".rept 16\n s_nop 0\n .endr");
        if (IN(pb + 6)) for (int rep_ = 0; rep_ < REPS_L(6); ++rep_) { PHASE_IDS;

#ifndef SKIP_G1
            pg8::Gemm g{H, (const bf16_t*)(ws + WS_W13) + (size_t)l * NE * NFT * 256 * DM, NE * 2048, NE * NFT * 256, DM, 0}; pg8::GroupOrder S; S.init(NE, 8, NFT, G, bx, 0); pg8::EpiG1 E{HID};
            { const unsigned* GIDX = (const unsigned*)(ws + WS_IDX); LAS unsigned* gt = (LAS unsigned*)(L + pg8::STAGE_BYTES);
              pg8::Unit uu; for (int ui = 0; ui < 15 && S.next(ui, uu); ++ui) if (tid < 256) gt[ui * 256 + tid] = GIDX[(size_t)uu.pm * 256 + tid];
              __syncthreads(); }
            pg8::gemm_phase<pg8::EpiG1, pg8::GroupOrder, true, true, true>(L, g, S, E);
#endif

        }
        SEAM(pb + 6);
        asm volatile(".rept 14\n s_nop 0\n .endr");
        if (IN(pb + 7)) for (int rep_ = 0; rep_ < REPS_L(7); ++rep_) { PHASE_IDS;

#ifndef SKIP_G2
            pg8::Gemm g{HID, (const bf16_t*)(ws + WS_W2) + (size_t)l * NE * DM * FFL, NE * 2048, NE * DM, FFP, FFL}; pg8::GroupOrder S; S.init(NE, 8, 4, G, bx, 0); pg8::EpiG2 E{(bf16_t*)Y};
            pg8::gemm_phase<pg8::EpiG2, pg8::GroupOrder, true, true>(L, g, S, E);
#endif

        }
        SEAM(pb + 7);
        if (IN(pb + 8)) for (int rep_ = 0; rep_ < REPS_L(8); ++rep_) { PHASE_IDS;

#ifndef SKIP_COMB
            const bool last = (l + 1 == NL);
            for (int t0 = 8 * gw; t0 < MT; t0 += 8 * NGW) {
                const int b = t0 >> 11;
                f32x4 gr[4], am[4], bm[4];
#pragma unroll
                for (int q = 0; q < 4; ++q) gr[q] = *((const f32x4*)(ada_l + (size_t)b * 6144 + 5120) + lane + 64 * q);
                if (!last) mod_load(am, bm, g_mix + (l + 1) * DM, ADA + ((size_t)(l + 1) * NB + b) * 6144, 0, 1024, lane);
                else {
#pragma unroll
                    for (int q = 0; q < 4; ++q) { am[q] = *((const f32x4*)a.in[23] + lane + 64 * q); bm[q] = (f32x4){0.f, 0.f, 0.f, 0.f}; } }
                int jn = -1; float gn = 0.f; f32x4 xn[4];
                { const int s0 = t0 & 2047; if (lane < NE) { jn = SEL[((size_t)b * NE + lane) * SEQ + s0]; gn = AFF[((size_t)b * NE + lane) * SEQ + s0]; }
#pragma unroll
                  for (int q = 0; q < 4; ++q) xn[q] = *((const f32x4*)(X + (size_t)t0 * DM) + lane + 64 * q); }
#pragma unroll 1
                for (int i = 0; i < 8; ++i) { const int t = t0 + i;
                    const int jv = jn; const float gvv = gn; f32x4 xc[4];
#pragma unroll
                    for (int q = 0; q < 4; ++q) xc[q] = xn[q];
                    if (i + 1 < 8) { const int s1 = (t + 1) & 2047; if (lane < NE) { jn = SEL[((size_t)b * NE + lane) * SEQ + s1]; gn = AFF[((size_t)b * NE + lane) * SEQ + s1]; }
#pragma unroll
                        for (int q = 0; q < 4; ++q) xn[q] = *((const f32x4*)(X + (size_t)(t + 1) * DM) + lane + 64 * q); }
                    f32x4 acc[4];
#pragma unroll
                    for (int q = 0; q < 4; ++q) acc[q] = (f32x4){0.f, 0.f, 0.f, 0.f};
                    unsigned long long msk = __ballot(jv >= 0);
                    while (msk) {
                        const int e0 = __builtin_ctzll(msk); msk &= msk - 1; const bool two = msk != 0ull; const int e1 = two ? __builtin_ctzll(msk) : e0; if (two) msk &= msk - 1;
                        const int j0 = __builtin_amdgcn_readlane(jv, e0), j1 = __builtin_amdgcn_readlane(jv, e1);
                        const float g0 = __builtin_bit_cast(float, __builtin_amdgcn_readlane(__builtin_bit_cast(int, gvv), e0)), g1 = two ? __builtin_bit_cast(float, __builtin_amdgcn_readlane(__builtin_bit_cast(int, gvv), e1)) : 0.f;
                        const unsigned long long* y0 = (const unsigned long long*)((const bf16_t*)Y + ((size_t)e0 * 2048 + b * CAP + j0) * DM) + lane; const unsigned long long* y1 = (const unsigned long long*)((const bf16_t*)Y + ((size_t)e1 * 2048 + b * CAP + j1) * DM) + lane;
                        unsigned long long r0[4], r1[4];
#pragma unroll
                        for (int q = 0; q < 4; ++q) { r0[q] = y0[64 * q]; r1[q] = y1[64 * q]; }
#pragma unroll
                        for (int q = 0; q < 4; ++q) { const unsigned a0 = (unsigned)r0[q], a1 = (unsigned)(r0[q] >> 32), b0 = (unsigned)r1[q], b1 = (unsigned)(r1[q] >> 32);
                            const f32x4 ya = {__builtin_bit_cast(float, a0 << 16), __builtin_bit_cast(float, a0 & 0xffff0000u), __builtin_bit_cast(float, a1 << 16), __builtin_bit_cast(float, a1 & 0xffff0000u)};
                            const f32x4 yb = {__builtin_bit_cast(float, b0 << 16), __builtin_bit_cast(float, b0 & 0xffff0000u), __builtin_bit_cast(float, b1 << 16), __builtin_bit_cast(float, b1 & 0xffff0000u)};
                            acc[q] += ya * g0; acc[q] += yb * g1; }
                    }
                    f32x4 v[4];
#pragma unroll
                    for (int q = 0; q < 4; ++q) v[q] = xc[q] + gr[q] * acc[q];
                    if (!last) {
#pragma unroll
                        for (int q = 0; q < 4; ++q) *((f32x4*)(X + (size_t)t * DM) + lane + 64 * q) = v[q];
                        hprep_regs<false>(v, t, lane, am, bm, H, (const LAS unsigned char*)nullptr, nullptr);
                    } else {
                        float ss = 0.f;
#pragma unroll
                        for (int q = 0; q < 4; ++q) ss += (v[q].x * v[q].x + v[q].y * v[q].y) + (v[q].z * v[q].z + v[q].w * v[q].w);
                        const float r = 1.0f / sqrtf(wave_sum(ss) * (1.0f / DM) + EPS);
#pragma unroll
                        for (int q = 0; q < 4; ++q) ((f32x4*)(a.out + (size_t)t * DM))[lane + 64 * q] = v[q] * r * am[q];
                    }
                }
            }
#endif

        }
        if (l + 1 < NL) SEAM(pb + 8);
    }
#undef IN
#undef SEAM
}

__global__ __launch_bounds__(512) void k_prologue(const float* x, const float* c, const int* positions, const float* w_ada, const float* b_ada, ConvPtrs P, InvF IF) {
    extern __shared__ __attribute__((aligned(16))) unsigned char lds[];
    const int tid = threadIdx.x, lane = tid & 63, wave = tid >> 6;
    unsigned char* ws = P.ws;
    const size_t gt = (size_t)blockIdx.x * 512 + tid, GT = (size_t)gridDim.x * 512;
    for (size_t i = gt; i < (size_t)MT * DM / 4; i += GT) ((f32x4*)(ws + WS_X))[i] = ((const f32x4*)x)[i];
    for (size_t i = gt; i < (size_t)MT * 8; i += GT) rope_entry((int)i, positions, (float*)(ws + WS_ROPE), IF);
    for (size_t i = gt; i < (size_t)2048 * 256; i += GT) dft_entry8((int)i, (bf16_t*)(ws + WS_DFTC), (bf16_t*)(ws + WS_DFTS));
    for (size_t i = gt; i < (size_t)NL * NE * PAD_CH; i += GT) pad_chunk(i, ws);
    for (int it = blockIdx.x; it < NL * 96; it += gridDim.x) ada_item(it, c, w_ada, b_ada, (float*)(ws + WS_CTL + CTL_ADA), (LAS float*)lds, tid);
    for (int it = blockIdx.x; it < NL * 4 * 16; it += gridDim.x) fold_item(it, P.w_in, (bf16_t*)(ws + WS_WIN), (LAS float*)lds, tid);
    __syncthreads();
    LAS float* scr = (LAS float*)(lds) + wave * (64 * 65);
    for (int it = blockIdx.x * 8 + wave; it < CV_TOTAL; it += gridDim.x * 8) conv_item(it, P, scr, lane);
}

template <bool ROUTER>
__global__ __launch_bounds__(256) void k_hprep(const float* X, const float* gain, const float* ADA, int sh_off, int sc_off, bf16_t* H, const float* w_router, float* AFF) {
    const int lane = threadIdx.x & 63; const int gw = blockIdx.x * 4 + (threadIdx.x >> 6), NGW = gridDim.x * 4;
    for (int t = gw; t < MT; t += NGW) {
        const int b = t >> 11;
        const f32x4* xr = (const f32x4*)(X + (size_t)t * DM) + lane;
        f32x4 v[4]; float ss = 0.f;
#pragma unroll
        for (int j = 0; j < 4; ++j) { v[j] = xr[64 * j]; ss += (v[j].x * v[j].x + v[j].y * v[j].y) + (v[j].z * v[j].z + v[j].w * v[j].w); }
        const float r = 1.0f / sqrtf(wave_sum(ss) * (1.0f / DM) + EPS);
        float lg[NE];
        if (ROUTER) {
#pragma unroll
            for (int e = 0; e < NE; ++e) lg[e] = 0.f; }
#pragma unroll
        for (int j = 0; j < 4; ++j) { const int col = 4 * lane + 256 * j;
            const f32x4 g4 = *(const f32x4*)(gain + col), sh = *(const f32x4*)(ADA + b * 6144 + sh_off + col), sc = *(const f32x4*)(ADA + b * 6144 + sc_off + col);
            f32x4 h; h.x = v[j].x * r * g4.x * (1.f + sc.x) + sh.x; h.y = v[j].y * r * g4.y * (1.f + sc.y) + sh.y; h.z = v[j].z * r * g4.z * (1.f + sc.z) + sh.z; h.w = v[j].w * r * g4.w * (1.f + sc.w) + sh.w;
            *(unsigned long long*)(H + (size_t)t * DM + col) = (unsigned long long)pk2(h.x, h.y) | ((unsigned long long)pk2(h.z, h.w) << 32);
            if (ROUTER) {
#pragma unroll
                for (int q = 0; q < 4; ++q) { const float hv = h[q]; const f32x4* wr = (const f32x4*)(w_router + (size_t)(col + q) * NE);
#pragma unroll
                    for (int e4 = 0; e4 < 4; ++e4) { const f32x4 w = wr[e4]; lg[e4 * 4 + 0] += hv * w.x; lg[e4 * 4 + 1] += hv * w.y; lg[e4 * 4 + 2] += hv * w.z; lg[e4 * 4 + 3] += hv * w.w; } } }
        }
        if (ROUTER) {
            float mx = -1e30f;
#pragma unroll
            for (int e = 0; e < NE; ++e) { lg[e] = wave_sum(lg[e]); mx = fmaxf(mx, lg[e]); }
            float den = 0.f;
#pragma unroll
            for (int e = 0; e < NE; ++e) { lg[e] = expf(lg[e] - mx); den += lg[e]; }
            const float inv = 1.0f / den; const int s = t & 2047;
#pragma unroll
            for (int e = 0; e < NE; ++e) if (lane == e) AFF[((size_t)b * NE + e) * SEQ + s] = lg[e] * inv;
        }
    }
}

struct GemmP { const bf16_t* A; const bf16_t* Bt; size_t strideA, strideB; int K, lda, ldb, pad; };
template <class Epi, bool PAIR>
__global__ __launch_bounds__(256) void k_gemm(GemmP g, Epi epi) {
    const int tid = threadIdx.x, wid = tid >> 6, lane = tid & 63, wr = wid >> 1, wc = wid & 1, fr = lane & 15, fq = lane >> 4;
    const int z = blockIdx.z, bx = blockIdx.x;
    const bf16_t* A = g.A + (size_t)z * g.strideA; const bf16_t* Bt = g.Bt + (size_t)z * g.strideB;
    const int row0 = blockIdx.y * 128 + wr * 64;
    int bcol[4];
#pragma unroll
    for (int j = 0; j < 4; ++j) bcol[j] = PAIR ? ((bx >> 1) * 256 + (bx & 1) * 64 + wc * 32 + (j & 1) * 16 + (j >> 1) * 128) : (bx * 128 + wc * 64 + j * 16);
    f32x4 acc[4][4];
#pragma unroll
    for (int i = 0; i < 4; ++i)
#pragma unroll
        for (int j = 0; j < 4; ++j) acc[i][j] = (f32x4){0.f, 0.f, 0.f, 0.f};
    for (int k0 = 0; k0 < g.K; k0 += 32) {
        bf16x8 a[4], b[4];
#pragma unroll
        for (int i = 0; i < 4; ++i) a[i] = *(const bf16x8*)(A + (size_t)(row0 + i * 16 + fr) * g.lda + k0 + fq * 8);
#pragma unroll
        for (int j = 0; j < 4; ++j) b[j] = *(const bf16x8*)(Bt + (size_t)(bcol[j] + fr) * g.ldb + k0 + fq * 8);
#pragma unroll
        for (int i = 0; i < 4; ++i)
#pragma unroll
            for (int j = 0; j < 4; ++j) acc[i][j] = __builtin_amdgcn_mfma_f32_16x16x32_bf16(a[i], b[j], acc[i][j], 0, 0, 0);
    }
#pragma unroll
    for (int i = 0; i < 4; ++i)
#pragma unroll
        for (int r = 0; r < 4; ++r) { const int row = row0 + i * 16 + fq * 4 + r;
            if constexpr (PAIR) {
#pragma unroll
                for (int j = 0; j < 2; ++j) epi.pair(z, row, (bx >> 1) * 128 + (bx & 1) * 64 + wc * 32 + j * 16 + fr, acc[i][j][r], acc[i][j + 2][r]);
            } else {
#pragma unroll
                for (int j = 0; j < 4; ++j) epi(z, row, bcol[j] + fr, acc[i][j][r]);
            } }
}
struct EWin { bf16_t *Q, *K, *V, *YT, *UV, *GATES;
    __device__ __forceinline__ void operator()(int, int t, int n, float v) const {
        if (n < 1024) Q[(size_t)t * DM + n] = (bf16_t)f2bf(v);
        else if (n < 2048) K[(size_t)t * DM + n - 1024] = (bf16_t)f2bf(v);
        else if (n < 3072) V[(size_t)t * DM + n - 2048] = (bf16_t)f2bf(v);
        else if (n < 4096) { const int g = (n - 3072) >> 8, nl = n & 255, part = nl >> 7, cp = nl & 127, b = t >> 11, pos = t & 2047;
            YT[((size_t)(b * 2 + part) * 512 + g * 128 + cp) * SEQ + pos] = (bf16_t)f2bf(v); }
        else if (n < 5120) UV[(size_t)t * 1024 + n - 4096] = (bf16_t)f2bf(gelu_tanh_f(v));
        else GATES[(size_t)t * 3072 + n - 5120] = (bf16_t)f2bf(sigmoid_f(v)); } };
struct EDftP { bf16_t* BOUT; int part, pad;
    __device__ __forceinline__ void operator()(int b, int m, int n, float v) const { BOUT[((size_t)b * SEQ + m) * 1024 + part * 512 + n] = (bf16_t)f2bf(v); } };
template <int WHICH> struct EProj { const bf16_t* GATES; bf16_t* T1; bf16_t* OUT;
    __device__ __forceinline__ void operator()(int, int t, int n, float v) const {
        const float g = bf2f(GATES[(size_t)t * 3072 + WHICH * 1024 + n]); const size_t o = (size_t)t * DM + n;
        if (WHICH == 0) T1[o] = (bf16_t)f2bf(g * v); else if (WHICH == 1) T1[o] = (bf16_t)f2bf(bf2f(T1[o]) + g * v); else OUT[o] = (bf16_t)f2bf(bf2f(T1[o]) + g * v); } };
struct EWout { float* X; const float* gt;
    __device__ __forceinline__ void operator()(int, int t, int n, float v) const { X[(size_t)t * DM + n] += gt[(t >> 11) * 6144 + n] * v; } };
struct EG1 { bf16_t* HID;
    __device__ __forceinline__ void operator()(int, int, int, float) const {}
    __device__ __forceinline__ void pair(int e, int row, int f, float a, float b) const { HID[((size_t)e * 2048 + row) * FFL + f] = (bf16_t)f2bf(silu_f(a) * b); } };
struct EG2 { float* Y;
    __device__ __forceinline__ void operator()(int e, int row, int n, float v) const { Y[((size_t)e * 2048 + row) * DM + n] = v; } };

__global__ __launch_bounds__(256) void k_rope(bf16_t* Q, bf16_t* K, const float* ROPE) {
    const size_t idx = (size_t)blockIdx.x * 256 + threadIdx.x; if (idx >= (size_t)MT * 256) return;
    const int i = idx & 7, c = (idx >> 3) & 1, h = (idx >> 4) & 7, which = (idx >> 7) & 1; const size_t t = idx >> 8;
    bf16_t* p = (which ? K : Q) + t * DM + h * 128 + c * 64 + i;
    const float a = bf2f(p[0]), b = bf2f(p[8]), cs = ROPE[t * 16 + i], sn = ROPE[t * 16 + 8 + i];
    p[0] = (bf16_t)f2bf(a * cs - b * sn); p[8] = (bf16_t)f2bf(a * sn + b * cs);
}
__global__ __launch_bounds__(128) void k_attn_naive(const bf16_t* Q, const bf16_t* K, const bf16_t* V, bf16_t* AOUT, const float* lq1, const float* lk1, const float* lq2, const float* lk2, const float* a_norm_g, float lam_init) {
    __shared__ float smem[16384];
    float (*Ks)[32][64] = (float (*)[32][64])smem;
    float (*Vs)[128] = (float (*)[128])(smem + 4096);
    float (*Ox)[129] = (float (*)[129])smem;
    const int bx = blockIdx.x, qblk = bx & 31, h = (bx >> 5) & 7, b = bx >> 8, tid = threadIdx.x, c = tid >> 6, qi = tid & 63;
    const size_t t = (size_t)b * SEQ + qblk * 64 + qi;
    float q[64], o[128];
#pragma unroll
    for (int d = 0; d < 64; ++d) q[d] = bf2f(Q[t * DM + h * 128 + c * 64 + d]) * (0.125f * 1.4426950408889634f);
#pragma unroll
    for (int d = 0; d < 128; ++d) o[d] = 0.f;
    float m = -1e30f, lsum = 0.f;
    for (int kt = 0; kt < SEQ / 32; ++kt) {
        __syncthreads();
        for (int idx = tid; idx < 32 * 128; idx += 128) { const int key = idx >> 7, d = idx & 127; const size_t src = ((size_t)b * SEQ + kt * 32 + key) * DM + h * 128 + d;
            Ks[d >> 6][key][d & 63] = bf2f(K[src]); Vs[key][d] = bf2f(V[src]); }
        __syncthreads();
        for (int j = 0; j < 32; ++j) {
            float s = 0.f;
#pragma unroll
            for (int d = 0; d < 64; ++d) s += q[d] * Ks[c][j][d];
            if (s > m) { const float al = exp2f(m - s);
#pragma unroll
                for (int d = 0; d < 128; ++d) o[d] *= al;
                lsum *= al; m = s; }
            const float p = exp2f(s - m); lsum += p;
#pragma unroll
            for (int d = 0; d < 128; ++d) o[d] += p * Vs[j][d];
        }
    }
    const float inv = 1.0f / lsum;
    __syncthreads();
    if (c == 1) {
#pragma unroll
        for (int d = 0; d < 128; ++d) Ox[qi][d] = o[d] * inv; }
    __syncthreads();
    if (c == 0) {
        float d1 = 0.f, d2 = 0.f;
        for (int d = 0; d < 64; ++d) { d1 += lq1[d] * lk1[d]; d2 += lq2[d] * lk2[d]; }
        const float lam = expf(d1) - expf(d2) + lam_init;
        float ss = 0.f;
#pragma unroll
        for (int d = 0; d < 128; ++d) { o[d] = o[d] * inv - lam * Ox[qi][d]; ss += o[d] * o[d]; }
        const float r = (1.0f - lam_init) / sqrtf(ss * (1.0f / 128.0f) + EPS);
#pragma unroll
        for (int d = 0; d < 128; ++d) AOUT[t * DM + h * 128 + d] = (bf16_t)f2bf(o[d] * r * a_norm_g[d]);
    }
}
__global__ __launch_bounds__(256) void k_gmlp_naive(const bf16_t* UV, const float* w_s, const float* b_s, bf16_t* COUT) {
    __shared__ float vg[128][128];
    const int bx = blockIdx.x, g = bx & 3, n = (bx >> 2) & 15, b = bx >> 6, tid = threadIdx.x;
    const size_t t0 = (size_t)b * SEQ + n * 128;
    { const int qr = tid >> 1, hf = tid & 1; float v[64]; float ss = 0.f;
#pragma unroll
      for (int cc = 0; cc < 64; ++cc) { v[cc] = bf2f(UV[(t0 + qr) * 1024 + 512 + g * 128 + hf * 64 + cc]); ss += v[cc] * v[cc]; }
      ss += __shfl_xor(ss, 1);
      const float r = 1.0f / sqrtf(ss * (1.0f / 128.0f) + EPS);
#pragma unroll
      for (int cc = 0; cc < 64; ++cc) vg[qr][hf * 64 + cc] = v[cc] * r; }
    __syncthreads();
    const int p = tid >> 1, ch0 = (tid & 1) * 64;
    float acc[64];
#pragma unroll
    for (int cc = 0; cc < 64; ++cc) acc[cc] = 0.f;
    const float* wrow = w_s + ((size_t)g * 128 + p) * 128;
    for (int qq = 0; qq < 128; ++qq) { const float w = wrow[qq];
#pragma unroll
        for (int cc = 0; cc < 64; ++cc) acc[cc] += w * vg[qq][ch0 + cc]; }
    const float bias = b_s[g * 128 + p];
#pragma unroll
    for (int cc = 0; cc < 64; ++cc) { const float u = bf2f(UV[(t0 + p) * 1024 + g * 128 + ch0 + cc]); COUT[(t0 + p) * 512 + g * 128 + ch0 + cc] = (bf16_t)f2bf(u * (acc[cc] + bias)); }
}
__global__ __launch_bounds__(512) void k_topk(const float* AFF, int* SEL, int* IDX) {
    __shared__ float v[SEQ];
    const int pair = blockIdx.x >> 1, half = blockIdx.x & 1, tid = threadIdx.x;
    for (int i = tid; i < SEQ; i += 512) v[i] = AFF[(size_t)pair * SEQ + i];
    __syncthreads();
    for (int ii = 0; ii < 2; ++ii) { const int i = half * 1024 + ii * 512 + tid; const float x = v[i]; int rank = 0;
        for (int j = 0; j < SEQ; ++j) { const float y = v[j]; rank += ((y > x) || (y == x && j < i)) ? 1 : 0; }
        SEL[(size_t)pair * SEQ + i] = rank < CAP ? rank : -1;
        if (rank < CAP) IDX[pair * CAP + rank] = i; }
}
__global__ __launch_bounds__(256) void k_gather(const bf16_t* H, const int* IDX, bf16_t* XIN) {
    const int lane = threadIdx.x & 63; const int gw = blockIdx.x * 4 + (threadIdx.x >> 6), NGW = gridDim.x * 4;
    for (int r = gw; r < NE * 2048; r += NGW) { const int e = r >> 11, b = (r >> 8) & 7, j = r & 255; const int s = IDX[(b * NE + e) * CAP + j];
        const u32x4* src = (const u32x4*)(H + ((size_t)b * SEQ + s) * DM); u32x4* dst = (u32x4*)(XIN + (size_t)r * DM);
        dst[lane] = src[lane]; dst[lane + 64] = src[lane + 64]; }
}
__global__ __launch_bounds__(256) void k_combine(float* X, const float* Y, const int* SEL, const float* AFF, const float* gt2) {
    const int lane = threadIdx.x & 63; const int gw = blockIdx.x * 4 + (threadIdx.x >> 6), NGW = gridDim.x * 4;
    for (int t = gw; t < MT; t += NGW) { const int b = t >> 11, s = t & 2047;
        f32x4 acc[4];
#pragma unroll
        for (int j = 0; j < 4; ++j) acc[j] = (f32x4){0.f, 0.f, 0.f, 0.f};
        for (int e = 0; e < NE; ++e) { const int j = SEL[((size_t)b * NE + e) * SEQ + s];
            if (j >= 0) { const float g = AFF[((size_t)b * NE + e) * SEQ + s]; const f32x4* yr = (const f32x4*)(Y + ((size_t)e * 2048 + b * 256 + j) * DM) + lane;
#pragma unroll
                for (int q = 0; q < 4; ++q) acc[q] += yr[64 * q] * g; } }
        f32x4* xr = (f32x4*)(X + (size_t)t * DM) + lane; const f32x4* gr = (const f32x4*)(gt2 + b * 6144) + lane;
#pragma unroll
        for (int q = 0; q < 4; ++q) xr[64 * q] = xr[64 * q] + gr[64 * q] * acc[q];
    }
}
__global__ __launch_bounds__(256) void k_final(const float* X, const float* gain, float* out) {
    const int lane = threadIdx.x & 63; const int gw = blockIdx.x * 4 + (threadIdx.x >> 6), NGW = gridDim.x * 4;
    for (int t = gw; t < MT; t += NGW) {
        const f32x4* xr = (const f32x4*)(X + (size_t)t * DM) + lane; f32x4 v[4]; float ss = 0.f;
#pragma unroll
        for (int j = 0; j < 4; ++j) { v[j] = xr[64 * j]; ss += (v[j].x * v[j].x + v[j].y * v[j].y) + (v[j].z * v[j].z + v[j].w * v[j].w); }
        const float r = 1.0f / sqrtf(wave_sum(ss) * (1.0f / DM) + EPS);
#pragma unroll
        for (int j = 0; j < 4; ++j) { const f32x4 g4 = *((const f32x4*)gain + lane + 64 * j); ((f32x4*)(out + (size_t)t * DM))[lane + 64 * j] = v[j] * r * g4; }
    }
}

#ifndef MEGA_MASK
#define MEGA_MASK 0x7fbff
#endif
#ifndef MEGA_MERGE
#define MEGA_MERGE 0
#endif
static void v1_launch(void* const* d_in, void* d_out, unsigned char* ws, InvF IF, hipStream_t stream, unsigned mask, int merge, MArgs a, int grid) {
    const float* x = (const float*)d_in[0]; const float* c = (const float*)d_in[1]; const int* positions = (const int*)d_in[2];
    const float* w_ada = (const float*)d_in[3]; const float* b_ada = (const float*)d_in[4]; const float* g_mix = (const float*)d_in[5]; const float* g_ffn = (const float*)d_in[6];
    const float* w_in = (const float*)d_in[7]; const float* lq1 = (const float*)d_in[8]; const float* lk1 = (const float*)d_in[9]; const float* lq2 = (const float*)d_in[10]; const float* lk2 = (const float*)d_in[11];
    const float* a_norm_g = (const float*)d_in[12]; const float* w_s = (const float*)d_in[13]; const float* b_s = (const float*)d_in[14];
    const float* p_a = (const float*)d_in[15]; const float* p_b = (const float*)d_in[16]; const float* p_c = (const float*)d_in[17]; const float* w_out = (const float*)d_in[18];
    const float* w_router = (const float*)d_in[19]; const float* w1 = (const float*)d_in[20]; const float* w3 = (const float*)d_in[21]; const float* w2 = (const float*)d_in[22]; const float* g_final = (const float*)d_in[23];
    ConvPtrs P{w_in, p_a, p_b, p_c, w_out, w1, w3, w2, ws};
    float* X = (float*)(ws + WS_X); bf16_t* H = (bf16_t*)(ws + WS_H); float* ADA = (float*)(ws + WS_CTL + CTL_ADA); float* ROPE = (float*)(ws + WS_ROPE);
    bf16_t *Q = (bf16_t*)(ws + WS_Q), *K = (bf16_t*)(ws + WS_K), *V = (bf16_t*)(ws + WS_V), *YT = (bf16_t*)(ws + WS_YT), *UV = (bf16_t*)(ws + WS_UV), *GATES = (bf16_t*)(ws + WS_GATES);
    bf16_t *AOUT = (bf16_t*)(ws + WS_AOUT), *BOUT = (bf16_t*)(ws + WS_BOUT), *COUT = (bf16_t*)(ws + WS_COUT), *T1 = (bf16_t*)(ws + WS_T1), *MERGED = (bf16_t*)(ws + WS_MERGED);
    bf16_t *XIN = (bf16_t*)(ws + WS_XIN), *HID = (bf16_t*)(ws + WS_HID); float* Y = (float*)(ws + WS_Y);
    int* SEL = (int*)(ws + WS_SEL); int* IDX = (int*)(ws + WS_IDX); float* AFF = (float*)(ws + WS_AFF);
    int n_mega = 0;
    for (int ph = 0; ph < N_PHASES; ++ph) {
        if ((mask >> ph) & 1u) {
#if (WIN_DBG & 0x6F) != 0x6F
            if (ph >= 2 && (ph - 2) % 9 == 0) { const int l = (ph - 2) / 9; GemmP g{H, (const bf16_t*)(ws + WS_WIN) + (size_t)l * NIN * DM, 0, 0, DM, DM, DM, 0}; EWin e{Q, K, V, YT, UV, GATES};
                hipLaunchKernelGGL((k_gemm<EWin, false>), dim3(NIN / 128, MT / 128, 1), dim3(256), 0, stream, g, e);
                hipLaunchKernelGGL(k_rope, dim3(MT), dim3(256), 0, stream, Q, K, (const float*)ROPE); }
#endif
            int hi = ph + 1; if (merge) while (hi < N_PHASES && ((mask >> hi) & 1u)) ++hi;
            a.ph_lo = ph; a.ph_hi = hi; a.li = n_mega++; a.pad = 0;
            hipLaunchKernelGGL(mega, dim3(grid), dim3(NWAVES * 64), LDS_TOTAL, stream, a);
#if (WIN_DBG >> 4) & 1
            if (ph >= 2 && (ph - 2) % 9 == 0) hipLaunchKernelGGL(k_rope, dim3(MT), dim3(256), 0, stream, Q, K, (const float*)ROPE);
#endif
            ph = hi - 1; continue;
        }
        if (ph == 0) { hipLaunchKernelGGL(k_prologue, dim3(1024), dim3(512), 8 * 64 * 65 * 4, stream, x, c, positions, w_ada, b_ada, P, IF); continue; }
        if (ph == 1) { hipLaunchKernelGGL(k_hprep<false>, dim3(1024), dim3(256), 0, stream, x, g_mix, (const float*)ADA, 0, 1024, H, (const float*)nullptr, (float*)nullptr); continue; }
        const int l = (ph - 2) / 9, k = (ph - 2) % 9;
        const float* ada_l = ADA + (size_t)l * NB * 6144;
        const float lam_init = (float)(0.8 - 0.6 * exp(-0.3 * (double)l));
        if (k == 0) { GemmP g{H, (const bf16_t*)(ws + WS_WIN) + (size_t)l * NIN * DM, 0, 0, DM, DM, DM, 0}; EWin e{Q, K, V, YT, UV, GATES};
            hipLaunchKernelGGL((k_gemm<EWin, false>), dim3(NIN / 128, MT / 128, 1), dim3(256), 0, stream, g, e);
            hipLaunchKernelGGL(k_rope, dim3(MT), dim3(256), 0, stream, Q, K, (const float*)ROPE); }
        else if (k == 1) {
            hipLaunchKernelGGL(k_attn_naive, dim3(NB * 8 * 32), dim3(128), 0, stream, (const bf16_t*)Q, (const bf16_t*)K, (const bf16_t*)V, AOUT, lq1 + l * 64, lk1 + l * 64, lq2 + l * 64, lk2 + l * 64, a_norm_g + l * 128, lam_init);
            for (int part = 0; part < 2; ++part) { GemmP gp{(const bf16_t*)(ws + (part ? WS_DFTS : WS_DFTC)), YT + (size_t)part * 512 * SEQ, 0, (size_t)2 * 512 * SEQ, SEQ, SEQ, SEQ, 0}; EDftP ep{BOUT, part, 0};
                hipLaunchKernelGGL((k_gemm<EDftP, false>), dim3(512 / 128, SEQ / 128, NB), dim3(256), 0, stream, gp, ep); }
            hipLaunchKernelGGL(k_gmlp_naive, dim3(NB * 16 * 4), dim3(256), 0, stream, (const bf16_t*)UV, w_s + (size_t)l * 4 * 128 * 128, b_s + (size_t)l * 4 * 128, COUT); }
        else if (k == 2) {
            { GemmP g{AOUT, (const bf16_t*)(ws + WS_PA) + (size_t)l * 1024 * 1024, 0, 0, 1024, 1024, 1024, 0}; EProj<0> e{GATES, T1, MERGED}; hipLaunchKernelGGL((k_gemm<EProj<0>, false>), dim3(8, MT / 128, 1), dim3(256), 0, stream, g, e); }
            { GemmP g{BOUT, (const bf16_t*)(ws + WS_PB) + (size_t)l * 1024 * 1024, 0, 0, 1024, 1024, 1024, 0}; EProj<1> e{GATES, T1, MERGED}; hipLaunchKernelGGL((k_gemm<EProj<1>, false>), dim3(8, MT / 128, 1), dim3(256), 0, stream, g, e); }
            { GemmP g{COUT, (const bf16_t*)(ws + WS_PC) + (size_t)l * 1024 * 512, 0, 0, 512, 512, 512, 0}; EProj<2> e{GATES, T1, MERGED}; hipLaunchKernelGGL((k_gemm<EProj<2>, false>), dim3(8, MT / 128, 1), dim3(256), 0, stream, g, e); } }
        else if (k == 3) { if (l == 0) (void)hipMemcpyAsync(X, x, (size_t)MT * DM * 4, hipMemcpyDeviceToDevice, stream);
            GemmP g{MERGED, (const bf16_t*)(ws + WS_WOUT) + (size_t)l * 1024 * 1024, 0, 0, 1024, 1024, 1024, 0}; EWout e{X, ada_l + 2048};
            hipLaunchKernelGGL((k_gemm<EWout, false>), dim3(8, MT / 128, 1), dim3(256), 0, stream, g, e); }
        else if (k == 4) hipLaunchKernelGGL(k_hprep<true>, dim3(1024), dim3(256), 0, stream, (const float*)X, g_ffn + l * DM, ada_l, 3072, 4096, H, w_router + (size_t)l * DM * NE, AFF);
        else if (k == 5) { hipLaunchKernelGGL(k_topk, dim3(NB * NE * 2), dim3(512), 0, stream, (const float*)AFF, SEL, IDX);
            hipLaunchKernelGGL(k_gather, dim3(1024), dim3(256), 0, stream, (const bf16_t*)H, (const int*)IDX, XIN); }
        else if (k == 6) { GemmP g{XIN, (const bf16_t*)(ws + WS_W13) + (size_t)l * NE * NFT * 256 * DM, (size_t)2048 * DM, (size_t)NFT * 256 * DM, DM, DM, DM, 0}; EG1 e{HID};
            hipLaunchKernelGGL((k_gemm<EG1, true>), dim3(NFT * 2, 2048 / 128, NE), dim3(256), 0, stream, g, e); }
        else if (k == 7) { GemmP g{HID, (const bf16_t*)(ws + WS_W2) + (size_t)l * NE * DM * FFL, (size_t)2048 * FFL, (size_t)DM * FFL, FFP, FFL, FFL, 0}; EG2 e{Y};
            hipLaunchKernelGGL((k_gemm<EG2, false>), dim3(8, 2048 / 128, NE), dim3(256), 0, stream, g, e); }
        else { hipLaunchKernelGGL(k_combine, dim3(1024), dim3(256), 0, stream, X, (const float*)Y, (const int*)SEL, (const float*)AFF, ada_l + 5120);
            if (l + 1 < NL) hipLaunchKernelGGL(k_hprep<false>, dim3(1024), dim3(256), 0, stream, (const float*)X, g_mix + (l + 1) * DM, (const float*)(ADA + (size_t)(l + 1) * NB * 6144), 0, 1024, H, (const float*)nullptr, (float*)nullptr);
            else hipLaunchKernelGGL(k_final, dim3(1024), dim3(256), 0, stream, (const float*)X, g_final, (float*)d_out); }
    }
}

#ifndef KMODE
#define KMODE 0
#endif
extern "C" void kernel_launch(void* const* d_in, const int* in_sizes, int n_in, void* d_out, int out_size, void* d_ws, size_t ws_size, hipStream_t stream) {
    static int grid = 0;
    if (grid == 0) {
        if (n_in != 24 || in_sizes[0] != MT * DM || out_size != MT * DM || ws_size < WS_END) { fprintf(stderr, "kernel_launch: unexpected shapes (n_in %d, in0 %d, out %d, ws %zu)\n", n_in, n_in > 0 ? in_sizes[0] : -1, out_size, ws_size); grid = -1; return; }
        int dev = 0, cus = 0, per_cu = 0;
        if (hipGetDevice(&dev) != hipSuccess || hipDeviceGetAttribute(&cus, hipDeviceAttributeMultiprocessorCount, dev) != hipSuccess) { grid = -1; return; }
        if (hipFuncSetAttribute((const void*)k_prologue, hipFuncAttributeMaxDynamicSharedMemorySize, 8 * 64 * 65 * 4) != hipSuccess) { fprintf(stderr, "kernel_launch: hipFuncSetAttribute failed\n"); grid = -1; return; }
        if (hipFuncSetAttribute((const void*)mega, hipFuncAttributeMaxDynamicSharedMemorySize, LDS_TOTAL) != hipSuccess) { fprintf(stderr, "kernel_launch: hipFuncSetAttribute(mega) failed\n"); grid = -1; return; }
        if (hipOccupancyMaxActiveBlocksPerMultiprocessor(&per_cu, (const void*)mega, NWAVES * 64, LDS_TOTAL) != hipSuccess || per_cu < 1) fprintf(stderr, "kernel_launch: note: occupancy query reports %d workgroups per CU\n", per_cu);
        (void)hipGetLastError();
        grid = cus;
    }
    if (grid < 0) return;
    unsigned char* ws = (unsigned char*)d_ws;
    (void)hipMemsetAsync(ws + WS_CTL, 0, CTL_ZERO_BYTES, stream);
    InvF IF{}; for (int i = 0; i < 8; ++i) IF.v[i] = (float)pow(500000.0, -(double)i / 8.0);
    MArgs a{};
    for (int i = 0; i < 24; ++i) a.in[i] = (const float*)d_in[i];
    a.out = (float*)d_out; a.ws = ws; a.invf = IF;
    for (int l = 0; l < NL; ++l) a.lam_init[l] = (float)(0.8 - 0.6 * exp(-0.3 * (double)l));
#if KMODE == 0
    a.ph_lo = 0; a.ph_hi = N_PHASES; a.li = 0;
    hipLaunchKernelGGL(mega, dim3(grid), dim3(NWAVES * 64), LDS_TOTAL, stream, a);
    { const hipError_t le = hipPeekAtLastError(); if (le != hipSuccess) fprintf(stderr, "kernel_launch: launch failed: %s\n", hipGetErrorName(le)); }
#elif KMODE == 1
    v1_launch(d_in, d_out, ws, IF, stream, 0u, 0, a, grid);
#else
    v1_launch(d_in, d_out, ws, IF, stream, (unsigned)(MEGA_MASK), MEGA_MERGE, a, grid);
#endif
}
```
